# Optimizing an MI355X kernel written in HIP

```python
import jax, jax.numpy as jnp
from jax import lax
import numpy as np

D_MODEL = 1024
BATCH = 16
SEQ = 2048
DEPTH = 1

CTX_LEN = 256
GRID_W = 64
CHUNK = 128
RET_HEADS = 4
RET_DK = 256
RET_DV = 256
RET_W = RET_HEADS * RET_DK
ML_HEADS = 4
ML_DK = 256
ML_DV = 256
ML_W = ML_HEADS * ML_DK
CONV_W = 3
N_ML_GATES = 4 * ML_HEADS
N_GROUPS = 4
EXP_PER_GROUP = 8
N_EXPERTS = N_GROUPS * EXP_PER_GROUP
TOP_K = 2
D_EXPERT = 512
MOE_BLOCK = 128
DN_ALPHA = (2 * DEPTH) ** 0.25
DN_BETA = (8 * DEPTH) ** -0.25
ROPE_BASE = 10000.0
LN_EPS = 1e-5
NEG_INF = -1e30
IN_SIZES = [RET_W, RET_W, RET_W, RET_W, ML_W, ML_W, ML_W, ML_W, N_ML_GATES, D_MODEL, D_MODEL]
IN_COLS = int(sum(IN_SIZES))
IN_SPLITS = np.cumsum(IN_SIZES)[:-1].tolist()

kernel_name = "hybrid_retention_mlstm_hmoe_dit"

F32 = jnp.float32


def layer_norm(x):
    xf = x.astype(F32)
    mu = xf.mean(-1, keepdims=True)
    var = jnp.mean(jnp.square(xf - mu), -1, keepdims=True)
    return ((xf - mu) * lax.rsqrt(var + LN_EPS)).astype(x.dtype)


def post_norm(x, g, b):
    return layer_norm(x) * g + b


def modulate(h, shift, scale):
    return h * (1.0 + scale) + shift


def heads(t, n_heads):
    B, T, _ = t.shape
    return t.reshape(B, T, n_heads, -1).transpose(0, 2, 1, 3)


def merge_heads(t):
    B, H, T, d = t.shape
    return t.transpose(0, 2, 1, 3).reshape(B, T, H * d)


def flip(t):
    return jnp.flip(t, axis=2)


def rotary_2d(t, pos_row, pos_col):
    half = t.shape[-1] // 2
    quarter = half // 2
    freqs = ROPE_BASE ** (-jnp.arange(quarter, dtype=F32) / quarter)

    def rot(u, pos):
        ang = pos.astype(F32)[:, None] * freqs[None, :]
        cos, sin = jnp.cos(ang), jnp.sin(ang)
        u1, u2 = u[..., :quarter], u[..., quarter:]
        return jnp.concatenate([u1 * cos - u2 * sin, u1 * sin + u2 * cos], -1)

    out = jnp.concatenate([rot(t[..., :half], pos_row), rot(t[..., half:], pos_col)], -1)
    return out.astype(t.dtype)


def centred_conv(x, w, b):
    pad = CONV_W // 2
    T = x.shape[1]
    xp = jnp.pad(x, ((0, 0), (pad, pad), (0, 0)))
    return sum(xp[:, j:j + T, :] * w[j] for j in range(CONV_W)) + b


def to_chunks(t):
    B, H, T = t.shape[:3]
    t = t.reshape((B, H, T // CHUNK, CHUNK) + t.shape[3:])
    return jnp.moveaxis(t, 2, 0)


def from_chunks(t):
    t = jnp.moveaxis(t, 0, 2)
    B, H, N, L = t.shape[:4]
    return t.reshape((B, H, N * L) + t.shape[4:])


def intra_mask(inclusive):
    idx = jnp.arange(CHUNK)
    rel = idx[:, None] - idx[None, :]
    return (rel >= 0) if inclusive else (rel > 0), rel.astype(F32)


def retention_scan(q, k, v, log_gamma, s0, inclusive):
    q, k, v = q.astype(F32), k.astype(F32), v.astype(F32)
    mask, rel = intra_mask(inclusive)
    idx = jnp.arange(CHUNK, dtype=F32)
    lg = log_gamma[:, None, None]
    intra_decay = jnp.where(mask, jnp.exp(jnp.where(mask, rel, 0.0) * lg), 0.0)
    q_decay = jnp.exp((idx + 1.0)[None, :] * log_gamma[:, None])
    k_decay = jnp.exp((CHUNK - 1.0 - idx)[None, :] * log_gamma[:, None])
    chunk_decay = jnp.exp(CHUNK * log_gamma)

    def step(s, qkv):
        qc, kc, vc = qkv
        att = jnp.einsum('bhld,bhmd->bhlm', qc, kc) * intra_decay
        out = (jnp.einsum('bhlm,bhme->bhle', att, vc)
               + jnp.einsum('bhld,bhde->bhle', qc, s) * q_decay[None, :, :, None])
        s = (s * chunk_decay[None, :, None, None]
             + jnp.einsum('bhld,bhle->bhde', kc * k_decay[None, :, :, None], vc))
        return s, out

    s, out = lax.scan(step, s0, (to_chunks(q), to_chunks(k), to_chunks(v)))
    return from_chunks(out), s


def retention_state(k, v, log_gamma):
    T = k.shape[2]
    w = jnp.exp((T - 1.0 - jnp.arange(T, dtype=F32))[None, :] * log_gamma[:, None])
    return jnp.einsum('bhtd,bhte->bhde', k.astype(F32) * w[None, :, :, None], v.astype(F32))


def mlstm_scan(q, k, v, log_i, log_f, state0, inclusive):
    q, k, v = q.astype(F32), k.astype(F32), v.astype(F32)
    mask, _ = intra_mask(inclusive)

    def step(carry, inp):
        C, n, m = carry
        qc, kc, vc, ic, fc = inp
        b = jnp.cumsum(fc, axis=-1)
        d = jnp.where(mask, b[..., :, None] - b[..., None, :] + ic[..., None, :], NEG_INF)
        inter = b + m[..., None]
        m_row = jnp.maximum(d.max(-1), inter)
        w = jnp.exp(d - m_row[..., None])
        a = jnp.exp(inter - m_row)
        att = jnp.einsum('bhld,bhmd->bhlm', qc, kc) * w
        num = jnp.einsum('bhlm,bhme->bhle', att, vc) + a[..., None] * jnp.einsum('bhld,bhde->bhle', qc, C)
        den = att.sum(-1) + a * jnp.einsum('bhld,bhd->bhl', qc, n)
        h = num / jnp.maximum(jnp.abs(den), jnp.exp(-m_row))[..., None]
        b_last = b[..., -1]
        g = b_last[..., None] - b + ic
        m_new = jnp.maximum(b_last + m, g.max(-1))
        kw = kc * jnp.exp(g - m_new[..., None])[..., None]
        decay = jnp.exp(b_last + m - m_new)
        C = decay[..., None, None] * C + jnp.einsum('bhld,bhle->bhde', kw, vc)
        n = decay[..., None] * n + kw.sum(2)
        return (C, n, m_new), h

    state, h = lax.scan(step, state0, (to_chunks(q), to_chunks(k), to_chunks(v),
                                       to_chunks(log_i), to_chunks(log_f)))
    return from_chunks(h), state


def mlstm_state(k, v, log_i, log_f):
    k, v = k.astype(F32), v.astype(F32)
    F = jnp.cumsum(log_f, axis=-1)
    FT = F[..., -1]
    g = FT[..., None] - F + log_i
    m = jnp.maximum(FT, g.max(-1))
    kw = k * jnp.exp(g - m[..., None])[..., None]
    return (jnp.einsum('bhtd,bhte->bhde', kw, v), kw.sum(2), m)


def project_stream(u, w_in, b_mgate, conv_w, conv_b, pos):
    B, T, _ = u.shape
    rq, rk, rv, rg, mq, mk, mv, mo, mg, gate_r, gate_m = jnp.split(u @ w_in, IN_SPLITS, axis=-1)
    rq, rk, rv = heads(rq, RET_HEADS), heads(rk, RET_HEADS) * RET_DK ** -0.5, heads(rv, RET_HEADS)
    if pos is not None:
        rq, rk = rotary_2d(rq, *pos), rotary_2d(rk, *pos)
    mq = jax.nn.silu(centred_conv(mq, conv_w[:, :ML_W], conv_b[:ML_W]))
    mk = jax.nn.silu(centred_conv(mk, conv_w[:, ML_W:], conv_b[ML_W:]))
    mq, mk, mv = heads(mq, ML_HEADS), heads(mk, ML_HEADS) * ML_DK ** -0.5, heads(mv, ML_HEADS)
    g = (mg + b_mgate).astype(F32).reshape(B, T, 4, ML_HEADS).transpose(2, 0, 3, 1)
    ml_gates = (g[0], jax.nn.log_sigmoid(g[1]), g[2], jax.nn.log_sigmoid(g[3]))
    return (rq, rk, rv, rg), (mq, mk, mv, mo), ml_gates, (gate_r, gate_m)


def merge_branches(ret, mls, rg, mo, gate_r, gate_m, w_ret_branch, w_ml_branch, w_out):
    r = merge_heads(layer_norm(ret)).astype(rg.dtype) * jax.nn.silu(rg)
    m = merge_heads(layer_norm(mls)).astype(mo.dtype) * jax.nn.sigmoid(mo)
    y = jax.nn.sigmoid(gate_r) * (r @ w_ret_branch) + jax.nn.sigmoid(gate_m) * (m @ w_ml_branch)
    return y @ w_out


def token_mixer(u_lat, u_ctx, pos, w_in, b_mgate, conv_w, conv_b, decay_logit,
                w_ret_branch, w_ml_branch, w_out, need_ctx_out):
    B = u_lat.shape[0]
    lg = jax.nn.log_sigmoid(decay_logit.astype(F32))
    (crq, crk, crv, crg), (cmq, cmk, cmv, cmo), (ci_f, clf_f, ci_b, clf_b), (cgr, cgm) = \
        project_stream(u_ctx, w_in, b_mgate, conv_w, conv_b, None)
    (lrq, lrk, lrv, lrg), (lmq, lmk, lmv, lmo), (li_f, llf_f, li_b, llf_b), (lgr, lgm) = \
        project_stream(u_lat, w_in, b_mgate, conv_w, conv_b, pos)
    merge = lambda ret, mls, rg, mo, gr, gm: merge_branches(ret, mls, rg, mo, gr, gm,
                                                           w_ret_branch, w_ml_branch, w_out)
    if need_ctx_out:
        zr = jnp.zeros((B, RET_HEADS, RET_DK, RET_DV), F32)
        zm = (jnp.zeros((B, ML_HEADS, ML_DK, ML_DV), F32), jnp.zeros((B, ML_HEADS, ML_DK), F32),
              jnp.zeros((B, ML_HEADS), F32))
        cr_f, s_f = retention_scan(crq, crk, crv, lg[0], zr, True)
        cr_b, s_b = retention_scan(flip(crq), flip(crk), flip(crv), lg[1], zr, False)
        cm_f, m_f = mlstm_scan(cmq, cmk, cmv, ci_f, clf_f, zm, True)
        cm_b, m_b = mlstm_scan(flip(cmq), flip(cmk), flip(cmv), flip(ci_b), flip(clf_b), zm, False)
        y_ctx = merge(cr_f + flip(cr_b), cm_f + flip(cm_b), crg, cmo, cgr, cgm)
    else:
        s_f = retention_state(crk, crv, lg[0])
        s_b = retention_state(flip(crk), flip(crv), lg[1])
        m_f = mlstm_state(cmk, cmv, ci_f, clf_f)
        m_b = mlstm_state(flip(cmk), flip(cmv), flip(ci_b), flip(clf_b))
        y_ctx = None
    lr_f, _ = retention_scan(lrq, lrk, lrv, lg[0], s_f, True)
    lr_b, _ = retention_scan(flip(lrq), flip(lrk), flip(lrv), lg[1], s_b, False)
    lm_f, _ = mlstm_scan(lmq, lmk, lmv, li_f, llf_f, m_f, True)
    lm_b, _ = mlstm_scan(flip(lmq), flip(lmk), flip(lmv), flip(li_b), flip(llf_b), m_b, False)
    y_lat = merge(lr_f + flip(lr_b), lm_f + flip(lm_b), lrg, lmo, lgr, lgm)
    return y_lat, y_ctx


def hier_moe(u, w_rg, b_rg, w_re, b_re, w_e1, w_e3, w_e2):
    N, D = u.shape
    p_g = jax.nn.softmax((u @ w_rg + b_rg).astype(F32), axis=-1)
    pg_top, g_idx = lax.top_k(p_g, 1)
    le = (u @ w_re + b_re).astype(F32).reshape(N, N_GROUPS, EXP_PER_GROUP)
    le = jnp.take_along_axis(le, g_idx[:, :, None], axis=1)[:, 0]
    pe_top, e_idx = lax.top_k(jax.nn.softmax(le, axis=-1), TOP_K)
    w = pg_top * pe_top / pe_top.sum(-1, keepdims=True)
    e_flat = (g_idx * EXP_PER_GROUP + e_idx).reshape(-1)
    w_flat = w.reshape(-1)
    t_flat = jnp.repeat(jnp.arange(N, dtype=jnp.int32), TOP_K)
    n_assign = N * TOP_K
    n_blocks = -(-n_assign // MOE_BLOCK) + N_EXPERTS
    n_slots = n_blocks * MOE_BLOCK
    order = jnp.argsort(e_flat)
    se, st, sw = e_flat[order], t_flat[order], w_flat[order]
    counts = jnp.zeros((N_EXPERTS,), jnp.int32).at[e_flat].add(1)
    offsets = jnp.cumsum(counts) - counts
    padded = (counts + MOE_BLOCK - 1) // MOE_BLOCK * MOE_BLOCK
    pad_end = jnp.cumsum(padded)
    pad_off = pad_end - padded
    dest = pad_off[se] + jnp.arange(n_assign, dtype=jnp.int32) - offsets[se]
    slot_tok = jnp.zeros((n_slots,), jnp.int32).at[dest].set(st)
    slot_w = jnp.zeros((n_slots,), F32).at[dest].set(sw)
    block_start = jnp.arange(n_blocks, dtype=jnp.int32) * MOE_BLOCK
    block_exp = jnp.minimum((block_start[:, None] >= pad_end[None, :]).sum(1), N_EXPERTS - 1)
    xs = u[slot_tok].reshape(n_blocks, MOE_BLOCK, D)

    def expert_block(args):
        xb, e = args
        return (jax.nn.silu(xb @ w_e1[e]) * (xb @ w_e3[e])) @ w_e2[e]

    ys = lax.map(expert_block, (xs, block_exp)).reshape(n_slots, D)
    out = jnp.zeros((N, D), F32).at[slot_tok].add(slot_w[:, None] * ys)
    return out.astype(u.dtype)


def setup_inputs(seed: int = 0) -> dict:
    key = jax.random.key(seed)
    ks = iter(jax.random.split(key, 32))
    nrm = lambda shape, scale: scale * jax.random.normal(next(ks), shape, F32)
    D = D_MODEL
    lin = jnp.linspace(3.0, 6.0, ML_HEADS, dtype=F32)
    zh = jnp.zeros((ML_HEADS,), F32)
    gate_base = jnp.concatenate([zh, lin, zh, lin])[None, :]
    decay_base = jnp.log(2.0 ** (5.0 + jnp.arange(RET_HEADS, dtype=F32)) - 1.0)
    return {
        "x": nrm((BATCH, SEQ, D), 1.0),
        "c": nrm((BATCH, D), 1.0),
        "ctx": nrm((BATCH, CTX_LEN, D), 1.0),
        "c_ctx": nrm((D,), 1.0),
        "w_ada": nrm((DEPTH, D, 6 * D), D ** -0.5),
        "b_ada": nrm((DEPTH, 6 * D), 0.02),
        "w_in": nrm((DEPTH, D, IN_COLS), D ** -0.5),
        "b_mgate": gate_base + nrm((DEPTH, N_ML_GATES), 0.1),
        "ml_conv_w": nrm((DEPTH, CONV_W, 2 * ML_W), CONV_W ** -0.5),
        "ml_conv_b": nrm((DEPTH, 2 * ML_W), 0.02),
        "ret_decay_logit": decay_base[None, None, :] + nrm((DEPTH, 2, RET_HEADS), 0.01),
        "w_ret_branch": nrm((DEPTH, RET_HEADS * RET_DV, D), (RET_HEADS * RET_DV) ** -0.5),
        "w_ml_branch": nrm((DEPTH, ML_HEADS * ML_DV, D), (ML_HEADS * ML_DV) ** -0.5),
        "w_out": nrm((DEPTH, D, D), DN_BETA * D ** -0.5),
        "ln1_g": 1.0 + nrm((DEPTH, D), 0.02),
        "ln1_b": nrm((DEPTH, D), 0.02),
        "w_rg": nrm((DEPTH, D, N_GROUPS), D ** -0.5),
        "b_rg": nrm((DEPTH, N_GROUPS), 0.01),
        "w_re": nrm((DEPTH, D, N_EXPERTS), D ** -0.5),
        "b_re": nrm((DEPTH, N_EXPERTS), 0.01),
        "w_e1": nrm((DEPTH, N_EXPERTS, D, D_EXPERT), D ** -0.5),
        "w_e3": nrm((DEPTH, N_EXPERTS, D, D_EXPERT), D ** -0.5),
        "w_e2": nrm((DEPTH, N_EXPERTS, D_EXPERT, D), DN_BETA * D_EXPERT ** -0.5),
        "ln2_g": 1.0 + nrm((DEPTH, D), 0.02),
        "ln2_b": nrm((DEPTH, D), 0.02),
    }


def reference(x, c, ctx, c_ctx, w_ada, b_ada, w_in, b_mgate, ml_conv_w, ml_conv_b, ret_decay_logit,
              w_ret_branch, w_ml_branch, w_out, ln1_g, ln1_b, w_rg, b_rg, w_re, b_re,
              w_e1, w_e3, w_e2, ln2_g, ln2_b):
    B, T, D = x.shape
    ROWS = T // GRID_W
    pos = (jnp.repeat(jnp.arange(ROWS), GRID_W), jnp.tile(jnp.arange(GRID_W), ROWS))
    h_ctx = ctx
    for l in range(DEPTH):
        last = l == DEPTH - 1
        mod = jax.nn.silu(c) @ w_ada[l] + b_ada[l]
        sh1, sc1, g1, sh2, sc2, g2 = jnp.split(mod[:, None, :], 6, axis=-1)
        cmod = jax.nn.silu(c_ctx) @ w_ada[l] + b_ada[l]
        csh1, csc1, cg1, csh2, csc2, cg2 = jnp.split(cmod[None, None, :], 6, axis=-1)
        u_lat = modulate(layer_norm(x), sh1, sc1)
        u_ctx = modulate(layer_norm(h_ctx), csh1, csc1)
        y_lat, y_ctx = token_mixer(u_lat, u_ctx, pos, w_in[l], b_mgate[l], ml_conv_w[l], ml_conv_b[l],
                                   ret_decay_logit[l], w_ret_branch[l], w_ml_branch[l], w_out[l],
                                   not last)
        x = post_norm(DN_ALPHA * x + g1 * y_lat, ln1_g[l], ln1_b[l])
        moe_p = (w_rg[l], b_rg[l], w_re[l], b_re[l], w_e1[l], w_e3[l], w_e2[l])
        u2 = modulate(layer_norm(x), sh2, sc2)
        if last:
            f_lat = hier_moe(u2.reshape(-1, D), *moe_p).reshape(x.shape)
        else:
            h_ctx = post_norm(DN_ALPHA * h_ctx + cg1 * y_ctx, ln1_g[l], ln1_b[l])
            u2c = modulate(layer_norm(h_ctx), csh2, csc2)
            f_all = hier_moe(jnp.concatenate([u2.reshape(-1, D), u2c.reshape(-1, D)], axis=0), *moe_p)
            f_lat = f_all[:B * T].reshape(x.shape)
            h_ctx = post_norm(DN_ALPHA * h_ctx + cg2 * f_all[B * T:].reshape(h_ctx.shape),
                              ln2_g[l], ln2_b[l])
        x = post_norm(DN_ALPHA * x + g2 * f_lat, ln2_g[l], ln2_b[l])
    return x
```

```cpp
#include <hip/hip_runtime.h>
#include <hip/hip_cooperative_groups.h>
#include <cstdio>
#include <cstdint>
namespace cg = cooperative_groups;

#define LAS __attribute__((address_space(3)))
typedef unsigned short bf16_t;
typedef short bf16x8 __attribute__((ext_vector_type(8)));
typedef float f32x4 __attribute__((ext_vector_type(4)));
typedef float f32x2 __attribute__((ext_vector_type(2)));
typedef unsigned u32x4 __attribute__((ext_vector_type(4)));
typedef unsigned u32x2 __attribute__((ext_vector_type(2)));
typedef __bf16 bf16x2_t __attribute__((ext_vector_type(2)));

constexpr int D = 1024, NB = 16, T = 2048, TC = 256, TT = T + TC;
constexpr int NROW = NB * TT;
constexpr int NLAT = NB * T;
constexpr int NH = 4, DH = 256;
constexpr int IN_COLS = 10256, IN_PHYS = 10496;
constexpr int NE = 32, DE = 512;
constexpr int CH = 64;
constexpr float LN_EPS = 1e-5f;
constexpr float DN_ALPHA = 1.189207115002721f;
constexpr int MAXSLOT = 73728;

constexpr size_t MiB = 1u << 20;
constexpr size_t WS_CTL = 0;
constexpr size_t WS_BAR = 16384;
constexpr size_t WS_WT_IN = 1 * MiB;
constexpr size_t WS_WT_R = 22 * MiB, WS_WT_M = 24 * MiB, WS_WT_O = 26 * MiB;
constexpr size_t WS_MOD = 28 * MiB;
constexpr size_t WS_ROT = 29 * MiB;
constexpr size_t WS_G = 30 * MiB;
constexpr size_t WS_WRT = 33 * MiB;
constexpr size_t WS_TOKREC = 34 * MiB;
constexpr size_t WS_TOKSLOT = 35 * MiB;
constexpr size_t WS_TILEEXP = 36 * MiB;
constexpr size_t WS_BASE = 37 * MiB;
constexpr size_t WS_U = 40 * MiB;
constexpr size_t WS_HS = 40 * MiB;
constexpr size_t WS_X0 = 112 * MiB;
constexpr size_t WS_RQ = 296 * MiB, WS_RK = 368 * MiB, WS_RVT = 440 * MiB;
constexpr size_t WS_MVT = 296 * MiB, WS_MQRAW = 112 * MiB, WS_MKRAW = 184 * MiB;
constexpr size_t WS_MQ = 368 * MiB, WS_MK = 440 * MiB;
constexpr size_t WS_OMF = 112 * MiB, WS_OMB = 176 * MiB;
constexpr size_t WS_RGA = 240 * MiB, WS_MOA = 304 * MiB, WS_GRA = 368 * MiB, WS_GMA = 432 * MiB;
constexpr size_t WS_M = 112 * MiB;
constexpr size_t WS_Y = 176 * MiB;
constexpr size_t WS_Y2 = 112 * MiB;
constexpr size_t WS_U2 = 176 * MiB;
constexpr size_t WS_W13T = 240 * MiB;
constexpr size_t WS_W2T = 304 * MiB;
constexpr size_t WS_XS = 336 * MiB;
constexpr size_t WS_YS = 336 * MiB;
constexpr size_t WS_NEED = 512 * MiB;

constexpr int LDS_BYTES = 147456;
constexpr int NTHREADS = 512, NWAVES = 8;

struct Params { const float* in[25]; float* out; unsigned char* ws; int ph_lo, ph_hi; };
enum { I_X = 0, I_C, I_CTX, I_CCTX, I_WADA, I_BADA, I_WIN, I_BMG, I_CONVW, I_CONVB, I_DECAY, I_WRB, I_WMB, I_WOUT, I_LN1G, I_LN1B,
       I_WRG, I_BRG, I_WRE, I_BRE, I_WE1, I_WE3, I_WE2, I_LN2G, I_LN2B };

__device__ __forceinline__ unsigned pk2(float lo, float hi) { f32x2 v = {lo, hi}; bf16x2_t b = __builtin_convertvector(v, bf16x2_t); return __builtin_bit_cast(unsigned, b); }
__device__ __forceinline__ float bflo(unsigned w) { return __uint_as_float(w << 16); }
__device__ __forceinline__ float bfhi(unsigned w) { return __uint_as_float(w & 0xffff0000u); }
__device__ __forceinline__ float bf2f(bf16_t h) { return __uint_as_float(((unsigned)h) << 16); }
__device__ __forceinline__ bf16_t f2bf(float f) { return (bf16_t)(pk2(f, 0.f) & 0xffffu); }
__device__ __forceinline__ float wave_sum(float v) {
#pragma unroll
    for (int o = 1; o < 64; o <<= 1) v += __shfl_xor(v, o);
    return v;
}
__device__ __forceinline__ float half_sum(float v) {
#pragma unroll
    for (int o = 1; o < 32; o <<= 1) v += __shfl_xor(v, o);
    return v;
}
template <class T> __device__ __forceinline__ T ld_nt(const T* p) { return __builtin_nontemporal_load(p); }
template <class T> __device__ __forceinline__ void st_nt(T* p, const T& v) { __builtin_nontemporal_store(v, p); }
__device__ __forceinline__ float silu_f(float x) { return x / (1.f + __expf(-x)); }
__device__ __forceinline__ float sigmoid_f(float x) { return 1.f / (1.f + __expf(-x)); }
__device__ __forceinline__ float logsigmoid_f(float x) { return fminf(x, 0.f) - log1pf(expf(-fabsf(x))); }
#define MFMA16(a, b, c) __builtin_amdgcn_mfma_f32_16x16x32_bf16((a), (b), (c), 0, 0, 0)

template <int MODE> __device__ __forceinline__ int rowmap(int n) {
    if (MODE == 0) return n;
    if (MODE == 1) {
        if (n < 2048) { const int blk = n >> 10, w = n & 1023, h = w >> 8, dd = w & 255, hb = dd >> 7, part = (dd >> 6) & 1, i = dd & 63; return blk * 1024 + h * 256 + part * 128 + hb * 64 + i; }
        if (n < 8192) return n;
        if (n < 8208) return 10240 + (n - 8192);
        return n - 16;
    }
    if (MODE == 2) return (n >> 7) * 256 + (n & 127);
    return (n >> 7) * 256 + 128 + (n & 127);
}
template <int MODE> __device__ __forceinline__ void transpose_item(const float* W, int K, int N, bf16_t* WT, LAS float* scr, int item, int lane) {
    const int nblk = (N + 31) / 32, kb = item / nblk, nb = item % nblk, k0 = 64 * kb, n0 = 32 * nb;
    const int nn = n0 + (lane & 31);
#pragma unroll 8
    for (int i = 0; i < 32; ++i) { const int kk = 2 * i + (lane >> 5); scr[kk * 33 + (lane & 31)] = (nn < N) ? ld_nt(W + (size_t)(k0 + kk) * N + nn) : 0.f; }
    asm volatile("s_waitcnt lgkmcnt(0)" ::: "memory");
    const int c = lane & 7;
#pragma unroll
    for (int j = 0; j < 4; ++j) { const int n = (lane >> 3) + 8 * j; const LAS float* s = scr + (8 * c) * 33 + n;
        u32x4 o; o.x = pk2(s[0 * 33], s[1 * 33]); o.y = pk2(s[2 * 33], s[3 * 33]); o.z = pk2(s[4 * 33], s[5 * 33]); o.w = pk2(s[6 * 33], s[7 * 33]);
        if (n0 + n < N) *(u32x4*)(WT + (size_t)rowmap<MODE>(n0 + n) * K + k0 + 8 * c) = o; }
    asm volatile("s_waitcnt lgkmcnt(0)" ::: "memory");
}

__device__ __forceinline__ void phase0(const Params& p, LAS unsigned char* lds, int tid, int wave, int lane) {
    const int G = gridDim.x, gw = blockIdx.x * NWAVES + wave, NGW = G * NWAVES;
    unsigned char* ws = p.ws;
    if (blockIdx.x == 0) { if (tid < 64) ((int*)(ws + WS_CTL))[tid] = 0; for (int i = tid; i < 3456; i += NTHREADS) ((unsigned*)(ws + WS_BAR))[i] = 0u; }
    {
        LAS float* scr = (LAS float*)(lds + wave * 8448);
        constexpr int I_IN = 16 * 321, I_SQ = 16 * 32;
        for (int it = gw; it < I_IN + 3 * I_SQ; it += NGW) {
            int r = it;
            if (r < I_IN) { transpose_item<1>(p.in[I_WIN], 1024, IN_COLS, (bf16_t*)(ws + WS_WT_IN), scr, r, lane); continue; } r -= I_IN;
            if (r < I_SQ) { transpose_item<0>(p.in[I_WRB], 1024, 1024, (bf16_t*)(ws + WS_WT_R), scr, r, lane); continue; } r -= I_SQ;
            if (r < I_SQ) { transpose_item<0>(p.in[I_WMB], 1024, 1024, (bf16_t*)(ws + WS_WT_M), scr, r, lane); continue; } r -= I_SQ;
            transpose_item<0>(p.in[I_WOUT], 1024, 1024, (bf16_t*)(ws + WS_WT_O), scr, r, lane);
        }
        u32x4* z = (u32x4*)(ws + WS_WT_IN + (size_t)10256 * 1024 * 2);
        const int nz = 240 * 1024 * 2 / 16;
        for (int i = blockIdx.x * NTHREADS + tid; i < nz; i += G * NTHREADS) z[i] = (u32x4){0u, 0u, 0u, 0u};
    }
    for (int i = blockIdx.x * NTHREADS + tid; i < 4096; i += G * NTHREADS) {
        const int pos = i >> 6, fi = i & 63; const float freq = powf(10000.f, -((float)fi / 64.f)); const float ang = (float)pos * freq;
        ((f32x2*)(ws + WS_ROT))[i] = (f32x2){cosf(ang), sinf(ang)};
    }
    for (int i = blockIdx.x * NTHREADS + tid; i < 48 * 1024; i += G * NTHREADS) {
        const int k = i / 48, o = i - k * 48;
        ((float*)(ws + WS_WRT))[i] = (o < 4) ? p.in[I_WRG][k * 4 + o] : ((o < 36) ? p.in[I_WRE][k * 32 + (o - 4)] : 0.f);
    }
    __syncthreads();
    if ((int)blockIdx.x < 96) {
        LAS float* sl = (LAS float*)lds;
        LAS float* red = (LAS float*)(lds + 17 * 1024 * 4);
        for (int i = tid; i < 17 * 1024; i += NTHREADS) { const int r = i >> 10, k = i & 1023; const float v = (r < 16) ? p.in[I_C][r * 1024 + k] : p.in[I_CCTX][k]; sl[i] = v / (1.f + expf(-v)); }
        __syncthreads();
        for (int it = blockIdx.x; it < 96; it += G) {
            const int col = it * 64 + lane; float acc[17];
#pragma unroll
            for (int r = 0; r < 17; ++r) acc[r] = 0.f;
            const float* wp = p.in[I_WADA] + col;
#pragma unroll 1
            for (int kb = 0; kb < 8; ++kb) {
                const int k0 = wave * 128 + kb * 16; float wv[16];
#pragma unroll
                for (int kk = 0; kk < 16; ++kk) wv[kk] = wp[(size_t)(k0 + kk) * 6144];
#pragma unroll
                for (int kk = 0; kk < 16; ++kk) {
#pragma unroll
                    for (int r = 0; r < 17; ++r) acc[r] += sl[r * 1024 + k0 + kk] * wv[kk];
                    if ((kk & 3) == 3) __builtin_amdgcn_sched_barrier(0);
                }
            }
#pragma unroll
            for (int r = 0; r < 17; ++r) red[(wave * 17 + r) * 64 + lane] = acc[r];
            __syncthreads();
            for (int i = tid; i < 17 * 64; i += NTHREADS) { const int r = i >> 6, l = i & 63; float s = 0.f;
#pragma unroll
                for (int w = 0; w < 8; ++w) s += red[(w * 17 + r) * 64 + l];
                ((float*)(ws + WS_MOD))[r * 6144 + it * 64 + l] = s + p.in[I_BADA][it * 64 + l]; }
            __syncthreads();
        }
    }
}

__device__ __forceinline__ const float* p1_src(const Params& p, int R, int& mr) {
    const int b = R / TT, tt = R - b * TT;
    if (tt < TC) { mr = 16; return p.in[I_CTX] + ((size_t)b * TC + tt) * D; }
    mr = b; return p.in[I_X] + ((size_t)b * T + (tt - TC)) * D;
}
__device__ __forceinline__ void phase1(const Params& p, int wave, int lane) {
    const int gw = blockIdx.x * NWAVES + wave, NGW = gridDim.x * NWAVES;
    const float* MOD = (const float*)(p.ws + WS_MOD); bf16_t* U = (bf16_t*)(p.ws + WS_U);
    f32x4 v[4], nx[4]; int mr = 0, mrn = 0;
    if (gw < NROW) { const float* src = p1_src(p, gw, mr);
#pragma unroll
        for (int j = 0; j < 4; ++j) v[j] = ld_nt((const f32x4*)src + lane + 64 * j); }
    for (int R = gw; R < NROW; R += NGW) {
        const int Rn = R + NGW;
        if (Rn < NROW) { const float* src = p1_src(p, Rn, mrn);
#pragma unroll
            for (int j = 0; j < 4; ++j) nx[j] = ld_nt((const f32x4*)src + lane + 64 * j); }
        const float* sh = MOD + (size_t)mr * 6144; const float* sc = sh + 1024;
        float s = 0.f;
#pragma unroll
        for (int j = 0; j < 4; ++j) s += (v[j].x + v[j].y) + (v[j].z + v[j].w);
        const float mean = wave_sum(s) * (1.f / D); float s2 = 0.f;
#pragma unroll
        for (int j = 0; j < 4; ++j) { v[j] = v[j] - mean; s2 += (v[j].x * v[j].x + v[j].y * v[j].y) + (v[j].z * v[j].z + v[j].w * v[j].w); }
        const float rstd = 1.f / sqrtf(wave_sum(s2) * (1.f / D) + LN_EPS);
        u32x2* o8 = (u32x2*)(U + (size_t)R * D);
#pragma unroll
        for (int j = 0; j < 4; ++j) { const int col = 4 * lane + 256 * j; const f32x4 a = *(const f32x4*)(sh + col), m = *(const f32x4*)(sc + col);
            const f32x4 y = v[j] * rstd * (m + 1.f) + a; o8[lane + 64 * j] = (u32x2){pk2(y.x, y.y), pk2(y.z, y.w)}; }
#pragma unroll
        for (int j = 0; j < 4; ++j) v[j] = nx[j];
        mr = mrn;
    }
}

struct Unit { int pm, pn; int aofs = 0, ovl = 0, sq0 = 0, tq0 = 0, slen = 0; };
struct Gemm { const bf16_t* A; const bf16_t* Bt; int M, N, K; };
template <class Epi, class Sched>
__device__ __forceinline__ void gemm_simple(const Gemm g, const Sched& S, const Epi& E) {
    const int tid = threadIdx.x, wid = __builtin_amdgcn_readfirstlane(tid >> 6), lane = tid & 63, wr = wid >> 2, wc = wid & 3, fr = lane & 15, fq = lane >> 4;
    const int K = g.K;
    Unit u;
    for (int it = 0; S.next(it, u); ++it) {
        f32x4 acc[2][2][4][2];
#pragma unroll
        for (int a = 0; a < 2; ++a)
#pragma unroll
            for (int b = 0; b < 2; ++b)
#pragma unroll
                for (int m = 0; m < 4; ++m)
#pragma unroll
                    for (int n = 0; n < 2; ++n) acc[a][b][m][n] = (f32x4){0.f, 0.f, 0.f, 0.f};
        const bf16_t* Ab = g.A + ((size_t)u.pm * 256 + wr * 64 + fr) * K + 8 * fq;
        const bf16_t* Bb = g.Bt + ((size_t)u.pn * 256 + wc * 32 + fr) * K + 8 * fq;
        for (int k0 = 0; k0 < K; k0 += 32) {
            bf16x8 At[2][4], Bf[2][2];
#pragma unroll
            for (int a = 0; a < 2; ++a)
#pragma unroll
                for (int m = 0; m < 4; ++m) At[a][m] = *(const bf16x8*)(Ab + (size_t)(a * 128 + m * 16) * K + k0);
#pragma unroll
            for (int b = 0; b < 2; ++b)
#pragma unroll
                for (int n = 0; n < 2; ++n) Bf[b][n] = *(const bf16x8*)(Bb + (size_t)(b * 128 + n * 16) * K + k0);
#pragma unroll
            for (int a = 0; a < 2; ++a)
#pragma unroll
                for (int b = 0; b < 2; ++b)
#pragma unroll
                    for (int m = 0; m < 4; ++m)
#pragma unroll
                        for (int n = 0; n < 2; ++n) acc[a][b][m][n] = MFMA16(Bf[b][n], At[a][m], acc[a][b][m][n]);
        }
        E(acc, u, wr, wc, fr, fq);
    }
}


namespace pg8 {
#define PG8_LAS LAS
constexpr int BM = 256, BK = 64, HALF = 128, HTB = HALF * BK * 2  , STAGE_BYTES = 8 * HTB, NXCD = 8, WGM = 8;

__host__ __device__ __forceinline__ int lds_byte(int r, int c) { const int st = (r >> 4) * 2 + (c >> 5), rr = r & 15, cc = c & 31, ob = rr * 64 + cc * 2; return st * 1024 + (ob ^ (((ob >> 9) & 1) << 5)); }
__host__ __device__ __forceinline__ void stage_rc(int b, int& R, int& C) { const int st = b / 1024, sb = b % 1024, swz = sb ^ (((sb >> 9) & 1) << 5); R = (st >> 1) * 16 + swz / 64; C = (st & 1) * 32 + (swz % 64) / 2; }
__host__ __device__ __forceinline__ int perm32(int rho) { const int n = rho >> 4, i = rho & 15; return 8 * (i >> 2) + 4 * n + (i & 3); }
template <class Epi, class Sched, bool ALIGN_EPI = false, bool SP2 = false>
__device__ __forceinline__ void gemm_phase(PG8_LAS unsigned char* lds, const Gemm g, const Sched& S, const Epi& E) {
    const int tid = threadIdx.x, wid = __builtin_amdgcn_readfirstlane(tid >> 6), lane = tid & 63, wr = wid >> 2, wc = wid & 3, fr = lane & 15, fq = lane >> 4;
    const int K = g.K, nt = K / BK;
    unsigned voffA[2], voffB[2];
#pragma unroll
    for (int i = 0; i < 2; ++i) { int R, C; stage_rc(tid * 16 + i * 8192, R, C); const int Rb = Epi::PERM ? ((R & ~31) + perm32(R & 31)) : R;
        voffA[i] = (unsigned)(R * K + C) * 2u; voffB[i] = (unsigned)(Rb * K + C) * 2u; }
    const size_t kstep = (size_t)(BK * 2);
    const size_t hstep = (size_t)HALF * K * 2;
    const size_t tstep = 2 * hstep;
    const unsigned ldsw = (unsigned)wid * 1024u;
    const int aoff = lds_byte(wr * 64 + fr, fq * 8), boff = lds_byte(wc * 32 + fr, fq * 8);
#define PG8_SA(b, h) (((b) * 2 + (h)) * HTB)
#define PG8_SB(b, h) ((4 + (b) * 2 + (h)) * HTB)
#define PG8_STAGE(bufoff, gbase, voff) do { _Pragma("unroll") for (int _i = 0; _i < 2; ++_i) \
        __builtin_amdgcn_global_load_lds((const unsigned*)((const char*)(gbase) + (voff)[_i]), (PG8_LAS unsigned*)(lds + (bufoff) + ldsw + _i * 8192), 16, 0, 0); } while (0)
#define PG8_LDA(dst, b, h) do { _Pragma("unroll") for (int m = 0; m < 4; ++m) _Pragma("unroll") for (int k = 0; k < 2; ++k) dst[m][k] = *(const PG8_LAS bf16x8*)(lds + PG8_SA(b, h) + aoff + m * 2048 + k * 1024); } while (0)
#define PG8_LDB(dst, b, h) do { _Pragma("unroll") for (int n = 0; n < 2; ++n) _Pragma("unroll") for (int k = 0; k < 2; ++k) dst[n][k] = *(const PG8_LAS bf16x8*)(lds + PG8_SB(b, h) + boff + n * 2048 + k * 1024); } while (0)
#define PG8_MMA(ai, bj, At, Bt) do { __builtin_amdgcn_s_setprio(1); _Pragma("unroll") for (int m = 0; m < 4; ++m) _Pragma("unroll") for (int n = 0; n < 2; ++n) _Pragma("unroll") for (int k = 0; k < 2; ++k) \
        acc[ai][bj][m][n] = __builtin_amdgcn_mfma_f32_16x16x32_bf16(Bt[n][k], At[m][k], acc[ai][bj][m][n], 0, 0, 0); __builtin_amdgcn_s_setprio(0); } while (0)
#define PG8_WAIT_V(n) asm volatile("s_waitcnt vmcnt(" #n ")" ::: "memory")
#define PG8_WAIT_L(n) asm volatile("s_waitcnt lgkmcnt(" #n ")" ::: "memory")
#define PG8_BAR __builtin_amdgcn_s_barrier()
#define PG8_SCHED __builtin_amdgcn_sched_barrier(0)
    Unit cur, nxt; int ui = 0;
    if (!S.next(0, cur)) return;
    f32x4 acc[2][2][4][2];
#pragma unroll
    for (int a = 0; a < 2; ++a)
#pragma unroll
        for (int b = 0; b < 2; ++b)
#pragma unroll
            for (int m = 0; m < 4; ++m)
#pragma unroll
                for (int n = 0; n < 2; ++n) acc[a][b][m][n] = (f32x4){0.f, 0.f, 0.f, 0.f};
    bf16x8 At[4][2], B0[2][2], B1[2][2];
    const char* cA = (const char*)g.A + (ptrdiff_t)cur.pm * (ptrdiff_t)tstep + (ptrdiff_t)cur.aofs * (ptrdiff_t)(g.K * 2); const char* cB = (const char*)g.Bt + (size_t)cur.pn * tstep;
    S.a_ready(cur);
    if constexpr (SP2) {
        PG8_STAGE(PG8_SB(0, 0), cB, voffB); PG8_STAGE(PG8_SB(0, 1), cB + hstep, voffB); PG8_STAGE(PG8_SA(0, 0), cA, voffA); PG8_STAGE(PG8_SA(0, 1), cA + hstep, voffA);
        if (wr == 1) PG8_BAR;
        PG8_WAIT_V(2); PG8_BAR;
        PG8_STAGE(PG8_SB(1, 0), cB + kstep, voffB); PG8_STAGE(PG8_SA(1, 0), cA + kstep, voffA); PG8_STAGE(PG8_SB(1, 1), cB + hstep + kstep, voffB);
        PG8_WAIT_V(6); PG8_BAR;
    } else {
        PG8_STAGE(PG8_SB(0, 0), cB, voffB); PG8_STAGE(PG8_SA(0, 0), cA, voffA); PG8_STAGE(PG8_SB(0, 1), cB + hstep, voffB); PG8_STAGE(PG8_SA(0, 1), cA + hstep, voffA);
        if (wr == 1) PG8_BAR;
        PG8_WAIT_V(4); PG8_BAR;
        PG8_STAGE(PG8_SB(1, 0), cB + kstep, voffB); PG8_STAGE(PG8_SA(1, 0), cA + kstep, voffA); PG8_STAGE(PG8_SB(1, 1), cB + hstep + kstep, voffB);
        PG8_WAIT_V(6); PG8_BAR;
    }
    for (;;) {
        const bool has_next = S.next(ui + 1, nxt);
        const char* nA = has_next ? (const char*)g.A + (ptrdiff_t)nxt.pm * (ptrdiff_t)tstep + (ptrdiff_t)nxt.aofs * (ptrdiff_t)(g.K * 2) : cA; const char* nB = has_next ? (const char*)g.Bt + (size_t)nxt.pn * tstep : cB;
        for (int t = 0; t < nt; t += 2) {
            const bool last = (t == nt - 2);
            const char* a1 = cA + (size_t)(t + 1) * kstep;
            const char* a2 = last ? nA : cA + (size_t)(t + 2) * kstep; const char* b2 = last ? nB : cB + (size_t)(t + 2) * kstep;
            const char* a3 = a2 + kstep; const char* b3 = b2 + kstep;
            if (last && has_next) S.a_ready(nxt);
            if constexpr (SP2) {
            PG8_LDB(B0, 0, 0); PG8_LDB(B1, 0, 1); PG8_SCHED; PG8_LDA(At, 0, 0); PG8_STAGE(PG8_SA(1, 1), a1 + hstep, voffA);
            PG8_WAIT_V(8); PG8_WAIT_L(0); PG8_BAR; PG8_MMA(0, 0, At, B0); PG8_MMA(0, 1, At, B1); PG8_BAR; PG8_SCHED;
            PG8_LDA(At, 0, 1); PG8_STAGE(PG8_SB(0, 0), b2, voffB); PG8_STAGE(PG8_SB(0, 1), b2 + hstep, voffB); PG8_STAGE(PG8_SA(0, 0), a2, voffA);
            PG8_WAIT_V(8); PG8_WAIT_L(0); PG8_BAR; PG8_MMA(1, 0, At, B0); PG8_MMA(1, 1, At, B1); PG8_BAR; PG8_SCHED;
            PG8_LDB(B0, 1, 0); PG8_LDB(B1, 1, 1); PG8_SCHED; PG8_LDA(At, 1, 0); PG8_STAGE(PG8_SA(0, 1), a2 + hstep, voffA);
            PG8_WAIT_V(8); PG8_WAIT_L(0); PG8_BAR; PG8_MMA(0, 0, At, B0); PG8_MMA(0, 1, At, B1); PG8_BAR; PG8_SCHED;
            PG8_LDA(At, 1, 1); PG8_STAGE(PG8_SB(1, 0), b3, voffB); PG8_STAGE(PG8_SB(1, 1), b3 + hstep, voffB); PG8_STAGE(PG8_SA(1, 0), a3, voffA);
            PG8_WAIT_V(8); PG8_WAIT_L(0); PG8_BAR; PG8_MMA(1, 0, At, B0); PG8_MMA(1, 1, At, B1); PG8_BAR; PG8_SCHED;
            } else {
            PG8_LDB(B0, 0, 0); PG8_SCHED; PG8_LDA(At, 0, 0); PG8_STAGE(PG8_SA(1, 1), a1 + hstep, voffA);
            PG8_WAIT_L(8); PG8_BAR; PG8_WAIT_L(0); PG8_MMA(0, 0, At, B0); PG8_BAR; PG8_SCHED;
            PG8_LDB(B1, 0, 1); PG8_STAGE(PG8_SB(0, 0), b2, voffB);
            PG8_BAR; PG8_WAIT_L(0); PG8_MMA(0, 1, At, B1); PG8_BAR;
            PG8_LDA(At, 0, 1); PG8_STAGE(PG8_SA(0, 0), a2, voffA);
            PG8_BAR; PG8_WAIT_L(0); PG8_MMA(1, 0, At, B0); PG8_BAR; PG8_SCHED;
            PG8_STAGE(PG8_SB(0, 1), b2 + hstep, voffB);
            PG8_WAIT_V(6); PG8_BAR; PG8_MMA(1, 1, At, B1); PG8_BAR;
            PG8_LDB(B0, 1, 0); PG8_SCHED; PG8_LDA(At, 1, 0); PG8_STAGE(PG8_SA(0, 1), a2 + hstep, voffA);
            PG8_WAIT_L(8); PG8_BAR; PG8_WAIT_L(0); PG8_MMA(0, 0, At, B0); PG8_BAR; PG8_SCHED;
            PG8_LDB(B1, 1, 1); PG8_STAGE(PG8_SB(1, 0), b3, voffB);
            PG8_BAR; PG8_WAIT_L(0); PG8_MMA(0, 1, At, B1); PG8_BAR;
            PG8_LDA(At, 1, 1); PG8_STAGE(PG8_SA(1, 0), a3, voffA);
            PG8_BAR; PG8_WAIT_L(0); PG8_MMA(1, 0, At, B0); PG8_BAR; PG8_SCHED;
            PG8_STAGE(PG8_SB(1, 1), b3 + hstep, voffB);
            PG8_WAIT_V(6); PG8_BAR; PG8_MMA(1, 1, At, B1); PG8_BAR;
            }
        }
        if constexpr (ALIGN_EPI) { if (wr == 0) PG8_BAR; }
        if constexpr (!Epi::AFTER_DRAIN) { E(acc, cur, wr, wc, fr, fq); S.done(cur); }
        if (!has_next) break;
#pragma unroll
        for (int a = 0; a < 2; ++a)
#pragma unroll
            for (int b = 0; b < 2; ++b)
#pragma unroll
                for (int m = 0; m < 4; ++m)
#pragma unroll
                    for (int n = 0; n < 2; ++n) acc[a][b][m][n] = (f32x4){0.f, 0.f, 0.f, 0.f};
        cur = nxt; cA = nA; cB = nB; ++ui;
        if constexpr (ALIGN_EPI) { if (wr == 1) PG8_BAR; }
    }
    PG8_WAIT_V(0);
    if constexpr (!ALIGN_EPI) { if (wr == 0) PG8_BAR; }
    PG8_BAR;
    if constexpr (Epi::AFTER_DRAIN) { E.fused(acc, cur, wr, wc, fr, fq, lds, wid, lane); S.done(cur); }
#undef PG8_SA
#undef PG8_SB
#undef PG8_STAGE
#undef PG8_LDA
#undef PG8_LDB
#undef PG8_MMA
#undef PG8_WAIT_V
#undef PG8_WAIT_L
#undef PG8_BAR
#undef PG8_SCHED
}
}

template <int PH> struct SchedProj {
    int G, c, rep;
    __device__ __forceinline__ void a_ready(const Unit&) const {}
    __device__ __forceinline__ void done(const Unit&) const {}
    static __device__ __forceinline__ int nlat() { return PH == 0 ? 12 : (PH == 1 ? 13 : 16); }
    static __device__ __forceinline__ int nctx() { return PH == 0 ? 8 : (PH == 1 ? 9 : 0); }
    __device__ __forceinline__ bool next(int i, Unit& u) const {
        const int x = c & 7, y = c >> 3, nxc = G >> 3;
        int q = i * nxc + y;
        u.aofs = 0; u.ovl = 0; u.sq0 = 0; u.tq0 = 0; u.slen = 0;
        if (PH == 1) {
            constexpr int UA = 144, UB = 80, UC = 16, UD = 10, ntot = UA + UB + UC + UD;
            if (q >= rep * ntot) return false;
            q %= ntot;
            if (q < UB) { const int grp = q / 20, rem = q - grp * 20, idx = rem >> 2, pmi = x + 8 * (grp * 4 + (rem & 3)); u.pm = (pmi >> 3) * 9 + 1 + (pmi & 7); u.pn = (idx < 4) ? 24 + idx : 40; return true; }
            q -= UB;
            if (q < UD) { const int bsel = q / 5, idx = q - bsel * 5; u.pm = (x + 8 * bsel) * 9; u.pn = (idx < 4) ? 24 + idx : 40; return true; }
            q -= UD;
            if (q < UA) { const int k = (q >> 4) * 2 + (q & 1), pi = (q & 15) >> 1, tau = x + 8 * k, b = tau / 9, j = tau - b * 9;
                u.pm = 0; u.pn = 16 + pi; u.ovl = 1; u.sq0 = b * TT + TC; u.tq0 = 254 * j - 1; u.slen = T; u.aofs = u.sq0 + u.tq0; return true; }
            q -= UA;
            { const int tau = x + 8 * (q & 3), pi = q >> 2, b = tau >> 1, j = tau & 1;
                u.pm = 0; u.pn = 20 + pi; u.ovl = 1; u.sq0 = b * TT; u.tq0 = 254 * j - 1; u.slen = TC; u.aofs = u.sq0 + u.tq0; return true; }
        }
        const int nl = 16 * nlat(), ntot = nl + 2 * nctx();
        if (q >= rep * ntot) return false;
        q %= ntot;
        int idx;
        if (q < nl) { const int grp = q / (4 * nlat()), rem = q - grp * 4 * nlat(); idx = rem >> 2; const int pmi = x + 8 * (grp * 4 + (rem & 3)); u.pm = (pmi >> 3) * 9 + 1 + (pmi & 7);
            if (PH == 0) u.pn = idx; else u.pn = (idx < 4) ? 12 + idx : 24 + idx;
            return true; }
        q -= nl; const int bsel = q / (nctx() > 0 ? nctx() : 1); idx = q - bsel * nctx(); u.pm = (x + 8 * bsel) * 9;
        u.pn = 4 + idx;
        return true;
    }
};
struct EpiProj {
    static constexpr bool PERM = true, AFTER_DRAIN = false;
    unsigned char* ws; const float* b_mgate; LAS unsigned char* lds; const float* cw; const float* cb; int pn_lds = -1;
    template <int CTRL> static __device__ __forceinline__ float dpp_f(float v) { return __builtin_bit_cast(float, __builtin_amdgcn_update_dpp(0, __builtin_bit_cast(int, v), CTRL, 0xF, 0xF, true)); }
    __device__ __forceinline__ void operator()(const f32x4 (&acc)[2][2][4][2], const Unit& u, int wr, int wc, int fr, int fq) const {
        const int pn = u.pn;
        if (u.ovl) {
            const int blk = pn >> 2, h = pn & 3; int cw0 = wc * 32 + 8 * fq;
            asm volatile("" : "+v"(cw0));
            LAS float* XB = (LAS float*)(lds + 131072);
#pragma unroll
            for (int ai = 0; ai < 2; ++ai) { const int gm = 2 * ai + wr;
                if (fr == 0) {
#pragma unroll
                    for (int bj = 0; bj < 2; ++bj) { LAS f32x4* d = (LAS f32x4*)(XB + (gm * 2 + 0) * 256 + bj * 128 + cw0); d[0] = acc[ai][bj][0][0]; d[1] = acc[ai][bj][0][1]; } }
                if (fr == 15) {
#pragma unroll
                    for (int bj = 0; bj < 2; ++bj) { LAS f32x4* d = (LAS f32x4*)(XB + (gm * 2 + 1) * 256 + bj * 128 + cw0); d[0] = acc[ai][bj][3][0]; d[1] = acc[ai][bj][3][1]; } } }
            asm volatile("s_waitcnt lgkmcnt(0)\n\ts_barrier" ::: "memory");
            bf16_t* dst = (bf16_t*)(ws + (blk == 4 ? WS_MQ : WS_MK));
            const float scl = (blk == 5) ? 0.0625f : 1.f, nl2e = (blk == 5) ? -16.f * 1.4426950408889634f : -1.4426950408889634f;
#pragma unroll
            for (int bj = 0; bj < 2; ++bj) {
                const int cg = (blk - 4) * 1024 + h * 256 + bj * 128 + cw0;
                f32x4 w0[2], w1[2], w2[2], bs[2];
                if (pn == pn_lds) {
                    LAS const float* WL = (LAS const float*)(lds + 139264) + bj * 128 + cw0;
#pragma unroll
                    for (int n = 0; n < 2; ++n) { w0[n] = *(LAS const f32x4*)(WL + 4 * n); w1[n] = *(LAS const f32x4*)(WL + 256 + 4 * n); w2[n] = *(LAS const f32x4*)(WL + 512 + 4 * n); bs[n] = *(LAS const f32x4*)(WL + 768 + 4 * n); }
                } else {
#pragma unroll
                    for (int n = 0; n < 2; ++n) { w0[n] = *(const f32x4*)(cw + cg + 4 * n) * scl; w1[n] = *(const f32x4*)(cw + 2048 + cg + 4 * n) * scl; w2[n] = *(const f32x4*)(cw + 4096 + cg + 4 * n) * scl; bs[n] = *(const f32x4*)(cb + cg + 4 * n) * scl; }
                }
#pragma unroll
                for (int ai = 0; ai < 2; ++ai) { const int gm = 2 * ai + wr;
#pragma unroll
                    for (int m = 0; m < 4; ++m) {
                        __builtin_amdgcn_sched_barrier(0);
                        const int rho = 128 * ai + 64 * wr + 16 * m + fr, t = u.tq0 + rho;
                        f32x4 hx[2];
                        if (m == 0) { hx[0] = *(LAS const f32x4*)(XB + ((gm > 0 ? gm - 1 : 0) * 2 + 1) * 256 + bj * 128 + cw0); hx[1] = *(LAS const f32x4*)(XB + ((gm > 0 ? gm - 1 : 0) * 2 + 1) * 256 + bj * 128 + cw0 + 4); }
                        if (m == 3) { hx[0] = *(LAS const f32x4*)(XB + ((gm < 3 ? gm + 1 : 3) * 2 + 0) * 256 + bj * 128 + cw0); hx[1] = *(LAS const f32x4*)(XB + ((gm < 3 ? gm + 1 : 3) * 2 + 0) * 256 + bj * 128 + cw0 + 4); }
                        unsigned pk[4];
#pragma unroll
                        for (int kp = 0; kp < 4; ++kp) { const int n = kp >> 1, j0 = (2 * kp) & 3;
                            f32x2 cur, pv, nv;
#pragma unroll
                            for (int jj = 0; jj < 2; ++jj) { const int j = j0 + jj;
                                const float cu = acc[ai][bj][m][n][j];
                                float xs = (fr == 15) ? (m == 0 ? hx[n][j] : acc[ai][bj][m > 0 ? m - 1 : 0][n][j]) : cu;
                                float ys = (fr == 0) ? (m == 3 ? hx[n][j] : acc[ai][bj][m < 3 ? m + 1 : 3][n][j]) : cu;
                                if (ai == 0 && m <= 1) { if (t == -1) xs = 0.f; if (t == u.slen) ys = 0.f; }
                                cur[jj] = cu; pv[jj] = dpp_f<0x121>(xs); nv[jj] = dpp_f<0x12F>(ys); }
                            const f32x2 a0 = {w0[n][j0], w0[n][j0 + 1]}, a1 = {w1[n][j0], w1[n][j0 + 1]}, a2 = {w2[n][j0], w2[n][j0 + 1]}, ab = {bs[n][j0], bs[n][j0 + 1]};
                            f32x2 z = __builtin_elementwise_fma(a1, cur, ab);
                            z = __builtin_elementwise_fma(a0, pv, z);
                            z = __builtin_elementwise_fma(a2, nv, z);
                            const f32x2 ez = z * nl2e;
                            f32x2 den = {__builtin_amdgcn_exp2f(ez[0]), __builtin_amdgcn_exp2f(ez[1])};
                            den = den + 1.f;
                            const f32x2 rc = {__builtin_amdgcn_rcpf(den[0]), __builtin_amdgcn_rcpf(den[1])};
                            const f32x2 o = z * rc;
                            pk[kp] = pk2(o[0], o[1]);
                        }
                        if (rho >= 1 && rho <= 254 && t < u.slen) *(u32x4*)(dst + (size_t)(u.sq0 + t) * D + h * 256 + bj * 128 + cw0) = (u32x4){pk[0], pk[1], pk[2], pk[3]};
                    }
                }
            }
            return;
        }
        if (pn == 40) {
            if (wc != 0 || fq >= 2) return;
            float* Gt = (float*)(ws + WS_G);
#pragma unroll
            for (int ai = 0; ai < 2; ++ai)
#pragma unroll
                for (int m = 0; m < 4; ++m) { const int r = u.pm * 256 + ai * 128 + wr * 64 + m * 16 + fr, b = r / TT, tt = r - b * TT;
#pragma unroll
                    for (int k = 0; k < 8; ++k) { const int c = 8 * fq + k; float v = acc[ai][0][m][k >> 2][k & 3] + b_mgate[c]; if ((c >> 2) & 1) v = logsigmoid_f(v);
                        Gt[((size_t)b * 16 + c) * TT + tt] = v; } }
            return;
        }
        const int blk = pn >> 2, h = pn & 3;
        if (blk < 2) {
            bf16_t* dst = (bf16_t*)(ws + (blk == 0 ? WS_RQ : WS_RK));
            const float* ROT = (const float*)(ws + WS_ROT);
            const float scl = (blk == 1) ? 0.0625f : 1.f;
            const int q = wc * 32 + 8 * fq, hb = q >> 6, i0 = q & 63;
#pragma unroll
            for (int ai = 0; ai < 2; ++ai)
#pragma unroll
                for (int m = 0; m < 4; ++m) { const int r = u.pm * 256 + ai * 128 + wr * 64 + m * 16 + fr, b = r / TT, tt = r - b * TT; const bool lat = tt >= TC; const int t = tt - TC;
                    float o1[8], o2[8];
                    if (lat) { const int pos = hb ? (t & 63) : (t >> 6); const f32x4* rp = (const f32x4*)(ROT + (size_t)(pos * 64 + i0) * 2);
#pragma unroll
                        for (int k2 = 0; k2 < 4; ++k2) { const f32x4 cs = rp[k2];
                            const float a0 = acc[ai][0][m][k2 >> 1][(2 * k2) & 3], a1 = acc[ai][0][m][k2 >> 1][(2 * k2 + 1) & 3], b0 = acc[ai][1][m][k2 >> 1][(2 * k2) & 3], b1 = acc[ai][1][m][k2 >> 1][(2 * k2 + 1) & 3];
                            o1[2 * k2] = a0 * cs[0] - b0 * cs[1]; o2[2 * k2] = a0 * cs[1] + b0 * cs[0]; o1[2 * k2 + 1] = a1 * cs[2] - b1 * cs[3]; o2[2 * k2 + 1] = a1 * cs[3] + b1 * cs[2]; } }
                    else {
#pragma unroll
                        for (int k = 0; k < 8; ++k) { o1[k] = acc[ai][0][m][k >> 2][k & 3]; o2[k] = acc[ai][1][m][k >> 2][k & 3]; } }
                    bf16_t* rowp = dst + (size_t)r * D + h * 256 + q;
                    *(u32x4*)(rowp) = (u32x4){pk2(o1[0] * scl, o1[1] * scl), pk2(o1[2] * scl, o1[3] * scl), pk2(o1[4] * scl, o1[5] * scl), pk2(o1[6] * scl, o1[7] * scl)};
                    *(u32x4*)(rowp + 128) = (u32x4){pk2(o2[0] * scl, o2[1] * scl), pk2(o2[2] * scl, o2[3] * scl), pk2(o2[4] * scl, o2[5] * scl), pk2(o2[6] * scl, o2[7] * scl)}; }
            return;
        }
        if (blk == 2 || blk == 6) {
            bf16_t* dst = (bf16_t*)(ws + (blk == 2 ? WS_RVT : WS_MVT));
#pragma unroll
            for (int ai = 0; ai < 2; ++ai)
#pragma unroll
                for (int m = 0; m < 4; ++m) { const int r = u.pm * 256 + ai * 128 + wr * 64 + m * 16 + fr, b = r / TT, tt = r - b * TT;
                    bf16_t* bp = dst + ((size_t)(b * 4 + h) * 256) * TT + tt;
#pragma unroll
                    for (int bj = 0; bj < 2; ++bj)
#pragma unroll
                        for (int k = 0; k < 8; ++k) { const int e = bj * 128 + wc * 32 + 8 * fq + k; bp[(size_t)e * TT] = f2bf(acc[ai][bj][m][k >> 2][k & 3]); } }
            return;
        }
        if (blk == 4 || blk == 5) {
            bf16_t* dst = (bf16_t*)(ws + (blk == 4 ? WS_MQRAW : WS_MKRAW));
#pragma unroll
            for (int ai = 0; ai < 2; ++ai)
#pragma unroll
                for (int m = 0; m < 4; ++m) { const int r = u.pm * 256 + ai * 128 + wr * 64 + m * 16 + fr;
#pragma unroll
                    for (int bj = 0; bj < 2; ++bj) { const f32x4 v0 = acc[ai][bj][m][0], v1 = acc[ai][bj][m][1]; const int c = h * 256 + bj * 128 + wc * 32 + 8 * fq;
                        *(u32x4*)(dst + (size_t)r * D + c) = (u32x4){pk2(v0[0], v0[1]), pk2(v0[2], v0[3]), pk2(v1[0], v1[1]), pk2(v1[2], v1[3])}; } }
            return;
        }
        {
            bf16_t* dst = (bf16_t*)(ws + (blk == 3 ? WS_RGA : (blk == 7 ? WS_MOA : (blk == 8 ? WS_GRA : WS_GMA))));
#pragma unroll
            for (int ai = 0; ai < 2; ++ai)
#pragma unroll
                for (int m = 0; m < 4; ++m) { const int r = u.pm * 256 + ai * 128 + wr * 64 + m * 16 + fr, b = r / TT, tt = r - b * TT; const int rl = b * T + (tt - TC);
#pragma unroll
                    for (int bj = 0; bj < 2; ++bj) { f32x4 v0 = acc[ai][bj][m][0], v1 = acc[ai][bj][m][1]; const int c = h * 256 + bj * 128 + wc * 32 + 8 * fq;
                        if (blk >= 8) { _Pragma("unroll") for (int j = 0; j < 4; ++j) { v0[j] = sigmoid_f(v0[j]); v1[j] = sigmoid_f(v1[j]); } }
                        if (tt >= TC) *(u32x4*)(dst + (size_t)rl * D + c) = (u32x4){pk2(v0[0], v0[1]), pk2(v0[2], v0[3]), pk2(v1[0], v1[1]), pk2(v1[2], v1[3])}; } }
        }
    }
};

__device__ __forceinline__ void phase_conv(const Params& p, int tid) {
    const bf16_t* QR = (const bf16_t*)(p.ws + WS_MQRAW); const bf16_t* KR = (const bf16_t*)(p.ws + WS_MKRAW);
    bf16_t* QO = (bf16_t*)(p.ws + WS_MQ); bf16_t* KO = (bf16_t*)(p.ws + WS_MK);
    const float* cw = p.in[I_CONVW]; const float* cb = p.in[I_CONVB];
    const int gt = blockIdx.x * NTHREADS + tid, nthr = gridDim.x * NTHREADS, ch = gt & 127;
    constexpr int NGRP = NROW / 8;
#pragma unroll 1
    for (int which = 0; which < 2; ++which) {
        const int c0 = which * 1024 + ch * 8; const float scl = which ? 0.0625f : 1.f;
        float w0[8], w1[8], w2[8], bs[8];
#pragma unroll
        for (int j = 0; j < 8; ++j) { w0[j] = cw[c0 + j]; w1[j] = cw[2048 + c0 + j]; w2[j] = cw[4096 + c0 + j]; bs[j] = cb[c0 + j]; }
        const bf16_t* srcb = (which ? KR : QR) + ch * 8; bf16_t* dstb = (which ? KO : QO) + ch * 8;
        for (int g = gt >> 7; g < NGRP; g += nthr >> 7) {
            const int R0 = g * 8, tt = R0 % TT;
            if (which == 0 && tt < TC) continue;
            const bool hasp = !(tt == 0 || tt == TC), hasn = !(tt + 7 == TC - 1 || tt + 7 == TT - 1);
            u32x4 rw[10];
            rw[0] = hasp ? ld_nt((const u32x4*)(srcb + (size_t)(R0 - 1) * D)) : (u32x4){0u, 0u, 0u, 0u};
#pragma unroll
            for (int i = 0; i < 8; ++i) rw[1 + i] = ld_nt((const u32x4*)(srcb + (size_t)(R0 + i) * D));
            rw[9] = hasn ? ld_nt((const u32x4*)(srcb + (size_t)(R0 + 8) * D)) : (u32x4){0u, 0u, 0u, 0u};
#pragma unroll
            for (int i = 0; i < 8; ++i) {
                float o[8];
#pragma unroll
                for (int j = 0; j < 4; ++j) {
                    const float a = w0[2 * j] * bflo(rw[i][j]) + w1[2 * j] * bflo(rw[i + 1][j]) + w2[2 * j] * bflo(rw[i + 2][j]) + bs[2 * j];
                    const float c = w0[2 * j + 1] * bfhi(rw[i][j]) + w1[2 * j + 1] * bfhi(rw[i + 1][j]) + w2[2 * j + 1] * bfhi(rw[i + 2][j]) + bs[2 * j + 1];
                    o[2 * j] = silu_f(a) * scl; o[2 * j + 1] = silu_f(c) * scl;
                }
                *(u32x4*)(dstb + (size_t)(R0 + i) * D) = (u32x4){pk2(o[0], o[1]), pk2(o[2], o[3]), pk2(o[4], o[5]), pk2(o[6], o[7])};
            }
        }
    }
}

struct ScanArgs { const bf16_t* Q; const bf16_t* K; const bf16_t* VT; const float* G; const float* decay; bf16_t* Of; bf16_t* Ob; int is_ml; };
constexpr int SC_S = 0;
constexpr int SC_ATT = 131072;
constexpr int ATT_LD = 72;
constexpr int SC_VEC = SC_ATT + 64 * ATT_LD * 2;
__device__ __forceinline__ void scan_phase(LAS unsigned char* lds, const ScanArgs a, int tid, int wave, int lane) {
    LAS float* Sm = (LAS float*)(lds + SC_S);
    LAS bf16_t* att = (LAS bf16_t*)(lds + SC_ATT);
    LAS float* vec = (LAS float*)(lds + SC_VEC);
    LAS float* rowv = vec, *colv = vec + 64, *aq = vec + 128, *kd = vec + 192, *emr = vec + 256, *cv = vec + 320, *av = vec + 384, *mxv = vec + 448, *qn = vec + 512, *denp = vec + 576, *nv = vec + 832, *scal = vec + 1088;
    const int fr = lane & 15, fq = lane >> 4;
    for (int item = blockIdx.x; item < 256; item += gridDim.x) {
        const int eh = item & 1, dir = (item >> 1) & 1, h = (item >> 2) & 3, b = item >> 4;
        __syncthreads();
        for (int i = tid; i < 256 * 128; i += NTHREADS) Sm[i] = 0.f;
        if (tid < 256) nv[tid] = 0.f;
        if (tid == 0) { scal[0] = 0.f;   scal[1] = 1.f;   }
        const float lg = a.is_ml ? 0.f : logsigmoid_f(a.decay[dir * 4 + h]);
        const float* Gi = a.G + ((size_t)b * 16 + (dir ? 8 : 0) + h) * TT;
        const float* Gf = a.G + ((size_t)b * 16 + (dir ? 12 : 4) + h) * TT;
        bf16_t* Oo = dir ? a.Ob : a.Of;
        __syncthreads();
        for (int st = 0; st < 36; ++st) {
            int tt0;
            if (st < 4) tt0 = (dir ? (3 - st) : st) * CH; else tt0 = TC + (dir ? (35 - st) : (st - 4)) * CH;
            const bool lat = st >= 4;
            const size_t R0 = (size_t)b * TT + tt0;
            if (a.is_ml) {
                if (tid == 0) {
                    const float mst = scal[0];
                    float run = 0.f;
                    if (dir == 0) { for (int l = 0; l < CH; ++l) { run += Gf[tt0 + l]; cv[l] = run; } }
                    else { for (int l = CH - 1; l >= 0; --l) { run += Gf[tt0 + l]; cv[l] = run; } }
                    const float ctot = run;
                    float mxr = -1e30f;
                    if (dir == 0) { for (int l = 0; l < CH; ++l) { const float x = Gi[tt0 + l] - cv[l]; av[l] = x; mxr = fmaxf(mxr, x); mxv[l] = mxr; } }
                    else { for (int l = CH - 1; l >= 0; --l) { mxv[l] = mxr; const float x = Gi[tt0 + l] - cv[l]; av[l] = x; mxr = fmaxf(mxr, x); } }
                    const float mnew = fmaxf(ctot + mst, ctot + mxr);
                    scal[1] = expf(ctot + mst - mnew); scal[2] = ctot; scal[3] = mnew; scal[4] = mst;
                }
                __syncthreads();
                if (tid < CH) { const int l = tid; const float mst = scal[4], ctot = scal[2], mnew = scal[3];
                    const float mrow = fmaxf(cv[l] + mxv[l], cv[l] + mst);
                    rowv[l] = cv[l] - mrow; colv[l] = av[l]; aq[l] = expf(cv[l] + mst - mrow); emr[l] = expf(-mrow); kd[l] = expf(ctot + av[l] - mnew); }
                if (tid == 0) scal[0] = scal[3];
            } else {
                if (tid < CH) { const int l = tid;
                    rowv[l] = (dir ? -(float)l : (float)l) * lg; colv[l] = (dir ? (float)l : -(float)l) * lg;
                    aq[l] = expf((float)(dir ? (CH - l) : (l + 1)) * lg); kd[l] = expf((float)(dir ? l : (CH - 1 - l)) * lg); emr[l] = 0.f; }
                if (tid == 0) scal[1] = expf((float)CH * lg);
            }
            __syncthreads();
            if (lat) {
#pragma unroll
                for (int tq = 0; tq < 2; ++tq) {
                    const int ti = wave * 2 + tq, lt = ti >> 2, mt = ti & 3, l0 = lt * 16, m0 = mt * 16;
                    f32x4 acc = (f32x4){0.f, 0.f, 0.f, 0.f};
                    const bf16_t* kp = a.K + (R0 + m0 + fr) * D + h * 256 + 8 * fq;
                    const bf16_t* qp = a.Q + (R0 + l0 + fr) * D + h * 256 + 8 * fq;
#pragma unroll
                    for (int d0 = 0; d0 < 256; d0 += 32) { const bf16x8 ka = *(const bf16x8*)(kp + d0), qb = *(const bf16x8*)(qp + d0); acc = MFMA16(ka, qb, acc); }
                    const int l = l0 + fr; const float rv = rowv[l]; float o[4]; float s = 0.f;
#pragma unroll
                    for (int r = 0; r < 4; ++r) { const int m = m0 + 4 * fq + r; const bool ok = dir ? (m > l) : (m <= l); const float w = ok ? __expf(rv + colv[m]) : 0.f; o[r] = acc[r] * w; s += o[r]; }
                    *(LAS u32x2*)(att + l * ATT_LD + m0 + 4 * fq) = (u32x2){pk2(o[0], o[1]), pk2(o[2], o[3])};
                    s += __shfl_xor(s, 16); s += __shfl_xor(s, 32);
                    if (fq == 0) denp[l * 4 + mt] = s;
                }
                if (a.is_ml && tid < CH) { const int l = tid; const bf16_t* qp = a.Q + (R0 + l) * D + h * 256; float s = 0.f;
                    for (int d = 0; d < 256; d += 8) { const u32x4 w = *(const u32x4*)(qp + d);
#pragma unroll
                        for (int j = 0; j < 4; ++j) s += bflo(w[j]) * nv[d + 2 * j] + bfhi(w[j]) * nv[d + 2 * j + 1]; }
                    qn[l] = s; }
            }
            __syncthreads();
            {
                const int ew = wave * 16; const float cdec = scal[1];
                const bf16_t* vp = a.VT + ((size_t)(b * 4 + h) * 256 + eh * 128 + ew + fr) * TT + tt0 + 8 * fq;
                const bf16x8 vf0 = *(const bf16x8*)(vp), vf1 = *(const bf16x8*)(vp + 32);
                if (lat) {
                    const int t0 = tt0 - TC;
#pragma unroll 1
                    for (int lt = 0; lt < 4; ++lt) {
                        f32x4 acc = (f32x4){0.f, 0.f, 0.f, 0.f};
                        const bf16_t* qp = a.Q + (R0 + lt * 16 + fr) * D + h * 256 + 8 * fq;
#pragma unroll
                        for (int d0 = 0; d0 < 256; d0 += 32) {
                            const bf16x8 qa = *(const bf16x8*)(qp + d0);
                            const LAS float* sp = Sm + (d0 + 8 * fq) * 128 + ew + fr;
                            u32x4 sb; sb.x = pk2(sp[0], sp[128]); sb.y = pk2(sp[256], sp[384]); sb.z = pk2(sp[512], sp[640]); sb.w = pk2(sp[768], sp[896]);
                            acc = MFMA16(qa, __builtin_bit_cast(bf16x8, sb), acc);
                        }
                        float hs[4];
#pragma unroll
                        for (int r = 0; r < 4; ++r) { const int l = lt * 16 + 4 * fq + r; acc[r] *= aq[l];
                            if (a.is_ml) { const float den = (denp[l * 4] + denp[l * 4 + 1]) + (denp[l * 4 + 2] + denp[l * 4 + 3]) + aq[l] * qn[l]; hs[r] = 1.f / fmaxf(fabsf(den), emr[l]); } else hs[r] = 1.f; }
                        const bf16x8 a0 = *(const LAS bf16x8*)(att + (lt * 16 + fr) * ATT_LD + 8 * fq), a1 = *(const LAS bf16x8*)(att + (lt * 16 + fr) * ATT_LD + 32 + 8 * fq);
                        acc = MFMA16(a0, vf0, acc); acc = MFMA16(a1, vf1, acc);
#pragma unroll
                        for (int r = 0; r < 4; ++r) { const int l = lt * 16 + 4 * fq + r; Oo[((size_t)b * T + t0 + l) * D + h * 256 + eh * 128 + ew + fr] = f2bf(acc[r] * hs[r]); }
                    }
                }
#pragma unroll 1
                for (int dt = 0; dt < 16; ++dt) {
                    const int d0 = dt * 16;
                    LAS float* sp = Sm + (d0 + 4 * fq) * 128 + ew + fr;
                    f32x4 acc; acc[0] = sp[0] * cdec; acc[1] = sp[128] * cdec; acc[2] = sp[256] * cdec; acc[3] = sp[384] * cdec;
#pragma unroll
                    for (int ks = 0; ks < 2; ++ks) {
                        const bf16_t* kp = a.K + (R0 + 32 * ks + 8 * fq) * D + h * 256 + d0 + fr;
                        float kk[8];
#pragma unroll
                        for (int j = 0; j < 8; ++j) kk[j] = bf2f(kp[(size_t)j * D]) * kd[32 * ks + 8 * fq + j];
                        u32x4 ka; ka.x = pk2(kk[0], kk[1]); ka.y = pk2(kk[2], kk[3]); ka.z = pk2(kk[4], kk[5]); ka.w = pk2(kk[6], kk[7]);
                        acc = MFMA16(__builtin_bit_cast(bf16x8, ka), ks ? vf1 : vf0, acc);
                    }
                    sp[0] = acc[0]; sp[128] = acc[1]; sp[256] = acc[2]; sp[384] = acc[3];
                }
                if (a.is_ml && tid < 256) { const int d = tid; const bf16_t* kp = a.K + R0 * D + h * 256 + d; float s = nv[d] * cdec;
                    for (int m = 0; m < CH; ++m) s += kd[m] * bf2f(kp[(size_t)m * D]);
                    nv[d] = s; }
            }
            __syncthreads();
        }
    }
}


typedef short v4i16_t __attribute__((ext_vector_type(4)));
__device__ __forceinline__ int swz_f(int row) { return ((row & 3) << 2) | ((row >> 2) & 3); }
__device__ __forceinline__ int img_chunk(int row, int half, int ch) { return half * 16384 + 256 * row + 16 * (ch ^ swz_f(row)); }
constexpr int S2_Q = 0, S2_K = 65536, S2_ATT = 131072, S2_VEC = S2_ATT + 64 * ATT_LD * 2;
__device__ __forceinline__ void scan_dma_tile(LAS unsigned char* dstbuf, const bf16_t* src, int wave, int lane) {
#pragma unroll
    for (int j = 0; j < 4; ++j) { const int ii = wave * 4 + j, half = ii >> 4, rg = ii & 15; const int row = 4 * rg + (lane >> 4), ch = (lane & 15) ^ swz_f(row);
        __builtin_amdgcn_global_load_lds((const unsigned*)(src + (size_t)row * D + half * 128 + 8 * ch), (LAS unsigned*)(dstbuf + half * 16384 + rg * 1024), 16, 0, 0); }
}
__device__ __forceinline__ float scan_incl_sum(float v, int lane) {
#pragma unroll
    for (int o = 1; o < 64; o <<= 1) { const float t = __shfl_up(v, o); if (lane >= o) v += t; }
    return v;
}
__device__ __forceinline__ float scan_incl_max(float v, int lane) {
#pragma unroll
    for (int o = 1; o < 64; o <<= 1) { const float t = __shfl_up(v, o); if (lane >= o) v = fmaxf(v, t); }
    return v;
}
__device__ __forceinline__ void scan_phase2(LAS unsigned char* lds, const ScanArgs a, int tid, int wave, int lane) {
    LAS bf16_t* att = (LAS bf16_t*)(lds + S2_ATT);
    LAS float* vec = (LAS float*)(lds + S2_VEC);
    LAS float* rowv = vec, *colv = vec + 64, *aq = vec + 128, *kd = vec + 192, *emr = vec + 256, *qn = vec + 320, *denp = vec + 384, *nv = vec + 640, *scal = vec + 896;
    const int fr = lane & 15, fq = lane >> 4;
    for (int item = blockIdx.x; item < 256; item += gridDim.x) {
        const int eh = item & 1, dir = (item >> 1) & 1, h = (item >> 2) & 3, b = item >> 4;
        const int ew = wave * 16;
        const int Ff = swz_f(fr), Fhp = Ff >> 2, Flp = Ff & 3;
        int X4[4];
#pragma unroll
        for (int c2 = 0; c2 < 4; ++c2) X4[c2] = 64 * (c2 ^ Fhp);
        const int LB1 = 256 * fr + 16 * (fq ^ Flp);
        const int LB2 = 256 * fr + 16 * ((fq >> 1) ^ Flp) + 8 * (fq & 1);
        const int LB3 = 256 * fr + 16 * (((fq >> 1) | 2) ^ Flp) + 8 * (fq & 1);
        const int q4 = (lane & 15) >> 2, p4 = lane & 3;
        const int TB0 = 256 * (8 * fq + q4) + 16 * (p4 >> 1) + 8 * (p4 & 1);
        const int TB1 = 256 * (8 * fq + q4 + 4) + 16 * ((p4 >> 1) ^ 1) + 8 * (p4 & 1);
        int W8[8];
#pragma unroll
        for (int i = 0; i < 8; ++i) W8[i] = 64 * ((i >> 1) ^ q4) + 32 * ((i & 1) ^ (fq & 1));
        __syncthreads();
        f32x4 S[16];
#pragma unroll
        for (int i = 0; i < 16; ++i) S[i] = (f32x4){0.f, 0.f, 0.f, 0.f};
        if (tid < 256) nv[tid] = 0.f;
        if (tid == 0) { scal[0] = 0.f; scal[1] = 1.f; }
        const float* Gi = a.G + ((size_t)b * 16 + (dir ? 8 : 0) + h) * TT;
        const float* Gf = a.G + ((size_t)b * 16 + (dir ? 12 : 4) + h) * TT;
        bf16_t* Oo = dir ? a.Ob : a.Of;
        const bf16_t* Qh = a.Q + (size_t)b * TT * D + h * 256;
        const bf16_t* Kh = a.K + (size_t)b * TT * D + h * 256;
        const bf16_t* Vw = a.VT + ((size_t)(b * 4 + h) * 256 + eh * 128 + ew + fr) * TT + 8 * fq;
        if (!a.is_ml) {
            const float lg = logsigmoid_f(a.decay[dir * 4 + h]);
            if (tid < CH) { const int l = tid;
                rowv[l] = (dir ? -(float)l : (float)l) * lg; colv[l] = (dir ? (float)l : -(float)l) * lg;
                aq[l] = expf((float)(dir ? (CH - l) : (l + 1)) * lg); kd[l] = expf((float)(dir ? l : (CH - 1 - l)) * lg); emr[l] = 0.f; }
            if (tid == 0) scal[1] = expf((float)CH * lg);
        }
        { const int tt0 = (dir ? 3 : 0) * CH; scan_dma_tile(lds + S2_K, Kh + (size_t)tt0 * D, wave, lane); }
        const int sidx = dir ? 63 - lane : lane;
        float gf_n = 0.f, gi_n = 0.f;
        if (a.is_ml && wave == 0) { const int tt0 = (dir ? 3 : 0) * CH; gf_n = Gf[tt0 + sidx]; gi_n = Gi[tt0 + sidx]; }
        asm volatile("s_waitcnt vmcnt(0)" ::: "memory");
        __syncthreads();
        for (int st = 0; st < 36; ++st) {
            int tt0, ttn;
            if (st < 4) tt0 = (dir ? (3 - st) : st) * CH; else tt0 = TC + (dir ? (35 - st) : (st - 4)) * CH;
            { const int sn = st + 1; if (sn < 4) ttn = (dir ? (3 - sn) : sn) * CH; else ttn = TC + (dir ? (35 - sn) : (sn - 4)) * CH; }
            const bool lat = st >= 4, latn = (st + 1) >= 4, hasn = (st + 1) < 36;
            int frs = fr, fqs = fq; asm volatile("" : "+v"(frs), "+v"(fqs));
            LAS unsigned char* Qb = lds + S2_Q + (st & 1) * 32768;
            LAS unsigned char* Kb = lds + S2_K + (st & 1) * 32768;
            const bf16x8 vf0 = *(const bf16x8*)(Vw + tt0), vf1 = *(const bf16x8*)(Vw + tt0 + 32);
            if (a.is_ml) {
                if (wave == 0) {
                    const float f = gf_n, ig = gi_n, mst = scal[0];
                    const float cc = scan_incl_sum(f, lane);
                    const float ctot = __shfl(cc, 63);
                    const float av = ig - cc;
                    const float mi = scan_incl_max(av, lane);
                    float mx = mi;
                    if (dir) { mx = __shfl_up(mi, 1); if (lane == 0) mx = -1e30f; }
                    const float gmax = __shfl(mi, 63);
                    const float mnew = fmaxf(ctot + mst, ctot + gmax);
                    const float mrow = fmaxf(cc + mx, cc + mst);
                    rowv[sidx] = cc - mrow; colv[sidx] = av; aq[sidx] = expf(cc + mst - mrow); emr[sidx] = expf(-mrow); kd[sidx] = expf(ctot + av - mnew);
                    if (lane == 0) { scal[1] = expf(ctot + mst - mnew); scal[0] = mnew; }
                    if (hasn) { gf_n = Gf[ttn + sidx]; gi_n = Gi[ttn + sidx]; }
                }
                __syncthreads();
            }
            if (lat) {
#pragma unroll
                for (int tq = 0; tq < 2; ++tq) {
                    const int ti = wave * 2 + tq, lt = ti >> 2, mt = ti & 3;
                    f32x4 acc = (f32x4){0.f, 0.f, 0.f, 0.f};
#pragma unroll
                    for (int k8 = 0; k8 < 8; ++k8) {
                        const bf16x8 ka = *(const LAS bf16x8*)(Kb + (LB1 + X4[k8 & 3] + mt * 4096) + (k8 >> 2) * 16384);
                        const bf16x8 qb = *(const LAS bf16x8*)(Qb + (LB1 + X4[k8 & 3] + lt * 4096) + (k8 >> 2) * 16384);
                        acc = MFMA16(ka, qb, acc);
                    }
                    const int l = lt * 16 + frs; const float rv = rowv[l]; float o[4]; float s = 0.f;
#pragma unroll
                    for (int r = 0; r < 4; ++r) { const int m = mt * 16 + 4 * fqs + r; const bool ok = dir ? (m > l) : (m <= l); const float w = ok ? __expf(rv + colv[m]) : 0.f; o[r] = acc[r] * w; s += o[r]; }
                    *(LAS u32x2*)(att + l * ATT_LD + mt * 16 + 4 * fqs) = (u32x2){pk2(o[0], o[1]), pk2(o[2], o[3])};
                    s += __shfl_xor(s, 16); s += __shfl_xor(s, 32);
                    if (fqs == 0) denp[l * 4 + mt] = s;
                }
                if (a.is_ml) {
                    const int l = tid >> 3, part = tid & 7; float s = 0.f;
#pragma unroll
                    for (int cc = 0; cc < 4; ++cc) { const int cg = part * 4 + cc; const u32x4 w = *(const LAS u32x4*)(Qb + img_chunk(l, cg >> 4, cg & 15)); const LAS float* np = nv + cg * 8;
#pragma unroll
                        for (int j = 0; j < 4; ++j) s += bflo(w[j]) * np[2 * j] + bfhi(w[j]) * np[2 * j + 1]; }
                    s += __shfl_xor(s, 1); s += __shfl_xor(s, 2); s += __shfl_xor(s, 4);
                    if (part == 0) qn[l] = s;
                }
            }
            __syncthreads();
            if (hasn) {
                scan_dma_tile(lds + S2_K + ((st + 1) & 1) * 32768, Kh + (size_t)ttn * D, wave, lane);
                if (latn) scan_dma_tile(lds + S2_Q + ((st + 1) & 1) * 32768, Qh + (size_t)ttn * D, wave, lane);
            }
            const float cdec = scal[1];
            if (lat) {
                const int t0 = tt0 - TC;
                f32x4 oacc[4];
#pragma unroll
                for (int lt = 0; lt < 4; ++lt) oacc[lt] = (f32x4){0.f, 0.f, 0.f, 0.f};
#pragma unroll
                for (int kb = 0; kb < 8; ++kb) {
                    u32x4 w; w.x = pk2(S[2 * kb][0], S[2 * kb][1]); w.y = pk2(S[2 * kb][2], S[2 * kb][3]); w.z = pk2(S[2 * kb + 1][0], S[2 * kb + 1][1]); w.w = pk2(S[2 * kb + 1][2], S[2 * kb + 1][3]);
                    const bf16x8 sbk = __builtin_bit_cast(bf16x8, w);
#pragma unroll
                    for (int lt = 0; lt < 4; ++lt) {
                        const u32x2 lo = *(const LAS u32x2*)(Qb + (LB2 + X4[kb & 3]) + lt * 4096 + (kb >> 2) * 16384);
                        const u32x2 hi = *(const LAS u32x2*)(Qb + (LB3 + X4[kb & 3]) + lt * 4096 + (kb >> 2) * 16384);
                        const u32x4 qa = (u32x4){lo.x, lo.y, hi.x, hi.y};
                        oacc[lt] = MFMA16(__builtin_bit_cast(bf16x8, qa), sbk, oacc[lt]);
                    }
                    if (kb & 1) __builtin_amdgcn_sched_barrier(0);
                }
#pragma unroll
                for (int lt = 0; lt < 4; ++lt) {
                    f32x4 acc = oacc[lt];
                    float hs[4];
#pragma unroll
                    for (int r = 0; r < 4; ++r) { const int l = lt * 16 + 4 * fqs + r; acc[r] *= aq[l];
                        if (a.is_ml) { const float den = (denp[l * 4] + denp[l * 4 + 1]) + (denp[l * 4 + 2] + denp[l * 4 + 3]) + aq[l] * qn[l]; hs[r] = 1.f / fmaxf(fabsf(den), emr[l]); } else hs[r] = 1.f; }
                    const bf16x8 a0 = *(const LAS bf16x8*)(att + (lt * 16 + frs) * ATT_LD + 8 * fqs), a1 = *(const LAS bf16x8*)(att + (lt * 16 + frs) * ATT_LD + 32 + 8 * fqs);
                    acc = MFMA16(a0, vf0, acc); acc = MFMA16(a1, vf1, acc);
#pragma unroll
                    for (int r = 0; r < 4; ++r) { const int l = lt * 16 + 4 * fqs + r; Oo[((size_t)b * T + t0 + l) * D + h * 256 + eh * 128 + ew + frs] = f2bf(acc[r] * hs[r]); }
                    __builtin_amdgcn_sched_barrier(0);
                }
            }
            {
                bf16x8 vs[2];
#pragma unroll
                for (int ks = 0; ks < 2; ++ks) { const u32x4 vw = __builtin_bit_cast(u32x4, ks ? vf1 : vf0); const LAS float* kp = kd + 32 * ks + 8 * fqs; u32x4 o;
#pragma unroll
                    for (int j = 0; j < 4; ++j) o[j] = pk2(bflo(vw[j]) * kp[2 * j], bfhi(vw[j]) * kp[2 * j + 1]);
                    vs[ks] = __builtin_bit_cast(bf16x8, o); }
#pragma unroll
                for (int dt = 0; dt < 16; ++dt) {
                    f32x4 acc = S[dt] * cdec;
#pragma unroll
                    for (int ks = 0; ks < 2; ++ks) {
                        const v4i16_t lo = __builtin_amdgcn_ds_read_tr16_b64_v4i16((LAS v4i16_t*)(Kb + (TB0 + W8[dt & 7]) + (dt >> 3) * 16384 + ks * 8192));
                        const v4i16_t hi = __builtin_amdgcn_ds_read_tr16_b64_v4i16((LAS v4i16_t*)(Kb + (TB1 + W8[dt & 7]) + (dt >> 3) * 16384 + ks * 8192));
                        const bf16x8 ka = __builtin_shufflevector(lo, hi, 0, 1, 2, 3, 4, 5, 6, 7);
                        acc = MFMA16(ka, vs[ks], acc);
                    }
                    S[dt] = acc;
                    if ((dt & 1) == 1) __builtin_amdgcn_sched_barrier(0);
                }
                if (a.is_ml && tid < 256) { const int d = tid; float s = nv[d] * cdec;
#pragma unroll 4
                    for (int m = 0; m < CH; ++m) s += kd[m] * bf2f(*(const LAS bf16_t*)(Kb + img_chunk(m, d >> 7, (d & 127) >> 3) + (d & 7) * 2));
                    nv[d] = s; }
            }
            asm volatile("s_waitcnt vmcnt(0)" ::: "memory");
            __syncthreads();
        }
    }
}


constexpr int S3_SET = 328;
template <int VAR> __device__ __forceinline__ void scan_phase3(LAS unsigned char* lds, const ScanArgs a, int tid, int wave, int lane) {
    LAS bf16_t* att = (LAS bf16_t*)(lds + S2_ATT);
    LAS float* vec = (LAS float*)(lds + S2_VEC);
    LAS float* qn2 = vec + 2 * S3_SET, *denp = qn2 + 128;
    const int fr = lane & 15, fq = lane >> 4;
    for (int item = blockIdx.x; item < 256; item += gridDim.x) {
        const int eh = item & 1, dir = (item >> 1) & 1, h = (item >> 2) & 3, b = item >> 4;
        const int ew = wave * 16;
        const int Ff = swz_f(fr), Fhp = Ff >> 2, Flp = Ff & 3;
        int X4[4];
#pragma unroll
        for (int c2 = 0; c2 < 4; ++c2) X4[c2] = 64 * (c2 ^ Fhp);
        const int LB1 = 256 * fr + 16 * (fq ^ Flp);
        const int LB2 = 256 * fr + 16 * ((fq >> 1) ^ Flp) + 8 * (fq & 1);
        const int LB3 = 256 * fr + 16 * (((fq >> 1) | 2) ^ Flp) + 8 * (fq & 1);
        const int q4 = (lane & 15) >> 2, p4 = lane & 3;
        const int TB0 = 256 * (8 * fq + q4) + 16 * (p4 >> 1) + 8 * (p4 & 1);
        const int TB1 = 256 * (8 * fq + q4 + 4) + 16 * ((p4 >> 1) ^ 1) + 8 * (p4 & 1);
        int W8[8];
#pragma unroll
        for (int i = 0; i < 8; ++i) W8[i] = 64 * ((i >> 1) ^ q4) + 32 * ((i & 1) ^ (fq & 1));
        __syncthreads();
        f32x4 S[16];
#pragma unroll
        for (int i = 0; i < 16; ++i) S[i] = (f32x4){0.f, 0.f, 0.f, 0.f};
        if (tid < 128) qn2[tid] = 0.f;
        f32x4 nA[2]; nA[0] = (f32x4){0.f, 0.f, 0.f, 0.f}; nA[1] = nA[0];
        const float* Gi = a.G + ((size_t)b * 16 + (dir ? 8 : 0) + h) * TT;
        const float* Gf = a.G + ((size_t)b * 16 + (dir ? 12 : 4) + h) * TT;
        bf16_t* Oo = (dir ? a.Ob : a.Of) + (size_t)b * T * D + h * 256 + eh * 128 + ew;
        const bf16_t* Qh = a.Q + (size_t)b * TT * D + h * 256;
        const bf16_t* Kh = a.K + (size_t)b * TT * D + h * 256;
        const bf16_t* Vw = a.VT + ((size_t)(b * 4 + h) * 256 + eh * 128 + ew + fr) * TT + 8 * fq;
        const int sidx = dir ? 63 - lane : lane;
        if (!a.is_ml) {
            const float lg = logsigmoid_f(a.decay[dir * 4 + h]);
            if (tid < 2 * CH) { const int l = tid & 63; LAS float* v = vec + (tid >> 6) * S3_SET;
                v[l] = (dir ? -(float)l : (float)l) * lg; v[64 + l] = (dir ? (float)l : -(float)l) * lg;
                v[128 + l] = expf((float)(dir ? (CH - l) : (l + 1)) * lg); v[192 + l] = expf((float)(dir ? l : (CH - 1 - l)) * lg); v[256 + l] = 0.f;
                if (l == 0) v[321] = expf((float)CH * lg); }
        }
#define S3_STAGE1(SET, f_, ig_) do { LAS float* v_ = vec + (SET) * S3_SET; \
            const float cc_ = scan_incl_sum((f_), lane); const float ctot_ = __shfl(cc_, 63); const float av_ = (ig_) - cc_; \
            const float mi_ = scan_incl_max(av_, lane); float mx_ = mi_; if (dir) { mx_ = __shfl_up(mi_, 1); if (lane == 0) mx_ = -1e30f; } \
            const float gmax_ = __shfl(mi_, 63); const float mnew_ = fmaxf(ctot_ + mst, ctot_ + gmax_); const float mrow_ = fmaxf(cc_ + mx_, cc_ + mst); \
            v_[sidx] = cc_ - mrow_; v_[64 + sidx] = av_; v_[128 + sidx] = __expf(cc_ + mst - mrow_); v_[256 + sidx] = __expf(-mrow_); v_[192 + sidx] = __expf(ctot_ + av_ - mnew_); \
            if (lane == 0) v_[321] = __expf(ctot_ + mst - mnew_); mst = mnew_; } while (0)
        float mst = 0.f, gf_n = 0.f, gi_n = 0.f;
        const int tt_first = (dir ? 3 : 0) * CH;
        if (!(VAR & 1)) scan_dma_tile(lds + S2_K, Kh + (size_t)tt_first * D, wave, lane);
        bf16x8 vf0 = *(const bf16x8*)(Vw + tt_first), vf1 = *(const bf16x8*)(Vw + tt_first + 32);
        if (a.is_ml && wave == 0) {
            const float f0 = Gf[tt_first + sidx], i0 = Gi[tt_first + sidx];
            S3_STAGE1(0, f0, i0);
            const int tt1 = (dir ? 2 : 1) * CH; gf_n = Gf[tt1 + sidx]; gi_n = Gi[tt1 + sidx];
        }
        float outv[16];
#pragma unroll
        for (int i = 0; i < 16; ++i) outv[i] = 0.f;
        int tprev = -1;
        asm volatile("s_waitcnt vmcnt(0)" ::: "memory");
        __syncthreads();
        for (int st = 0; st < 36; ++st) {
            int tt0, ttn, ttnn;
            if (st < 4) tt0 = (dir ? (3 - st) : st) * CH; else tt0 = TC + (dir ? (35 - st) : (st - 4)) * CH;
            { const int sn = st + 1; if (sn < 4) ttn = (dir ? (3 - sn) : sn) * CH; else ttn = TC + (dir ? (35 - sn) : (sn - 4)) * CH; }
            { const int sn = st + 2; if (sn < 4) ttnn = (dir ? (3 - sn) : sn) * CH; else ttnn = TC + (dir ? (35 - sn) : (sn - 4)) * CH; }
            const bool lat = st >= 4, latn = (st + 1) >= 4, hasn = (st + 1) < 36, hasnn = (st + 2) < 36;
            int frs = fr, fqs = fq; asm volatile("" : "+v"(frs), "+v"(fqs));
            LAS unsigned char* Qb = lds + S2_Q + (st & 1) * 32768;
            LAS unsigned char* Kb = lds + S2_K + (st & 1) * 32768;
            LAS float* vs_ = vec + ((a.is_ml ? st : 0) & 1) * S3_SET;
            LAS float* rowv = vs_, *colv = vs_ + 64, *aq = vs_ + 128, *kd = vs_ + 192, *emr = vs_ + 256;
            LAS float* qn = qn2 + (st & 1) * 64;
            bf16x8 vfn0 = vf0, vfn1 = vf1;
            if (tprev >= 0) {
#pragma unroll
                for (int lt = 0; lt < 4; ++lt)
#pragma unroll
                    for (int r = 0; r < 4; ++r) Oo[(size_t)(tprev + lt * 16 + 4 * fqs + r) * D + frs] = f2bf(outv[lt * 4 + r]);
            }
            f32x4 oacc[4];
#pragma unroll
            for (int lt = 0; lt < 4; ++lt) oacc[lt] = (f32x4){0.f, 0.f, 0.f, 0.f};
            if (lat) {
                if (!(VAR & 2)) {
                {
                    int lts[2], mts[2];
#pragma unroll
                    for (int tq = 0; tq < 2; ++tq) { const int ti = wave * 2 + tq;
                        const int ta = (int)((0x3333222110211000ull >> (4 * ti)) & 15ull), tb = (int)((0x3210210100332321ull >> (4 * ti)) & 15ull);
                        lts[tq] = dir ? tb : ta; mts[tq] = dir ? ta : tb; }
                    f32x4 accs[2]; accs[0] = (f32x4){0.f, 0.f, 0.f, 0.f}; accs[1] = accs[0];
                    if (wave >= 3) {
#pragma unroll
                        for (int k8 = 0; k8 < 8; ++k8) {
#pragma unroll
                            for (int tq = 0; tq < 2; ++tq) {
                                const bf16x8 ka = *(const LAS bf16x8*)(Kb + (LB1 + X4[k8 & 3] + mts[tq] * 4096) + (k8 >> 2) * 16384);
                                const bf16x8 qb = *(const LAS bf16x8*)(Qb + (LB1 + X4[k8 & 3] + lts[tq] * 4096) + (k8 >> 2) * 16384);
                                accs[tq] = MFMA16(ka, qb, accs[tq]);
                            }
                        }
                    }
#pragma unroll
                    for (int tq = 0; tq < 2; ++tq) {
                        const int lt = lts[tq], mt = mts[tq]; const f32x4 acc = accs[tq];
                        const int l = lt * 16 + frs; const float rv = rowv[l]; float o[4]; float s = 0.f;
#pragma unroll
                        for (int r = 0; r < 4; ++r) { const int m = mt * 16 + 4 * fqs + r; const bool ok = dir ? (m > l) : (m <= l); const float w = ok ? __expf(rv + colv[m]) : 0.f; o[r] = acc[r] * w; s += o[r]; }
                        *(LAS u32x2*)(att + l * ATT_LD + mt * 16 + 4 * fqs) = (u32x2){pk2(o[0], o[1]), pk2(o[2], o[3])};
                        s += __shfl_xor(s, 16); s += __shfl_xor(s, 32);
                        if (fqs == 0) denp[l * 4 + mt] = s;
                    }
                }
                }
            }
            asm volatile("" : "+v"(vf0), "+v"(vf1), "+v"(gf_n), "+v"(gi_n));
            if (hasn) { vfn0 = *(const bf16x8*)(Vw + ttn); vfn1 = *(const bf16x8*)(Vw + ttn + 32); }
            if (hasn) {
                scan_dma_tile(lds + S2_K + ((st + 1) & 1) * 32768, Kh + (size_t)ttn * D, wave, lane);
                if (latn) scan_dma_tile(lds + S2_Q + ((st + 1) & 1) * 32768, Qh + (size_t)ttn * D, wave, lane);
            }
            if (lat) {
                __builtin_amdgcn_sched_barrier(0);
                if (!(VAR & 4)) {
                bf16x8 nfr;
                { u32x4 w; w.x = pk2(nA[0][0], nA[0][1]); w.y = pk2(nA[0][2], nA[0][3]); w.z = pk2(nA[1][0], nA[1][1]); w.w = pk2(nA[1][2], nA[1][3]); nfr = __builtin_bit_cast(bf16x8, w); }
#pragma unroll
                for (int kb = 0; kb < 8; ++kb) {
                    u32x4 w; w.x = pk2(S[2 * kb][0], S[2 * kb][1]); w.y = pk2(S[2 * kb][2], S[2 * kb][3]); w.z = pk2(S[2 * kb + 1][0], S[2 * kb + 1][1]); w.w = pk2(S[2 * kb + 1][2], S[2 * kb + 1][3]);
                    const bf16x8 sbk = __builtin_bit_cast(bf16x8, w);
                    u32x2 ql[4], qh[4];
                    { const unsigned alo = (unsigned)(size_t)(Qb + (LB2 + X4[kb & 3]) + (kb >> 2) * 16384), ahi = (unsigned)(size_t)(Qb + (LB3 + X4[kb & 3]) + (kb >> 2) * 16384);
                      asm volatile("ds_read_b64 %0, %8\n\tds_read_b64 %1, %9\n\tds_read_b64 %2, %8 offset:4096\n\tds_read_b64 %3, %9 offset:4096\n\t"
                                   "ds_read_b64 %4, %8 offset:8192\n\tds_read_b64 %5, %9 offset:8192\n\tds_read_b64 %6, %8 offset:12288\n\tds_read_b64 %7, %9 offset:12288\n\ts_waitcnt lgkmcnt(0)"
                                   : "=&v"(ql[0]), "=&v"(qh[0]), "=&v"(ql[1]), "=&v"(qh[1]), "=&v"(ql[2]), "=&v"(qh[2]), "=&v"(ql[3]), "=&v"(qh[3]) : "v"(alo), "v"(ahi) : "memory"); }
#pragma unroll
                    for (int lt = 0; lt < 4; ++lt) {
                        const u32x2 lo = ql[lt], hi = qh[lt];
                        const u32x4 qa = (u32x4){lo.x, lo.y, hi.x, hi.y};
                        oacc[lt] = MFMA16(__builtin_bit_cast(bf16x8, qa), sbk, oacc[lt]);
                    }
                    if (kb & 1) __builtin_amdgcn_sched_barrier(0);
                }
                if (a.is_ml) {
                    u32x2 ql[4], qh[4];
                    { const int xw = 64 * ((wave & 3) ^ Fhp) + (wave >> 2) * 16384; const unsigned alo = (unsigned)(size_t)(Qb + LB2 + xw), ahi = (unsigned)(size_t)(Qb + LB3 + xw);
                      asm volatile("ds_read_b64 %0, %8\n\tds_read_b64 %1, %9\n\tds_read_b64 %2, %8 offset:4096\n\tds_read_b64 %3, %9 offset:4096\n\t"
                                   "ds_read_b64 %4, %8 offset:8192\n\tds_read_b64 %5, %9 offset:8192\n\tds_read_b64 %6, %8 offset:12288\n\tds_read_b64 %7, %9 offset:12288\n\ts_waitcnt lgkmcnt(0)"
                                   : "=&v"(ql[0]), "=&v"(qh[0]), "=&v"(ql[1]), "=&v"(qh[1]), "=&v"(ql[2]), "=&v"(qh[2]), "=&v"(ql[3]), "=&v"(qh[3]) : "v"(alo), "v"(ahi) : "memory"); }
#pragma unroll
                    for (int lt = 0; lt < 4; ++lt) {
                        const u32x4 qa = (u32x4){ql[lt].x, ql[lt].y, qh[lt].x, qh[lt].y};
                        const f32x4 qp = MFMA16(__builtin_bit_cast(bf16x8, qa), nfr, ((f32x4){0.f, 0.f, 0.f, 0.f}));
                        if (frs == 0) {
                            const unsigned qa_ = (unsigned)(size_t)(qn + lt * 16 + 4 * fqs);
                            asm volatile("s_nop 7\n\ts_nop 7\n\tds_add_f32 %0, %1\n\tds_add_f32 %0, %2 offset:4\n\tds_add_f32 %0, %3 offset:8\n\tds_add_f32 %0, %4 offset:12" :: "v"(qa_), "v"(qp[0]), "v"(qp[1]), "v"(qp[2]), "v"(qp[3]) : "memory");
                        }
                    }
                }
                }
            }
            if (a.is_ml && wave == 0 && hasn) {
                S3_STAGE1((st + 1) & 1, gf_n, gi_n);
                if (hasnn) { gf_n = Gf[ttnn + sidx]; gi_n = Gi[ttnn + sidx]; }
            }
            const float cdec = vs_[321];
            if (!(VAR & 8)) {
                bf16x8 vs[2];
#pragma unroll
                for (int ks = 0; ks < 2; ++ks) { const u32x4 vw = __builtin_bit_cast(u32x4, ks ? vf1 : vf0); const LAS float* kp = kd + 32 * ks + 8 * fqs; u32x4 o;
#pragma unroll
                    for (int j = 0; j < 4; ++j) o[j] = pk2(bflo(vw[j]) * kp[2 * j], bfhi(vw[j]) * kp[2 * j + 1]);
                    vs[ks] = __builtin_bit_cast(bf16x8, o); }
                bf16x8 kdf[2];
                if (a.is_ml) {
#pragma unroll
                    for (int ks = 0; ks < 2; ++ks) { const LAS float* kp = kd + 32 * ks + 8 * fqs; u32x4 o;
#pragma unroll
                        for (int j = 0; j < 4; ++j) o[j] = pk2(kp[2 * j], kp[2 * j + 1]);
                        kdf[ks] = __builtin_bit_cast(bf16x8, o); }
                    nA[0] = nA[0] * cdec; nA[1] = nA[1] * cdec;
                }
#pragma unroll
                for (int g = 0; g < 8; ++g) {
                    v4i16_t t0, t1, t2, t3, t4, t5, t6, t7;
                    const unsigned a00 = (unsigned)(size_t)(Kb + (TB0 + W8[(2 * g) & 7]) + ((2 * g) >> 3) * 16384), a01 = (unsigned)(size_t)(Kb + (TB1 + W8[(2 * g) & 7]) + ((2 * g) >> 3) * 16384);
                    const unsigned a10 = (unsigned)(size_t)(Kb + (TB0 + W8[(2 * g + 1) & 7]) + ((2 * g + 1) >> 3) * 16384), a11 = (unsigned)(size_t)(Kb + (TB1 + W8[(2 * g + 1) & 7]) + ((2 * g + 1) >> 3) * 16384);
                    asm volatile("ds_read_b64_tr_b16 %0, %8\n\tds_read_b64_tr_b16 %1, %9\n\tds_read_b64_tr_b16 %2, %8 offset:8192\n\tds_read_b64_tr_b16 %3, %9 offset:8192\n\t"
                                 "ds_read_b64_tr_b16 %4, %10\n\tds_read_b64_tr_b16 %5, %11\n\tds_read_b64_tr_b16 %6, %10 offset:8192\n\tds_read_b64_tr_b16 %7, %11 offset:8192\n\ts_waitcnt lgkmcnt(0)"
                                 : "=&v"(t0), "=&v"(t1), "=&v"(t2), "=&v"(t3), "=&v"(t4), "=&v"(t5), "=&v"(t6), "=&v"(t7) : "v"(a00), "v"(a01), "v"(a10), "v"(a11) : "memory");
#define S3_UPD(dt_, lo0_, hi0_, lo1_, hi1_) do { f32x4 acc = S[dt_] * cdec; \
                        const bf16x8 ka0 = __builtin_shufflevector(lo0_, hi0_, 0, 1, 2, 3, 4, 5, 6, 7), ka1 = __builtin_shufflevector(lo1_, hi1_, 0, 1, 2, 3, 4, 5, 6, 7); \
                        acc = MFMA16(ka0, vs[0], acc); acc = MFMA16(ka1, vs[1], acc); \
                        S[dt_] = acc; } while (0)
                    S3_UPD(2 * g, t0, t1, t2, t3); S3_UPD(2 * g + 1, t4, t5, t6, t7);
#undef S3_UPD
                    __builtin_amdgcn_sched_barrier(0);
                }
                if (a.is_ml) {
#pragma unroll
                    for (int t = 0; t < 2; ++t) {
                        const int w8 = 64 * ((wave & 3) ^ q4) + 32 * (t ^ (fq & 1)) + (wave >> 2) * 16384;
                        v4i16_t t0, t1, t2, t3; const unsigned a0 = (unsigned)(size_t)(Kb + TB0 + w8), a1 = (unsigned)(size_t)(Kb + TB1 + w8);
                        asm volatile("ds_read_b64_tr_b16 %0, %4\n\tds_read_b64_tr_b16 %1, %5\n\tds_read_b64_tr_b16 %2, %4 offset:8192\n\tds_read_b64_tr_b16 %3, %5 offset:8192\n\ts_waitcnt lgkmcnt(0)"
                                     : "=&v"(t0), "=&v"(t1), "=&v"(t2), "=&v"(t3) : "v"(a0), "v"(a1) : "memory");
                        const bf16x8 ka0 = __builtin_shufflevector(t0, t1, 0, 1, 2, 3, 4, 5, 6, 7), ka1 = __builtin_shufflevector(t2, t3, 0, 1, 2, 3, 4, 5, 6, 7);
                        nA[t] = MFMA16(ka0, kdf[0], nA[t]); nA[t] = MFMA16(ka1, kdf[1], nA[t]);
                    }
                }
            }
            asm volatile("s_waitcnt lgkmcnt(0)" ::: "memory"); __builtin_amdgcn_s_barrier(); asm volatile("" ::: "memory");
            const bf16x8 av0 = vf0, av1 = vf1;
            if (lat && !(VAR & 16)) {
#pragma unroll
                for (int lt = 0; lt < 4; ++lt) {
                    f32x4 acc = oacc[lt];
                    float hs[4];
#pragma unroll
                    for (int r = 0; r < 4; ++r) { const int l = lt * 16 + 4 * fqs + r; acc[r] *= aq[l];
                        if (a.is_ml) { const float den = (denp[l * 4] + denp[l * 4 + 1]) + (denp[l * 4 + 2] + denp[l * 4 + 3]) + aq[l] * qn[l]; hs[r] = 1.f / fmaxf(fabsf(den), emr[l]); } else hs[r] = 1.f; }
                    const bf16x8 a0 = *(const LAS bf16x8*)(att + (lt * 16 + frs) * ATT_LD + 8 * fqs), a1 = *(const LAS bf16x8*)(att + (lt * 16 + frs) * ATT_LD + 32 + 8 * fqs);
                    acc = MFMA16(a0, av0, acc); acc = MFMA16(a1, av1, acc);
#pragma unroll
                    for (int r = 0; r < 4; ++r) outv[lt * 4 + r] = acc[r] * hs[r];
                }
                tprev = tt0 - TC;
            } else tprev = -1;
            if (a.is_ml) {
                if (tid >= 448) qn2[((st + 1) & 1) * 64 + (tid - 448)] = 0.f;
            }
            asm volatile("s_waitcnt vmcnt(0)" ::: "memory");
            __syncthreads();
            vf0 = vfn0; vf1 = vfn1;
        }
        if (tprev >= 0) {
#pragma unroll
            for (int lt = 0; lt < 4; ++lt)
#pragma unroll
                for (int r = 0; r < 4; ++r) Oo[(size_t)(tprev + lt * 16 + 4 * fq + r) * D + fr] = f2bf(outv[lt * 4 + r]);
        }
#undef S3_STAGE1
    }
}

template <int ACT  > __device__ __forceinline__ void phase4_one(const bf16_t* Of, const bf16_t* Ob, const bf16_t* Ga, bf16_t* Out, int wave, int lane) {
    const int gw = blockIdx.x * NWAVES + wave, NGW = gridDim.x * NWAVES;
    u32x4 f[2], bb[2], gg[2], nf[2], nb[2], ng[2];
    if (gw < NLAT) {
#pragma unroll
        for (int j = 0; j < 2; ++j) { f[j] = ld_nt((const u32x4*)(Of + (size_t)gw * D) + lane + 64 * j); bb[j] = ld_nt((const u32x4*)(Ob + (size_t)gw * D) + lane + 64 * j); gg[j] = ld_nt((const u32x4*)(Ga + (size_t)gw * D) + lane + 64 * j); } }
    for (int R = gw; R < NLAT; R += NGW) {
        const int Rn = R + NGW;
        if (Rn < NLAT) {
#pragma unroll
            for (int j = 0; j < 2; ++j) { nf[j] = ld_nt((const u32x4*)(Of + (size_t)Rn * D) + lane + 64 * j); nb[j] = ld_nt((const u32x4*)(Ob + (size_t)Rn * D) + lane + 64 * j); ng[j] = ld_nt((const u32x4*)(Ga + (size_t)Rn * D) + lane + 64 * j); } }
        u32x4* op = (u32x4*)(Out + (size_t)R * D);
#pragma unroll
        for (int j = 0; j < 2; ++j) {
            float v[8]; float s = 0.f;
#pragma unroll
            for (int i = 0; i < 4; ++i) { v[2 * i] = bflo(f[j][i]) + bflo(bb[j][i]); v[2 * i + 1] = bfhi(f[j][i]) + bfhi(bb[j][i]); s += v[2 * i] + v[2 * i + 1]; }
            const float mean = half_sum(s) * (1.f / 256.f); float s2 = 0.f;
#pragma unroll
            for (int i = 0; i < 8; ++i) { v[i] -= mean; s2 += v[i] * v[i]; }
            const float rstd = 1.f / sqrtf(half_sum(s2) * (1.f / 256.f) + LN_EPS);
            u32x4 o;
#pragma unroll
            for (int i = 0; i < 4; ++i) { const float ga = bflo(gg[j][i]), gb = bfhi(gg[j][i]); o[i] = pk2(v[2 * i] * rstd * (ACT ? sigmoid_f(ga) : silu_f(ga)), v[2 * i + 1] * rstd * (ACT ? sigmoid_f(gb) : silu_f(gb))); }
            op[lane + 64 * j] = o;
        }
#pragma unroll
        for (int j = 0; j < 2; ++j) { f[j] = nf[j]; bb[j] = nb[j]; gg[j] = ng[j]; }
    }
}

struct SchedDense { int G, c, nM, nN, rep; __device__ __forceinline__ void a_ready(const Unit&) const {} __device__ __forceinline__ void done(const Unit&) const {}
    __device__ __forceinline__ bool next(int i, Unit& u) const {
        const int x = c & 7, y = c >> 3, nxc = G >> 3; int q = i * nxc + y; const int ntot = (nM >> 3) * 4; if (q >= rep * ntot) return false; q %= ntot; u.pm = x + 8 * (q >> 2); u.pn = q & 3; return true; } };
struct EpiY {
    static constexpr bool PERM = true, AFTER_DRAIN = false;
    bf16_t* Y; const bf16_t* gate; int pass;
    __device__ __forceinline__ void operator()(const f32x4 (&acc)[2][2][4][2], const Unit& u, int wr, int wc, int fr, int fq) const {
#pragma unroll
        for (int ai = 0; ai < 2; ++ai)
#pragma unroll
            for (int m = 0; m < 4; ++m) { const int r = u.pm * 256 + ai * 128 + wr * 64 + m * 16 + fr;
#pragma unroll
                for (int bj = 0; bj < 2; ++bj) { const size_t off = (size_t)r * D + u.pn * 256 + bj * 128 + wc * 32 + 8 * fq; const f32x4 v0 = acc[ai][bj][m][0], v1 = acc[ai][bj][m][1];
                    const u32x4 g = *(const u32x4*)(gate + off);
                    float o[8] = {bflo(g.x) * v0[0], bfhi(g.x) * v0[1], bflo(g.y) * v0[2], bfhi(g.y) * v0[3], bflo(g.z) * v1[0], bfhi(g.z) * v1[1], bflo(g.w) * v1[2], bfhi(g.w) * v1[3]};
                    if (pass) { const u32x4 y = *(const u32x4*)(Y + off); o[0] += bflo(y.x); o[1] += bfhi(y.x); o[2] += bflo(y.y); o[3] += bfhi(y.y); o[4] += bflo(y.z); o[5] += bfhi(y.z); o[6] += bflo(y.w); o[7] += bfhi(y.w); }
                    *(u32x4*)(Y + off) = (u32x4){pk2(o[0], o[1]), pk2(o[2], o[3]), pk2(o[4], o[5]), pk2(o[6], o[7])}; } }
    }
};
struct EpiY2 {
    static constexpr bool PERM = true, AFTER_DRAIN = false;
    bf16_t* Y2;
    __device__ __forceinline__ void operator()(const f32x4 (&acc)[2][2][4][2], const Unit& u, int wr, int wc, int fr, int fq) const {
#pragma unroll
        for (int ai = 0; ai < 2; ++ai)
#pragma unroll
            for (int m = 0; m < 4; ++m) { const int r = u.pm * 256 + ai * 128 + wr * 64 + m * 16 + fr;
#pragma unroll
                for (int bj = 0; bj < 2; ++bj) { const f32x4 v0 = acc[ai][bj][m][0], v1 = acc[ai][bj][m][1];
                    *(u32x4*)(Y2 + (size_t)r * D + u.pn * 256 + bj * 128 + wc * 32 + 8 * fq) = (u32x4){pk2(v0[0], v0[1]), pk2(v0[2], v0[3]), pk2(v1[0], v1[1]), pk2(v1[2], v1[3])}; } }
    }
};
struct EpiZ {
    static constexpr bool PERM = false, AFTER_DRAIN = false;
    const float* x; const float* MOD; float* Z;
    __device__ __forceinline__ void operator()(const f32x4 (&acc)[2][2][4][2], const Unit& u, int wr, int wc, int fr, int fq) const {
#pragma unroll
        for (int ai = 0; ai < 2; ++ai)
#pragma unroll
            for (int m = 0; m < 4; ++m) { const int r = u.pm * 256 + ai * 128 + wr * 64 + m * 16 + fr, b = r >> 11;
#pragma unroll
                for (int bj = 0; bj < 2; ++bj)
#pragma unroll
                    for (int n = 0; n < 2; ++n) { const int c = u.pn * 256 + bj * 128 + wc * 32 + n * 16 + 4 * fq; const size_t off = (size_t)r * D + c;
                        const f32x4 xv = *(const f32x4*)(x + off), gv = *(const f32x4*)(MOD + (size_t)b * 6144 + 2048 + c);
                        *(f32x4*)(Z + off) = xv * DN_ALPHA + gv * acc[ai][bj][m][n]; } }
    }
};

constexpr int P7_U2F = 0, P7_LD = 1028, P7_PART = 16 * P7_LD * 4, P7_LOG = P7_PART + 8 * 16 * 48 * 4, P7_CNT = P7_LOG + 16 * 48 * 4;
__device__ __forceinline__ void phase7(const Params& p, LAS unsigned char* lds, int tid, int wave, int lane) {
    const int G = gridDim.x, gw = blockIdx.x * NWAVES + wave, NGW = G * NWAVES;
    LAS float* u2f = (LAS float*)(lds + P7_U2F); LAS float* part = (LAS float*)(lds + P7_PART); LAS float* logt = (LAS float*)(lds + P7_LOG);
    LAS int* lcnt = (LAS int*)(lds + P7_CNT);
    if (tid < 32) lcnt[tid] = 0;
    __syncthreads();
    const float* MOD = (const float*)(p.ws + WS_MOD); const float* WR = (const float*)(p.ws + WS_WRT);
    bf16_t* U2 = (bf16_t*)(p.ws + WS_U2); int* rec = (int*)(p.ws + WS_TOKREC);
    const float* g1 = p.in[I_LN1G]; const float* b1 = p.in[I_LN1B];
    const int fr = lane & 15, fq = lane >> 4;
    float wreg[32][3];
    { const float* bp = WR + (size_t)(wave * 128 + fq) * 48 + fr;
#pragma unroll
      for (int kk = 0; kk < 32; ++kk)
#pragma unroll
          for (int nt = 0; nt < 3; ++nt) wreg[kk][nt] = bp[(size_t)kk * 4 * 48 + 16 * nt]; }
    const bf16_t* Y2 = (const bf16_t*)(p.ws + WS_Y2); const float* xin = p.in[I_X];
    f32x4 zn[2][4]; u32x2 yn[2][4];
    if ((int)blockIdx.x < NLAT / 16) {
#pragma unroll
        for (int rr = 0; rr < 2; ++rr)
#pragma unroll
            for (int j = 0; j < 4; ++j) { const size_t R = (size_t)(blockIdx.x * 16 + wave * 2 + rr); zn[rr][j] = ld_nt((const f32x4*)(xin + R * D) + lane + 64 * j); yn[rr][j] = ld_nt((const u32x2*)(Y2 + R * D) + lane + 64 * j); } }
    for (int bi = blockIdx.x; bi < NLAT / 16; bi += G) {
#pragma unroll
        for (int rr = 0; rr < 2; ++rr) {
            const int rl = wave * 2 + rr, R = bi * 16 + rl, b = R >> 11;
            f32x4 zc[4];
            { const float* gv = MOD + (size_t)b * 6144 + 2048;
#pragma unroll
              for (int j = 0; j < 4; ++j) { const f32x4 g = *(const f32x4*)(gv + 4 * lane + 256 * j); const u32x2 y = yn[rr][j];
                  zc[j] = zn[rr][j] * DN_ALPHA + g * (f32x4){bflo(y.x), bfhi(y.x), bflo(y.y), bfhi(y.y)}; } }
            if (bi + G < NLAT / 16) {
#pragma unroll
                for (int j = 0; j < 4; ++j) { const size_t Rn = (size_t)((bi + G) * 16 + rl); zn[rr][j] = ld_nt((const f32x4*)(xin + Rn * D) + lane + 64 * j); yn[rr][j] = ld_nt((const u32x2*)(Y2 + Rn * D) + lane + 64 * j); } }
            float* zr = p.out + (size_t)R * D;
            f32x4 v[4]; float s = 0.f;
#pragma unroll
            for (int j = 0; j < 4; ++j) { v[j] = zc[j]; s += (v[j].x + v[j].y) + (v[j].z + v[j].w); }
            float mean = wave_sum(s) * (1.f / D); float s2 = 0.f;
#pragma unroll
            for (int j = 0; j < 4; ++j) { v[j] = v[j] - mean; s2 += (v[j].x * v[j].x + v[j].y * v[j].y) + (v[j].z * v[j].z + v[j].w * v[j].w); }
            float rstd = 1.f / sqrtf(wave_sum(s2) * (1.f / D) + LN_EPS);
            s = 0.f;
#pragma unroll
            for (int j = 0; j < 4; ++j) { const int col = 4 * lane + 256 * j; v[j] = v[j] * rstd * *(const f32x4*)(g1 + col) + *(const f32x4*)(b1 + col); st_nt((f32x4*)zr + lane + 64 * j, v[j]); s += (v[j].x + v[j].y) + (v[j].z + v[j].w); }
            mean = wave_sum(s) * (1.f / D); s2 = 0.f;
#pragma unroll
            for (int j = 0; j < 4; ++j) { v[j] = v[j] - mean; s2 += (v[j].x * v[j].x + v[j].y * v[j].y) + (v[j].z * v[j].z + v[j].w * v[j].w); }
            rstd = 1.f / sqrtf(wave_sum(s2) * (1.f / D) + LN_EPS);
            const float* sh = MOD + (size_t)b * 6144 + 3072; const float* sc = sh + 1024;
            u32x2* o8 = (u32x2*)(U2 + (size_t)R * D);
#pragma unroll
            for (int j = 0; j < 4; ++j) { const int col = 4 * lane + 256 * j; v[j] = v[j] * rstd * (*(const f32x4*)(sc + col) + 1.f) + *(const f32x4*)(sh + col);
                o8[lane + 64 * j] = (u32x2){pk2(v[j].x, v[j].y), pk2(v[j].z, v[j].w)};
                *(LAS f32x4*)(u2f + rl * P7_LD + col) = v[j]; }
        }
        __syncthreads();
        {
            f32x4 acc[3];
#pragma unroll
            for (int nt = 0; nt < 3; ++nt) acc[nt] = (f32x4){0.f, 0.f, 0.f, 0.f};
            const LAS float* ap = u2f + fr * P7_LD + wave * 128 + fq;
#pragma unroll
            for (int kk = 0; kk < 32; ++kk) {
                const float av = ap[4 * kk];
#pragma unroll
                for (int nt = 0; nt < 3; ++nt) acc[nt] = __builtin_amdgcn_mfma_f32_16x16x4f32(av, wreg[kk][nt], acc[nt], 0, 0, 0);
            }
#pragma unroll
            for (int nt = 0; nt < 3; ++nt)
#pragma unroll
                for (int r = 0; r < 4; ++r) part[(wave * 16 + 4 * fq + r) * 48 + 16 * nt + fr] = acc[nt][r];
        }
        __syncthreads();
        for (int i = tid; i < 16 * 48; i += NTHREADS) { float q = 0.f;
#pragma unroll
            for (int w = 0; w < 8; ++w) q += part[w * 16 * 48 + i];
            logt[i] = q; }
        __syncthreads();
        if (tid < 16) {
            const int R = bi * 16 + tid; const LAS float* lg = logt + tid * 48;
            float gl[4];
#pragma unroll
            for (int i = 0; i < 4; ++i) gl[i] = lg[i] + p.in[I_BRG][i];
            int gi = 0; float gm = gl[0];
#pragma unroll
            for (int i = 1; i < 4; ++i) if (gl[i] > gm) { gm = gl[i]; gi = i; }
            float gsum = 0.f;
#pragma unroll
            for (int i = 0; i < 4; ++i) gsum += expf(gl[i] - gm);
            const float pg = 1.f / gsum;
            int e0 = 0, e1 = -1; float m0 = -3.0e38f, m1 = -3.0e38f;
            for (int j = 0; j < 8; ++j) { const float x = lg[4 + gi * 8 + j] + p.in[I_BRE][gi * 8 + j];
                if (x > m0) { m1 = m0; e1 = e0; m0 = x; e0 = j; } else if (x > m1) { m1 = x; e1 = j; } }
            const float p1 = expf(m1 - m0); const float w0 = pg / (1.f + p1), w1 = pg * p1 / (1.f + p1);
            const int E0 = gi * 8 + e0, E1 = gi * 8 + e1;
            const int r0 = atomicAdd((int*)&lcnt[E0], 1), r1 = atomicAdd((int*)&lcnt[E1], 1);
            int* rr = rec + (size_t)R * 8; rr[0] = E0; rr[1] = E1; rr[2] = r0; rr[3] = r1; rr[4] = __float_as_int(w0); rr[5] = __float_as_int(w1); rr[6] = (int)blockIdx.x; rr[7] = 0;
        }
    }
    __syncthreads();
    if (tid < 32) { const int base = atomicAdd((int*)(p.ws + WS_CTL) + tid, lcnt[tid]); ((int*)(p.ws + WS_BASE))[blockIdx.x * 32 + tid] = base; }
    {
        LAS float* scr = (LAS float*)(lds + wave * 8448);
        constexpr int I13 = 16 * 16, I2 = 8 * 32;
        for (int it = gw; it < 32 * (2 * I13 + I2); it += NGW) {
            const int e = it / (2 * I13 + I2); int r = it % (2 * I13 + I2);
            bf16_t* w13 = (bf16_t*)(p.ws + WS_W13T) + (size_t)e * 1024 * 1024; bf16_t* w2 = (bf16_t*)(p.ws + WS_W2T) + (size_t)e * 1024 * 512;
            if (r < I13) { transpose_item<2>(p.in[I_WE1] + (size_t)e * 1024 * 512, 1024, 512, w13, scr, r, lane); continue; } r -= I13;
            if (r < I13) { transpose_item<3>(p.in[I_WE3] + (size_t)e * 1024 * 512, 1024, 512, w13, scr, r, lane); continue; } r -= I13;
            transpose_item<0>(p.in[I_WE2] + (size_t)e * 512 * 1024, 512, 1024, w2, scr, r, lane);
        }
    }
}

__device__ __forceinline__ void phase8(const Params& p, LAS unsigned char* lds, int tid, int wave, int lane) {
    const int G = gridDim.x, gw = blockIdx.x * NWAVES + wave, NGW = G * NWAVES;
    LAS int* poff = (LAS int*)lds;
    if (tid == 0) { const int* gc = (const int*)(p.ws + WS_CTL); int off = 0;
        for (int e = 0; e < 32; ++e) { const int c = gc[e]; poff[e] = off; poff[32 + e] = c; off += ((c + 255) >> 8) << 8; }
        poff[64] = off >> 8; }
    __syncthreads();
    const int ntiles = poff[64];
    if (blockIdx.x == 0) {
        int* te = (int*)(p.ws + WS_TILEEXP);
        for (int t = tid; t < 288; t += NTHREADS) { int ex = 31; for (int e = 0; e < 32; ++e) { const int c = poff[32 + e]; const int pe = poff[e] + (((c + 255) >> 8) << 8); if (t * 256 < pe) { ex = e; break; } } te[t] = ex; }
        if (tid == 0) ((int*)(p.ws + WS_CTL))[64] = ntiles;
    }
    const int* rec = (const int*)(p.ws + WS_TOKREC); const int* base = (const int*)(p.ws + WS_BASE);
    const bf16_t* U2 = (const bf16_t*)(p.ws + WS_U2); bf16_t* Xs = (bf16_t*)(p.ws + WS_XS); int* ts = (int*)(p.ws + WS_TOKSLOT);
    {
        int E0 = 0, E1 = 0, lr0 = 0, lr1 = 0, w0b = 0, w1b = 0, blk = 0; u32x4 ua = (u32x4){0u, 0u, 0u, 0u}, uc = ua;
        if (gw < NLAT) { const int* rr = rec + (size_t)gw * 8; E0 = rr[0]; E1 = rr[1]; lr0 = rr[2]; lr1 = rr[3]; w0b = rr[4]; w1b = rr[5]; blk = rr[6];
            const u32x4* src = (const u32x4*)(U2 + (size_t)gw * D); ua = ld_nt(src + lane); uc = ld_nt(src + lane + 64); }
        for (int R = gw; R < NLAT; R += NGW) {
            const int Rn = R + NGW; int nE0 = 0, nE1 = 0, nlr0 = 0, nlr1 = 0, nw0 = 0, nw1 = 0, nblk = 0; u32x4 na = ua, nc = uc;
            if (Rn < NLAT) { const int* rr = rec + (size_t)Rn * 8; nE0 = rr[0]; nE1 = rr[1]; nlr0 = rr[2]; nlr1 = rr[3]; nw0 = rr[4]; nw1 = rr[5]; nblk = rr[6];
                const u32x4* src = (const u32x4*)(U2 + (size_t)Rn * D); na = ld_nt(src + lane); nc = ld_nt(src + lane + 64); }
            const int s0 = poff[E0] + base[blk * 32 + E0] + lr0, s1 = poff[E1] + base[blk * 32 + E1] + lr1;
            u32x4* d0 = (u32x4*)(Xs + (size_t)s0 * D); u32x4* d1 = (u32x4*)(Xs + (size_t)s1 * D);
            d0[lane] = ua; d0[lane + 64] = uc; d1[lane] = ua; d1[lane + 64] = uc;
            if (lane == 0) { int* t4 = ts + (size_t)R * 4; t4[0] = s0; t4[1] = s1; t4[2] = w0b; t4[3] = w1b; }
            E0 = nE0; E1 = nE1; lr0 = nlr0; lr1 = nlr1; w0b = nw0; w1b = nw1; blk = nblk; ua = na; uc = nc;
        }
    }
    for (int e = 0; e < 32; ++e) { const int c = poff[32 + e]; const int lo = poff[e] + c, hi = poff[e] + (((c + 255) >> 8) << 8);
        for (int r = lo + gw; r < hi; r += NGW) { u32x4* d = (u32x4*)(Xs + (size_t)r * D); d[lane] = (u32x4){0u, 0u, 0u, 0u}; d[lane + 64] = (u32x4){0u, 0u, 0u, 0u}; } }
}

struct SchedMoe { int G, c; const int* tile_exp; int ntiles, rep; __device__ __forceinline__ void a_ready(const Unit&) const {} __device__ __forceinline__ void done(const Unit&) const {}
    __device__ __forceinline__ bool next(int i, Unit& u) const {
        const int x = c & 7, y = c >> 3, nxc = G >> 3; int q = i * nxc + y; const int t0 = (x * ntiles) >> 3, t1 = ((x + 1) * ntiles) >> 3, ntot = (t1 - t0) * 4; if (q >= rep * ntot) return false; q %= ntot;
        const int t = t0 + (q >> 2); u.pm = t; u.pn = tile_exp[t] * 4 + (q & 3); return true; } };
struct EpiH {
    static constexpr bool PERM = true, AFTER_DRAIN = false;
    bf16_t* Hs;
    __device__ __forceinline__ void operator()(const f32x4 (&acc)[2][2][4][2], const Unit& u, int wr, int wc, int fr, int fq) const {
        const int j = u.pn & 3;
#pragma unroll
        for (int ai = 0; ai < 2; ++ai)
#pragma unroll
            for (int m = 0; m < 4; ++m) { const int r = u.pm * 256 + ai * 128 + wr * 64 + m * 16 + fr; float o[8];
#pragma unroll
                for (int k = 0; k < 8; ++k) o[k] = silu_f(acc[ai][0][m][k >> 2][k & 3]) * acc[ai][1][m][k >> 2][k & 3];
                *(u32x4*)(Hs + (size_t)r * DE + j * 128 + wc * 32 + 8 * fq) = (u32x4){pk2(o[0], o[1]), pk2(o[2], o[3]), pk2(o[4], o[5]), pk2(o[6], o[7])}; }
    }
};
struct EpiYs {
    static constexpr bool PERM = true, AFTER_DRAIN = false;
    bf16_t* Ys;
    __device__ __forceinline__ void operator()(const f32x4 (&acc)[2][2][4][2], const Unit& u, int wr, int wc, int fr, int fq) const {
        const int j = u.pn & 3;
#pragma unroll
        for (int ai = 0; ai < 2; ++ai)
#pragma unroll
            for (int m = 0; m < 4; ++m) { const int r = u.pm * 256 + ai * 128 + wr * 64 + m * 16 + fr;
#pragma unroll
                for (int bj = 0; bj < 2; ++bj) { const f32x4 v0 = acc[ai][bj][m][0], v1 = acc[ai][bj][m][1];
                    *(u32x4*)(Ys + (size_t)r * D + j * 256 + bj * 128 + wc * 32 + 8 * fq) = (u32x4){pk2(v0[0], v0[1]), pk2(v0[2], v0[3]), pk2(v1[0], v1[1]), pk2(v1[2], v1[3])}; } }
    }
};

__device__ __forceinline__ void phase11(const Params& p, int wave, int lane) {
    const int gw = blockIdx.x * NWAVES + wave, NGW = gridDim.x * NWAVES;
    const float* MOD = (const float*)(p.ws + WS_MOD); const bf16_t* Ys = (const bf16_t*)(p.ws + WS_YS); const int* ts = (const int*)(p.ws + WS_TOKSLOT);
    const float* g2 = p.in[I_LN2G]; const float* b2 = p.in[I_LN2B];
    f32x4 x1[4], nx1[4]; u32x2 ya[4], yc[4], nya[4], nyc[4]; float w0 = 0.f, w1 = 0.f, nw0 = 0.f, nw1 = 0.f;
    if (gw < NLAT) { const int* t4 = ts + (size_t)gw * 4; const int s0 = t4[0], s1 = t4[1]; w0 = __int_as_float(t4[2]); w1 = __int_as_float(t4[3]);
#pragma unroll
        for (int j = 0; j < 4; ++j) { x1[j] = ld_nt((const f32x4*)(p.out + (size_t)gw * D) + lane + 64 * j); ya[j] = ld_nt((const u32x2*)(Ys + (size_t)s0 * D) + lane + 64 * j); yc[j] = ld_nt((const u32x2*)(Ys + (size_t)s1 * D) + lane + 64 * j); } }
    for (int R = gw; R < NLAT; R += NGW) {
        const int Rn = R + NGW;
        if (Rn < NLAT) { const int* t4 = ts + (size_t)Rn * 4; const int s0 = t4[0], s1 = t4[1]; nw0 = __int_as_float(t4[2]); nw1 = __int_as_float(t4[3]);
#pragma unroll
            for (int j = 0; j < 4; ++j) { nx1[j] = ld_nt((const f32x4*)(p.out + (size_t)Rn * D) + lane + 64 * j); nya[j] = ld_nt((const u32x2*)(Ys + (size_t)s0 * D) + lane + 64 * j); nyc[j] = ld_nt((const u32x2*)(Ys + (size_t)s1 * D) + lane + 64 * j); } }
        const int b = R >> 11; float* xr = p.out + (size_t)R * D; const float* gg = MOD + (size_t)b * 6144 + 5120;
        f32x4 v[4]; float s = 0.f;
#pragma unroll
        for (int j = 0; j < 4; ++j) { const int col = 4 * lane + 256 * j; const u32x2 a = ya[j], c = yc[j];
            f32x4 f; f.x = w0 * bflo(a.x) + w1 * bflo(c.x); f.y = w0 * bfhi(a.x) + w1 * bfhi(c.x); f.z = w0 * bflo(a.y) + w1 * bflo(c.y); f.w = w0 * bfhi(a.y) + w1 * bfhi(c.y);
            v[j] = x1[j] * DN_ALPHA + *(const f32x4*)(gg + col) * f; s += (v[j].x + v[j].y) + (v[j].z + v[j].w); }
        const float mean = wave_sum(s) * (1.f / D); float s2 = 0.f;
#pragma unroll
        for (int j = 0; j < 4; ++j) { v[j] = v[j] - mean; s2 += (v[j].x * v[j].x + v[j].y * v[j].y) + (v[j].z * v[j].z + v[j].w * v[j].w); }
        const float rstd = 1.f / sqrtf(wave_sum(s2) * (1.f / D) + LN_EPS);
#pragma unroll
        for (int j = 0; j < 4; ++j) { const int col = 4 * lane + 256 * j; st_nt((f32x4*)xr + lane + 64 * j, v[j] * rstd * *(const f32x4*)(g2 + col) + *(const f32x4*)(b2 + col)); }
#pragma unroll
        for (int j = 0; j < 4; ++j) { x1[j] = nx1[j]; ya[j] = nya[j]; yc[j] = nyc[j]; }
        w0 = nw0; w1 = nw1;
    }
}

#define XB_TMO      128
#define XB_XCNT(j)  (256  + 64 * (j))
#define XB_XSUB(j)  (1280 + 64 * (j))
#define XB_XGEN(j)  (2304 + 64 * (j))
#define XB_TOP      3328
#define XB_TOPGEN   3392
#define XCD_BAR_WORDS 3456
#define XB_SPIN_CAP (1u << 18)

__device__ __forceinline__ unsigned xb_ld(unsigned* p)              { return __hip_atomic_load(p, __ATOMIC_RELAXED, __HIP_MEMORY_SCOPE_AGENT); }
__device__ __forceinline__ unsigned xb_add(unsigned* p, unsigned v) { return __hip_atomic_fetch_add(p, v, __ATOMIC_RELAXED, __HIP_MEMORY_SCOPE_AGENT); }
__device__ __forceinline__ unsigned xb_xcc_id() { return (unsigned)__builtin_amdgcn_s_getreg((3 << 11) | 20) & 0xFu; }
#define XB_SPIN(cond, bar) do { unsigned _sp = 0; while (cond) { __builtin_amdgcn_s_sleep(1); \
    if ((++_sp & 255u) == 0u) { if (xb_ld(&(bar)[XB_TMO])) break; if (_sp > XB_SPIN_CAP) { atomicAdd(&(bar)[XB_TMO], 1u); break; } } } } while (0)

struct XcdBarrier {
    unsigned* bar; unsigned x;
    volatile LAS unsigned* st;
};

__device__ __forceinline__ XcdBarrier xcd_barrier_post(unsigned* bar, volatile LAS unsigned* st) {
    XcdBarrier b; b.bar = bar; b.x = xb_xcc_id(); b.st = st;
    if (threadIdx.x == 0) (void)xb_add(&bar[XB_XCNT(b.x)], 1u);
    return b;
}
__device__ __forceinline__ void xcd_barrier_complete(unsigned* bar, unsigned x, unsigned& nloc, unsigned& nx) {
    const unsigned G = gridDim.x * gridDim.y * gridDim.z;
    unsigned sum, cnt, mine, sp = 0u;
    for (;;) {
        sum = 0u; cnt = 0u; mine = 0u;
#pragma unroll
        for (unsigned j = 0; j < 16; ++j) { const unsigned c = xb_ld(&bar[XB_XCNT(j)]); sum += c; cnt += (c > 0u) ? 1u : 0u; mine = (j == x) ? c : mine; }
        if (sum == G) break;
        __builtin_amdgcn_s_sleep(1);
        if ((++sp & 255u) == 0u) { if (xb_ld(&bar[XB_TMO])) break; if (sp > XB_SPIN_CAP) { atomicAdd(&bar[XB_TMO], 1u); break; } }
    }
    nloc = mine > 0u ? mine : 1u; nx = cnt > 0u ? cnt : 1u;
}

__device__ __forceinline__ void xcd_barrier(const XcdBarrier& b) {
    asm volatile("s_waitcnt vmcnt(0)" ::: "memory");
    __syncthreads();
    if (threadIdx.x == 0) {
        unsigned* bar = b.bar;
        __builtin_amdgcn_s_waitcnt(0);
        unsigned nloc = b.st[0], nx = b.st[1];
        if (nloc == 0u) { xcd_barrier_complete(bar, b.x, nloc, nx); b.st[0] = nloc; b.st[1] = nx; }
        const unsigned old = xb_add(&bar[XB_XSUB(b.x)], 1u);
        const unsigned gen = old / nloc;
        if (old + 1u == (gen + 1u) * nloc) {
            __builtin_amdgcn_fence(__ATOMIC_RELEASE, "agent");
            asm volatile("s_waitcnt vmcnt(0)" ::: "memory");
            const unsigned og = xb_add(&bar[XB_TOP], 1u);
            const unsigned tg = og / nx;
            if (og + 1u == (tg + 1u) * nx) xb_add(&bar[XB_TOPGEN], 1u);
            else XB_SPIN(xb_ld(&bar[XB_TOPGEN]) == tg, bar);
            __builtin_amdgcn_fence(__ATOMIC_ACQUIRE, "agent");
            xb_add(&bar[XB_XGEN(b.x)], 1u);
            asm volatile("s_waitcnt vmcnt(0)" ::: "memory");
        } else {
            XB_SPIN(xb_ld(&bar[XB_XGEN(b.x)]) == gen, bar);
            __builtin_amdgcn_fence(__ATOMIC_ACQUIRE, "agent");
            asm volatile("s_waitcnt vmcnt(0)" ::: "memory");
        }
    }
    __syncthreads();
}

#ifdef USE_SIMPLE_GEMM
#define GEMM_CALL(g, S, E) gemm_simple(g, S, E)
#else
#define GEMM_CALL(g, S, E) pg8::gemm_phase<decltype(E), decltype(S), true, true>(lds, g, S, E)
#endif
#ifdef USE_SIMPLE_SCAN
#define SCAN_CALL scan_phase
#else
#ifdef USE_SCAN2
#define SCAN_CALL scan_phase2
#else
#define SCAN_CALL scan_phase3<0>
#endif
#endif
constexpr int NPHASE = 15;
__global__ void __launch_bounds__(NTHREADS) mega(Params p) {
    extern __shared__ __attribute__((aligned(16))) unsigned char lds_raw[];
    LAS unsigned char* lds = (LAS unsigned char*)lds_raw;
    cg::grid_group grid = cg::this_grid();
    const int tid = threadIdx.x, lane = tid & 63, wave = __builtin_amdgcn_readfirstlane(tid >> 6);
    unsigned char* ws = p.ws;
    const int G = gridDim.x, c = blockIdx.x;
    volatile LAS unsigned* xst = (volatile LAS unsigned*)(lds + LDS_BYTES - 16);
    if (tid < 2) xst[tid] = 0u;
    __syncthreads();
    XcdBarrier xbar; xbar.bar = (unsigned*)(ws + WS_BAR); xbar.x = 0; xbar.st = xst;
#ifndef PHMASK
#define PHMASK 0x7fff
#endif
#define IN(k) (((PHMASK >> (k)) & 1) && p.ph_lo <= (k) && (k) < p.ph_hi)
#define GSYNC() xcd_barrier(xbar)
#define SEAM(k) do { if (IN(k) && IN((k) + 1)) { if ((k) == 0) { grid.sync(); xbar = xcd_barrier_post((unsigned*)(ws + WS_BAR), xst); } else GSYNC(); } } while (0)
#ifndef REPMASK
#define REPMASK 0
#endif
#ifndef REPN
#define REPN 2
#endif
#define GEMMPH ((1 << 2) | (1 << 4) | (1 << 7) | (1 << 9) | (1 << 10) | (1 << 13))
#define GREP(k) ((((REPMASK) >> (k)) & 1) ? REPN : 1)
#define PHASE(k) for (int rep_ = 0; rep_ < (IN(k) ? (((((REPMASK) & ~GEMMPH) >> (k)) & 1) ? REPN : 1) : 0); ++rep_) if (rep_ ? (GSYNC(), true) : true)
    PHASE(0) phase0(p, lds, tid, wave, lane);
    SEAM(0);
    PHASE(1) phase1(p, wave, lane);
    SEAM(1);
    PHASE(2) { Gemm g{(const bf16_t*)(ws + WS_U), (const bf16_t*)(ws + WS_WT_IN), NROW, IN_PHYS, D}; SchedProj<0> S{G, c, GREP(2)}; EpiProj E{ws, p.in[I_BMG], lds, p.in[I_CONVW], p.in[I_CONVB]}; GEMM_CALL(g, S, E); }
    SEAM(2);
    PHASE(3) { ScanArgs a{(const bf16_t*)(ws + WS_RQ), (const bf16_t*)(ws + WS_RK), (const bf16_t*)(ws + WS_RVT), (const float*)(ws + WS_G), p.in[I_DECAY], (bf16_t*)p.out, (bf16_t*)p.out + (size_t)NLAT * D, 0}; SCAN_CALL(lds, a, tid, wave, lane); }
#ifdef SCANPROBE
    if (IN(3)) { GSYNC(); ScanArgs a{(const bf16_t*)(ws + WS_RQ), (const bf16_t*)(ws + WS_RK), (const bf16_t*)(ws + WS_RVT), (const float*)(ws + WS_G), p.in[I_DECAY], (bf16_t*)(ws + WS_X0), (bf16_t*)(ws + WS_X0 + 64 * MiB), 0}; scan_phase3<SCANPROBE>(lds, a, tid, wave, lane); }
#endif
    SEAM(3);
    PHASE(4) { Gemm g{(const bf16_t*)(ws + WS_U), (const bf16_t*)(ws + WS_WT_IN), NROW, IN_PHYS, D}; SchedProj<1> S{G, c, GREP(4)};
        const int pnl = 16 + ((((c >> 3) + 6) & 15) >> 1);
        { LAS float* WL = (LAS float*)(lds + 139264); const float* cwp = p.in[I_CONVW]; const float* cbp = p.in[I_CONVB]; const int cg0 = ((pnl >> 2) - 4) * 1024 + (pnl & 3) * 256;
          for (int i = tid; i < 1024; i += NTHREADS) { const int k = i >> 8, col = i & 255; WL[i] = ((k < 3) ? cwp[k * 2048 + cg0 + col] : cbp[cg0 + col]) * ((pnl >> 2) == 5 ? 0.0625f : 1.f); }
          __syncthreads(); }
        EpiProj E{ws, p.in[I_BMG], lds, p.in[I_CONVW], p.in[I_CONVB], pnl}; GEMM_CALL(g, S, E); }
    if (IN(4) && IN(6)) GSYNC();
    PHASE(6) { ScanArgs a{(const bf16_t*)(ws + WS_MQ), (const bf16_t*)(ws + WS_MK), (const bf16_t*)(ws + WS_MVT), (const float*)(ws + WS_G), p.in[I_DECAY], (bf16_t*)(ws + WS_OMF), (bf16_t*)(ws + WS_OMB), 1}; SCAN_CALL(lds, a, tid, wave, lane); }
    SEAM(6);
    PHASE(7) { Gemm g{(const bf16_t*)(ws + WS_U), (const bf16_t*)(ws + WS_WT_IN), NROW, IN_PHYS, D}; SchedProj<2> S{G, c, GREP(7)}; EpiProj E{ws, p.in[I_BMG], lds, p.in[I_CONVW], p.in[I_CONVB]}; GEMM_CALL(g, S, E); }
    SEAM(7);
    PHASE(8) {
        phase4_one<0>((const bf16_t*)p.out, (const bf16_t*)p.out + (size_t)NLAT * D, (const bf16_t*)(ws + WS_RGA), (bf16_t*)p.out, wave, lane);
        phase4_one<1>((const bf16_t*)(ws + WS_OMF), (const bf16_t*)(ws + WS_OMB), (const bf16_t*)(ws + WS_MOA), (bf16_t*)(ws + WS_M), wave, lane);
    }
    SEAM(8);
    PHASE(9) {
        SchedDense S{G, c, 128, 4, 1}; SchedDense S1{G, c, 128, 4, GREP(9)};
        { Gemm g{(const bf16_t*)p.out, (const bf16_t*)(ws + WS_WT_R), NLAT, D, D}; EpiY E{(bf16_t*)(ws + WS_Y), (const bf16_t*)(ws + WS_GRA), 0}; GEMM_CALL(g, S1, E); }
        { Gemm g{(const bf16_t*)(ws + WS_M), (const bf16_t*)(ws + WS_WT_M), NLAT, D, D}; EpiY E{(bf16_t*)(ws + WS_Y), (const bf16_t*)(ws + WS_GMA), 1}; GEMM_CALL(g, S, E); }
    }
    SEAM(9);
    PHASE(10) { SchedDense S{G, c, 128, 4, GREP(10)}; Gemm g{(const bf16_t*)(ws + WS_Y), (const bf16_t*)(ws + WS_WT_O), NLAT, D, D}; EpiY2 E{(bf16_t*)(ws + WS_Y2)}; GEMM_CALL(g, S, E); }
    SEAM(10);
    PHASE(11) phase7(p, lds, tid, wave, lane);
    SEAM(11);
    PHASE(12) phase8(p, lds, tid, wave, lane);
    SEAM(12);
    PHASE(13) {
        const int ntiles = ((const int*)(ws + WS_CTL))[64];
        SchedMoe S{G, c, (const int*)(ws + WS_TILEEXP), ntiles, GREP(13)};
        Gemm g{(const bf16_t*)(ws + WS_XS), (const bf16_t*)(ws + WS_W13T), MAXSLOT, 32 * 1024, D}; EpiH E{(bf16_t*)(ws + WS_HS)}; GEMM_CALL(g, S, E);
        GSYNC();
        Gemm g2{(const bf16_t*)(ws + WS_HS), (const bf16_t*)(ws + WS_W2T), MAXSLOT, 32 * 1024, DE}; EpiYs E2{(bf16_t*)(ws + WS_YS)}; GEMM_CALL(g2, S, E2);
    }
    SEAM(13);
    PHASE(14) phase11(p, wave, lane);
#undef IN
#undef SEAM
}

extern "C" void kernel_launch(void* const* d_in, const int* in_sizes, int n_in, void* d_out, int out_size, void* d_ws, size_t ws_size, hipStream_t stream) {
    static int grid = 0;
    if (grid == 0) {
        if (n_in != 25 || out_size != NLAT * D || ws_size < WS_NEED) { fprintf(stderr, "kernel_launch: unexpected shapes n_in %d out %d ws %zu; nothing launched\n", n_in, out_size, ws_size); grid = -1; return; }
        int dev = 0, cus = 0, per_cu = 0;
        if (hipGetDevice(&dev) != hipSuccess || hipDeviceGetAttribute(&cus, hipDeviceAttributeMultiprocessorCount, dev) != hipSuccess) { grid = -1; return; }
        if (hipFuncSetAttribute((const void*)mega, hipFuncAttributeMaxDynamicSharedMemorySize, LDS_BYTES) != hipSuccess) { fprintf(stderr, "kernel_launch: hipFuncSetAttribute failed\n"); grid = -1; return; }
        if (hipOccupancyMaxActiveBlocksPerMultiprocessor(&per_cu, (const void*)mega, NTHREADS, LDS_BYTES) != hipSuccess || per_cu < 1) { fprintf(stderr, "kernel_launch: occupancy query says %d\n", per_cu); per_cu = 1; }
        (void)hipGetLastError();
        grid = cus * 1;
        (void)per_cu;
    }
    if (grid < 0) return;
    Params p{};
    for (int i = 0; i < 25; ++i) p.in[i] = (const float*)d_in[i];
    p.out = (float*)d_out; p.ws = (unsigned char*)d_ws; p.ph_lo = 0; p.ph_hi = NPHASE;
    void* args[] = {&p};
    hipError_t e = hipLaunchCooperativeKernel((const void*)mega, dim3(grid), dim3(NTHREADS), args, LDS_BYTES, stream);
    if (e != hipSuccess) fprintf(stderr, "kernel_launch: cooperative launch failed: %s (grid %d)\n", hipGetErrorString(e), grid);
}
```

```cpp
#include <hip/hip_runtime.h>
#include <hip/hip_cooperative_groups.h>
#include <cstdio>
#include <cstdint>
namespace cg = cooperative_groups;

#define LAS __attribute__((address_space(3)))
typedef unsigned short bf16_t;
typedef short bf16x8 __attribute__((ext_vector_type(8)));
typedef float f32x4 __attribute__((ext_vector_type(4)));
typedef float f32x2 __attribute__((ext_vector_type(2)));
typedef unsigned u32x4 __attribute__((ext_vector_type(4)));
typedef unsigned u32x2 __attribute__((ext_vector_type(2)));
typedef __bf16 bf16x2_t __attribute__((ext_vector_type(2)));

constexpr int D = 1024, NB = 16, T = 2048, TC = 256, TT = T + TC;
constexpr int NROW = NB * TT;
constexpr int NLAT = NB * T;
constexpr int NH = 4, DH = 256;
constexpr int IN_COLS = 10256, IN_PHYS = 10496;
constexpr int NE = 32, DE = 512;
constexpr int CH = 64;
constexpr float LN_EPS = 1e-5f;
constexpr float DN_ALPHA = 1.189207115002721f;
constexpr int MAXSLOT = 73728;

constexpr size_t MiB = 1u << 20;
constexpr size_t WS_CTL = 0;
constexpr size_t WS_BAR = 16384;
constexpr size_t WS_WT_IN = 1 * MiB;
constexpr size_t WS_WT_R = 22 * MiB, WS_WT_M = 24 * MiB, WS_WT_O = 26 * MiB;
constexpr size_t WS_MOD = 28 * MiB;
constexpr size_t WS_ROT = 29 * MiB;
constexpr size_t WS_G = 30 * MiB;
constexpr size_t WS_WRT = 33 * MiB;
constexpr size_t WS_TOKREC = 34 * MiB;
constexpr size_t WS_TOKSLOT = 35 * MiB;
constexpr size_t WS_TILEEXP = 36 * MiB;
constexpr size_t WS_BASE = 37 * MiB;
constexpr size_t WS_U = 40 * MiB;
constexpr size_t WS_HS = 40 * MiB;
constexpr size_t WS_X0 = 112 * MiB;
constexpr size_t WS_RQ = 296 * MiB, WS_RK = 368 * MiB, WS_RVT = 440 * MiB;
constexpr size_t WS_MVT = 296 * MiB, WS_MQRAW = 112 * MiB, WS_MKRAW = 184 * MiB;
constexpr size_t WS_MQ = 368 * MiB, WS_MK = 440 * MiB;
constexpr size_t WS_OMF = 112 * MiB, WS_OMB = 176 * MiB;
constexpr size_t WS_RGA = 240 * MiB, WS_MOA = 304 * MiB, WS_GRA = 368 * MiB, WS_GMA = 432 * MiB;
constexpr size_t WS_M = 112 * MiB;
constexpr size_t WS_Y = 176 * MiB;
constexpr size_t WS_Y2 = 112 * MiB;
constexpr size_t WS_U2 = 176 * MiB;
constexpr size_t WS_W13T = 240 * MiB;
constexpr size_t WS_W2T = 304 * MiB;
constexpr size_t WS_XS = 336 * MiB;
constexpr size_t WS_YS = 336 * MiB;
constexpr size_t WS_NEED = 512 * MiB;

constexpr int LDS_BYTES = 147456;
constexpr int NTHREADS = 512, NWAVES = 8;

struct Params { const float* in[25]; float* out; unsigned char* ws; int ph_lo, ph_hi; };
enum { I_X = 0, I_C, I_CTX, I_CCTX, I_WADA, I_BADA, I_WIN, I_BMG, I_CONVW, I_CONVB, I_DECAY, I_WRB, I_WMB, I_WOUT, I_LN1G, I_LN1B,
       I_WRG, I_BRG, I_WRE, I_BRE, I_WE1, I_WE3, I_WE2, I_LN2G, I_LN2B };

__device__ __forceinline__ unsigned pk2(float lo, float hi) { f32x2 v = {lo, hi}; bf16x2_t b = __builtin_convertvector(v, bf16x2_t); return __builtin_bit_cast(unsigned, b); }
__device__ __forceinline__ float bflo(unsigned w) { return __uint_as_float(w << 16); }
__device__ __forceinline__ float bfhi(unsigned w) { return __uint_as_float(w & 0xffff0000u); }
__device__ __forceinline__ float bf2f(bf16_t h) { return __uint_as_float(((unsigned)h) << 16); }
__device__ __forceinline__ bf16_t f2bf(float f) { return (bf16_t)(pk2(f, 0.f) & 0xffffu); }
__device__ __forceinline__ float wave_sum(float v) {
#pragma unroll
    for (int o = 1; o < 64; o <<= 1) v += __shfl_xor(v, o);
    return v;
}
__device__ __forceinline__ float half_sum(float v) {
#pragma unroll
    for (int o = 1; o < 32; o <<= 1) v += __shfl_xor(v, o);
    return v;
}
template <class T> __device__ __forceinline__ T ld_nt(const T* p) { return __builtin_nontemporal_load(p); }
template <class T> __device__ __forceinline__ void st_nt(T* p, const T& v) { __builtin_nontemporal_store(v, p); }
__device__ __forceinline__ float silu_f(float x) { return x / (1.f + __expf(-x)); }
__device__ __forceinline__ float sigmoid_f(float x) { return 1.f / (1.f + __expf(-x)); }
__device__ __forceinline__ float logsigmoid_f(float x) { return fminf(x, 0.f) - log1pf(expf(-fabsf(x))); }
#define MFMA16(a, b, c) __builtin_amdgcn_mfma_f32_16x16x32_bf16((a), (b), (c), 0, 0, 0)

template <int MODE> __device__ __forceinline__ int rowmap(int n) {
    if (MODE == 0) return n;
    if (MODE == 1) {
        if (n < 2048) { const int blk = n >> 10, w = n & 1023, h = w >> 8, dd = w & 255, hb = dd >> 7, part = (dd >> 6) & 1, i = dd & 63; return blk * 1024 + h * 256 + part * 128 + hb * 64 + i; }
        if (n < 8192) return n;
        if (n < 8208) return 10240 + (n - 8192);
        return n - 16;
    }
    if (MODE == 2) return (n >> 7) * 256 + (n & 127);
    return (n >> 7) * 256 + 128 + (n & 127);
}
template <int MODE> __device__ __forceinline__ void transpose_item(const float* W, int K, int N, bf16_t* WT, LAS float* scr, int item, int lane) {
    const int nblk = (N + 31) / 32, kb = item / nblk, nb = item % nblk, k0 = 64 * kb, n0 = 32 * nb;
    const int nn = n0 + (lane & 31);
#pragma unroll 8
    for (int i = 0; i < 32; ++i) { const int kk = 2 * i + (lane >> 5); scr[kk * 33 + (lane & 31)] = (nn < N) ? ld_nt(W + (size_t)(k0 + kk) * N + nn) : 0.f; }
    asm volatile("s_waitcnt lgkmcnt(0)" ::: "memory");
    const int c = lane & 7;
#pragma unroll
    for (int j = 0; j < 4; ++j) { const int n = (lane >> 3) + 8 * j; const LAS float* s = scr + (8 * c) * 33 + n;
        u32x4 o; o.x = pk2(s[0 * 33], s[1 * 33]); o.y = pk2(s[2 * 33], s[3 * 33]); o.z = pk2(s[4 * 33], s[5 * 33]); o.w = pk2(s[6 * 33], s[7 * 33]);
        if (n0 + n < N) *(u32x4*)(WT + (size_t)rowmap<MODE>(n0 + n) * K + k0 + 8 * c) = o; }
    asm volatile("s_waitcnt lgkmcnt(0)" ::: "memory");
}

__device__ __forceinline__ void phase0(const Params& p, LAS unsigned char* lds, int tid, int wave, int lane) {
    const int G = gridDim.x, gw = blockIdx.x * NWAVES + wave, NGW = G * NWAVES;
    unsigned char* ws = p.ws;
    if (blockIdx.x == 0) { if (tid < 64) ((int*)(ws + WS_CTL))[tid] = 0; for (int i = tid; i < 3456; i += NTHREADS) ((unsigned*)(ws + WS_BAR))[i] = 0u; }
    {
        LAS float* scr = (LAS float*)(lds + wave * 8448);
        constexpr int I_IN = 16 * 321, I_SQ = 16 * 32;
        for (int it = gw; it < I_IN + 3 * I_SQ; it += NGW) {
            int r = it;
            if (r < I_IN) { transpose_item<1>(p.in[I_WIN], 1024, IN_COLS, (bf16_t*)(ws + WS_WT_IN), scr, r, lane); continue; } r -= I_IN;
            if (r < I_SQ) { transpose_item<0>(p.in[I_WRB], 1024, 1024, (bf16_t*)(ws + WS_WT_R), scr, r, lane); continue; } r -= I_SQ;
            if (r < I_SQ) { transpose_item<0>(p.in[I_WMB], 1024, 1024, (bf16_t*)(ws + WS_WT_M), scr, r, lane); continue; } r -= I_SQ;
            transpose_item<0>(p.in[I_WOUT], 1024, 1024, (bf16_t*)(ws + WS_WT_O), scr, r, lane);
        }
        u32x4* z = (u32x4*)(ws + WS_WT_IN + (size_t)10256 * 1024 * 2);
        const int nz = 240 * 1024 * 2 / 16;
        for (int i = blockIdx.x * NTHREADS + tid; i < nz; i += G * NTHREADS) z[i] = (u32x4){0u, 0u, 0u, 0u};
    }
    for (int i = blockIdx.x * NTHREADS + tid; i < 4096; i += G * NTHREADS) {
        const int pos = i >> 6, fi = i & 63; const float freq = powf(10000.f, -((float)fi / 64.f)); const float ang = (float)pos * freq;
        ((f32x2*)(ws + WS_ROT))[i] = (f32x2){cosf(ang), sinf(ang)};
    }
    for (int i = blockIdx.x * NTHREADS + tid; i < 48 * 1024; i += G * NTHREADS) {
        const int k = i / 48, o = i - k * 48;
        ((float*)(ws + WS_WRT))[i] = (o < 4) ? p.in[I_WRG][k * 4 + o] : ((o < 36) ? p.in[I_WRE][k * 32 + (o - 4)] : 0.f);
    }
    __syncthreads();
    if ((int)blockIdx.x < 96) {
        LAS float* sl = (LAS float*)lds;
        LAS float* red = (LAS float*)(lds + 17 * 1024 * 4);
        for (int i = tid; i < 17 * 1024; i += NTHREADS) { const int r = i >> 10, k = i & 1023; const float v = (r < 16) ? p.in[I_C][r * 1024 + k] : p.in[I_CCTX][k]; sl[i] = v / (1.f + expf(-v)); }
        __syncthreads();
        for (int it = blockIdx.x; it < 96; it += G) {
            const int col = it * 64 + lane; float acc[17];
#pragma unroll
            for (int r = 0; r < 17; ++r) acc[r] = 0.f;
            const float* wp = p.in[I_WADA] + col;
#pragma unroll 1
            for (int kb = 0; kb < 8; ++kb) {
                const int k0 = wave * 128 + kb * 16; float wv[16];
#pragma unroll
                for (int kk = 0; kk < 16; ++kk) wv[kk] = wp[(size_t)(k0 + kk) * 6144];
#pragma unroll
                for (int kk = 0; kk < 16; ++kk) {
#pragma unroll
                    for (int r = 0; r < 17; ++r) acc[r] += sl[r * 1024 + k0 + kk] * wv[kk];
                    if ((kk & 3) == 3) __builtin_amdgcn_sched_barrier(0);
                }
            }
#pragma unroll
            for (int r = 0; r < 17; ++r) red[(wave * 17 + r) * 64 + lane] = acc[r];
            __syncthreads();
            for (int i = tid; i < 17 * 64; i += NTHREADS) { const int r = i >> 6, l = i & 63; float s = 0.f;
#pragma unroll
                for (int w = 0; w < 8; ++w) s += red[(w * 17 + r) * 64 + l];
                ((float*)(ws + WS_MOD))[r * 6144 + it * 64 + l] = s + p.in[I_BADA][it * 64 + l]; }
            __syncthreads();
        }
    }
}

__device__ __forceinline__ const float* p1_src(const Params& p, int R, int& mr) {
    const int b = R / TT, tt = R - b * TT;
    if (tt < TC) { mr = 16; return p.in[I_CTX] + ((size_t)b * TC + tt) * D; }
    mr = b; return p.in[I_X] + ((size_t)b * T + (tt - TC)) * D;
}
__device__ __forceinline__ void phase1(const Params& p, int wave, int lane) {
    const int gw = blockIdx.x * NWAVES + wave, NGW = gridDim.x * NWAVES;
    const float* MOD = (const float*)(p.ws + WS_MOD); bf16_t* U = (bf16_t*)(p.ws + WS_U);
    f32x4 v[4], nx[4]; int mr = 0, mrn = 0;
    if (gw < NROW) { const float* src = p1_src(p, gw, mr);
#pragma unroll
        for (int j = 0; j < 4; ++j) v[j] = ld_nt((const f32x4*)src + lane + 64 * j); }
    for (int R = gw; R < NROW; R += NGW) {
        const int Rn = R + NGW;
        if (Rn < NROW) { const float* src = p1_src(p, Rn, mrn);
#pragma unroll
            for (int j = 0; j < 4; ++j) nx[j] = ld_nt((const f32x4*)src + lane + 64 * j); }
        const float* sh = MOD + (size_t)mr * 6144; const float* sc = sh + 1024;
        float s = 0.f;
#pragma unroll
        for (int j = 0; j < 4; ++j) s += (v[j].x + v[j].y) + (v[j].z + v[j].w);
        const float mean = wave_sum(s) * (1.f / D); float s2 = 0.f;
#pragma unroll
        for (int j = 0; j < 4; ++j) { v[j] = v[j] - mean; s2 += (v[j].x * v[j].x + v[j].y * v[j].y) + (v[j].z * v[j].z + v[j].w * v[j].w); }
        const float rstd = 1.f / sqrtf(wave_sum(s2) * (1.f / D) + LN_EPS);
        u32x2* o8 = (u32x2*)(U + (size_t)R * D);
#pragma unroll
        for (int j = 0; j < 4; ++j) { const int col = 4 * lane + 256 * j; const f32x4 a = *(const f32x4*)(sh + col), m = *(const f32x4*)(sc + col);
            const f32x4 y = v[j] * rstd * (m + 1.f) + a; o8[lane + 64 * j] = (u32x2){pk2(y.x, y.y), pk2(y.z, y.w)}; }
#pragma unroll
        for (int j = 0; j < 4; ++j) v[j] = nx[j];
        mr = mrn;
    }
}

struct Unit { int pm, pn; int aofs = 0, ovl = 0, sq0 = 0, tq0 = 0, slen = 0; };
struct Gemm { const bf16_t* A; const bf16_t* Bt; int M, N, K; };
template <class Epi, class Sched>
__device__ __forceinline__ void gemm_simple(const Gemm g, const Sched& S, const Epi& E) {
    const int tid = threadIdx.x, wid = __builtin_amdgcn_readfirstlane(tid >> 6), lane = tid & 63, wr = wid >> 2, wc = wid & 3, fr = lane & 15, fq = lane >> 4;
    const int K = g.K;
    Unit u;
    for (int it = 0; S.next(it, u); ++it) {
        f32x4 acc[2][2][4][2];
#pragma unroll
        for (int a = 0; a < 2; ++a)
#pragma unroll
            for (int b = 0; b < 2; ++b)
#pragma unroll
                for (int m = 0; m < 4; ++m)
#pragma unroll
                    for (int n = 0; n < 2; ++n) acc[a][b][m][n] = (f32x4){0.f, 0.f, 0.f, 0.f};
        const bf16_t* Ab = g.A + ((size_t)u.pm * 256 + wr * 64 + fr) * K + 8 * fq;
        const bf16_t* Bb = g.Bt + ((size_t)u.pn * 256 + wc * 32 + fr) * K + 8 * fq;
        for (int k0 = 0; k0 < K; k0 += 32) {
            bf16x8 At[2][4], Bf[2][2];
#pragma unroll
            for (int a = 0; a < 2; ++a)
#pragma unroll
                for (int m = 0; m < 4; ++m) At[a][m] = *(const bf16x8*)(Ab + (size_t)(a * 128 + m * 16) * K + k0);
#pragma unroll
            for (int b = 0; b < 2; ++b)
#pragma unroll
                for (int n = 0; n < 2; ++n) Bf[b][n] = *(const bf16x8*)(Bb + (size_t)(b * 128 + n * 16) * K + k0);
#pragma unroll
            for (int a = 0; a < 2; ++a)
#pragma unroll
                for (int b = 0; b < 2; ++b)
#pragma unroll
                    for (int m = 0; m < 4; ++m)
#pragma unroll
                        for (int n = 0; n < 2; ++n) acc[a][b][m][n] = MFMA16(Bf[b][n], At[a][m], acc[a][b][m][n]);
        }
        E(acc, u, wr, wc, fr, fq);
    }
}


namespace pg8 {
#define PG8_LAS LAS
constexpr int BM = 256, BK = 64, HALF = 128, HTB = HALF * BK * 2  , STAGE_BYTES = 8 * HTB, NXCD = 8, WGM = 8;

__host__ __device__ __forceinline__ int lds_byte(int r, int c) { const int st = (r >> 4) * 2 + (c >> 5), rr = r & 15, cc = c & 31, ob = rr * 64 + cc * 2; return st * 1024 + (ob ^ (((ob >> 9) & 1) << 5)); }
__host__ __device__ __forceinline__ void stage_rc(int b, int& R, int& C) { const int st = b / 1024, sb = b % 1024, swz = sb ^ (((sb >> 9) & 1) << 5); R = (st >> 1) * 16 + swz / 64; C = (st & 1) * 32 + (swz % 64) / 2; }
__host__ __device__ __forceinline__ int perm32(int rho) { const int n = rho >> 4, i = rho & 15; return 8 * (i >> 2) + 4 * n + (i & 3); }
template <class Epi, class Sched, bool ALIGN_EPI = false, bool SP2 = false>
__device__ __forceinline__ void gemm_phase(PG8_LAS unsigned char* lds, const Gemm g, const Sched& S, const Epi& E) {
    const int tid = threadIdx.x, wid = __builtin_amdgcn_readfirstlane(tid >> 6), lane = tid & 63, wr = wid >> 2, wc = wid & 3, fr = lane & 15, fq = lane >> 4;
    const int K = g.K, nt = K / BK;
    unsigned voffA[2], voffB[2];
#pragma unroll
    for (int i = 0; i < 2; ++i) { int R, C; stage_rc(tid * 16 + i * 8192, R, C); const int Rb = Epi::PERM ? ((R & ~31) + perm32(R & 31)) : R;
        voffA[i] = (unsigned)(R * K + C) * 2u; voffB[i] = (unsigned)(Rb * K + C) * 2u; }
    const size_t kstep = (size_t)(BK * 2);
    const size_t hstep = (size_t)HALF * K * 2;
    const size_t tstep = 2 * hstep;
    const unsigned ldsw = (unsigned)wid * 1024u;
    const int aoff = lds_byte(wr * 64 + fr, fq * 8), boff = lds_byte(wc * 32 + fr, fq * 8);
#define PG8_SA(b, h) (((b) * 2 + (h)) * HTB)
#define PG8_SB(b, h) ((4 + (b) * 2 + (h)) * HTB)
#define PG8_STAGE(bufoff, gbase, voff) do { _Pragma("unroll") for (int _i = 0; _i < 2; ++_i) \
        __builtin_amdgcn_global_load_lds((const unsigned*)((const char*)(gbase) + (voff)[_i]), (PG8_LAS unsigned*)(lds + (bufoff) + ldsw + _i * 8192), 16, 0, 0); } while (0)
#define PG8_LDA(dst, b, h) do { _Pragma("unroll") for (int m = 0; m < 4; ++m) _Pragma("unroll") for (int k = 0; k < 2; ++k) dst[m][k] = *(const PG8_LAS bf16x8*)(lds + PG8_SA(b, h) + aoff + m * 2048 + k * 1024); } while (0)
#define PG8_LDB(dst, b, h) do { _Pragma("unroll") for (int n = 0; n < 2; ++n) _Pragma("unroll") for (int k = 0; k < 2; ++k) dst[n][k] = *(const PG8_LAS bf16x8*)(lds + PG8_SB(b, h) + boff + n * 2048 + k * 1024); } while (0)
#define PG8_MMA(ai, bj, At, Bt) do { __builtin_amdgcn_s_setprio(1); _Pragma("unroll") for (int m = 0; m < 4; ++m) _Pragma("unroll") for (int n = 0; n < 2; ++n) _Pragma("unroll") for (int k = 0; k < 2; ++k) \
        acc[ai][bj][m][n] = __builtin_amdgcn_mfma_f32_16x16x32_bf16(Bt[n][k], At[m][k], acc[ai][bj][m][n], 0, 0, 0); __builtin_amdgcn_s_setprio(0); } while (0)
#define PG8_WAIT_V(n) asm volatile("s_waitcnt vmcnt(" #n ")" ::: "memory")
#define PG8_WAIT_L(n) asm volatile("s_waitcnt lgkmcnt(" #n ")" ::: "memory")
#define PG8_BAR __builtin_amdgcn_s_barrier()
#define PG8_SCHED __builtin_amdgcn_sched_barrier(0)
    Unit cur, nxt; int ui = 0;
    if (!S.next(0, cur)) return;
    f32x4 acc[2][2][4][2];
#pragma unroll
    for (int a = 0; a < 2; ++a)
#pragma unroll
        for (int b = 0; b < 2; ++b)
#pragma unroll
            for (int m = 0; m < 4; ++m)
#pragma unroll
                for (int n = 0; n < 2; ++n) acc[a][b][m][n] = (f32x4){0.f, 0.f, 0.f, 0.f};
    bf16x8 At[4][2], B0[2][2], B1[2][2];
    const char* cA = (const char*)g.A + (ptrdiff_t)cur.pm * (ptrdiff_t)tstep + (ptrdiff_t)cur.aofs * (ptrdiff_t)(g.K * 2); const char* cB = (const char*)g.Bt + (size_t)cur.pn * tstep;
    S.a_ready(cur);
    if constexpr (SP2) {
        PG8_STAGE(PG8_SB(0, 0), cB, voffB); PG8_STAGE(PG8_SB(0, 1), cB + hstep, voffB); PG8_STAGE(PG8_SA(0, 0), cA, voffA); PG8_STAGE(PG8_SA(0, 1), cA + hstep, voffA);
        if (wr == 1) PG8_BAR;
        PG8_WAIT_V(2); PG8_BAR;
        PG8_STAGE(PG8_SB(1, 0), cB + kstep, voffB); PG8_STAGE(PG8_SA(1, 0), cA + kstep, voffA); PG8_STAGE(PG8_SB(1, 1), cB + hstep + kstep, voffB);
        PG8_WAIT_V(6); PG8_BAR;
    } else {
        PG8_STAGE(PG8_SB(0, 0), cB, voffB); PG8_STAGE(PG8_SA(0, 0), cA, voffA); PG8_STAGE(PG8_SB(0, 1), cB + hstep, voffB); PG8_STAGE(PG8_SA(0, 1), cA + hstep, voffA);
        if (wr == 1) PG8_BAR;
        PG8_WAIT_V(4); PG8_BAR;
        PG8_STAGE(PG8_SB(1, 0), cB + kstep, voffB); PG8_STAGE(PG8_SA(1, 0), cA + kstep, voffA); PG8_STAGE(PG8_SB(1, 1), cB + hstep + kstep, voffB);
        PG8_WAIT_V(6); PG8_BAR;
    }
    for (;;) {
        const bool has_next = S.next(ui + 1, nxt);
        const char* nA = has_next ? (const char*)g.A + (ptrdiff_t)nxt.pm * (ptrdiff_t)tstep + (ptrdiff_t)nxt.aofs * (ptrdiff_t)(g.K * 2) : cA; const char* nB = has_next ? (const char*)g.Bt + (size_t)nxt.pn * tstep : cB;
        for (int t = 0; t < nt; t += 2) {
            const bool last = (t == nt - 2);
            const char* a1 = cA + (size_t)(t + 1) * kstep;
            const char* a2 = last ? nA : cA + (size_t)(t + 2) * kstep; const char* b2 = last ? nB : cB + (size_t)(t + 2) * kstep;
            const char* a3 = a2 + kstep; const char* b3 = b2 + kstep;
            if (last && has_next) S.a_ready(nxt);
            if constexpr (SP2) {
            PG8_LDB(B0, 0, 0); PG8_LDB(B1, 0, 1); PG8_SCHED; PG8_LDA(At, 0, 0); PG8_STAGE(PG8_SA(1, 1), a1 + hstep, voffA);
            PG8_WAIT_V(8); PG8_WAIT_L(0); PG8_BAR; PG8_MMA(0, 0, At, B0); PG8_MMA(0, 1, At, B1); PG8_BAR; PG8_SCHED;
            PG8_LDA(At, 0, 1); PG8_STAGE(PG8_SB(0, 0), b2, voffB); PG8_STAGE(PG8_SB(0, 1), b2 + hstep, voffB); PG8_STAGE(PG8_SA(0, 0), a2, voffA);
            PG8_WAIT_V(8); PG8_WAIT_L(0); PG8_BAR; PG8_MMA(1, 0, At, B0); PG8_MMA(1, 1, At, B1); PG8_BAR; PG8_SCHED;
            PG8_LDB(B0, 1, 0); PG8_LDB(B1, 1, 1); PG8_SCHED; PG8_LDA(At, 1, 0); PG8_STAGE(PG8_SA(0, 1), a2 + hstep, voffA);
            PG8_WAIT_V(8); PG8_WAIT_L(0); PG8_BAR; PG8_MMA(0, 0, At, B0); PG8_MMA(0, 1, At, B1); PG8_BAR; PG8_SCHED;
            PG8_LDA(At, 1, 1); PG8_STAGE(PG8_SB(1, 0), b3, voffB); PG8_STAGE(PG8_SB(1, 1), b3 + hstep, voffB); PG8_STAGE(PG8_SA(1, 0), a3, voffA);
            PG8_WAIT_V(8); PG8_WAIT_L(0); PG8_BAR; PG8_MMA(1, 0, At, B0); PG8_MMA(1, 1, At, B1); PG8_BAR; PG8_SCHED;
            } else {
            PG8_LDB(B0, 0, 0); PG8_SCHED; PG8_LDA(At, 0, 0); PG8_STAGE(PG8_SA(1, 1), a1 + hstep, voffA);
            PG8_WAIT_L(8); PG8_BAR; PG8_WAIT_L(0); PG8_MMA(0, 0, At, B0); PG8_BAR; PG8_SCHED;
            PG8_LDB(B1, 0, 1); PG8_STAGE(PG8_SB(0, 0), b2, voffB);
            PG8_BAR; PG8_WAIT_L(0); PG8_MMA(0, 1, At, B1); PG8_BAR;
            PG8_LDA(At, 0, 1); PG8_STAGE(PG8_SA(0, 0), a2, voffA);
            PG8_BAR; PG8_WAIT_L(0); PG8_MMA(1, 0, At, B0); PG8_BAR; PG8_SCHED;
            PG8_STAGE(PG8_SB(0, 1), b2 + hstep, voffB);
            PG8_WAIT_V(6); PG8_BAR; PG8_MMA(1, 1, At, B1); PG8_BAR;
            PG8_LDB(B0, 1, 0); PG8_SCHED; PG8_LDA(At, 1, 0); PG8_STAGE(PG8_SA(0, 1), a2 + hstep, voffA);
            PG8_WAIT_L(8); PG8_BAR; PG8_WAIT_L(0); PG8_MMA(0, 0, At, B0); PG8_BAR; PG8_SCHED;
            PG8_LDB(B1, 1, 1); PG8_STAGE(PG8_SB(1, 0), b3, voffB);
            PG8_BAR; PG8_WAIT_L(0); PG8_MMA(0, 1, At, B1); PG8_BAR;
            PG8_LDA(At, 1, 1); PG8_STAGE(PG8_SA(1, 0), a3, voffA);
            PG8_BAR; PG8_WAIT_L(0); PG8_MMA(1, 0, At, B0); PG8_BAR; PG8_SCHED;
            PG8_STAGE(PG8_SB(1, 1), b3 + hstep, voffB);
            PG8_WAIT_V(6); PG8_BAR; PG8_MMA(1, 1, At, B1); PG8_BAR;
            }
        }
        if constexpr (ALIGN_EPI) { if (wr == 0) PG8_BAR; }
        if constexpr (!Epi::AFTER_DRAIN) { E(acc, cur, wr, wc, fr, fq); S.done(cur); }
        if (!has_next) break;
#pragma unroll
        for (int a = 0; a < 2; ++a)
#pragma unroll
            for (int b = 0; b < 2; ++b)
#pragma unroll
                for (int m = 0; m < 4; ++m)
#pragma unroll
                    for (int n = 0; n < 2; ++n) acc[a][b][m][n] = (f32x4){0.f, 0.f, 0.f, 0.f};
        cur = nxt; cA = nA; cB = nB; ++ui;
        if constexpr (ALIGN_EPI) { if (wr == 1) PG8_BAR; }
    }
    PG8_WAIT_V(0);
    if constexpr (!ALIGN_EPI) { if (wr == 0) PG8_BAR; }
    PG8_BAR;
    if constexpr (Epi::AFTER_DRAIN) { E.fused(acc, cur, wr, wc, fr, fq, lds, wid, lane); S.done(cur); }
#undef PG8_SA
#undef PG8_SB
#undef PG8_STAGE
#undef PG8_LDA
#undef PG8_LDB
#undef PG8_MMA
#undef PG8_WAIT_V
#undef PG8_WAIT_L
#undef PG8_BAR
#undef PG8_SCHED
}
}

template <int PH> struct SchedProj {
    int G, c, rep;
    __device__ __forceinline__ void a_ready(const Unit&) const {}
    __device__ __forceinline__ void done(const Unit&) const {}
    static __device__ __forceinline__ int nlat() { return PH == 0 ? 12 : (PH == 1 ? 13 : 16); }
    static __device__ __forceinline__ int nctx() { return PH == 0 ? 8 : (PH == 1 ? 9 : 0); }
    __device__ __forceinline__ bool next(int i, Unit& u) const {
        const int x = c & 7, y = c >> 3, nxc = G >> 3;
        int q = i * nxc + y;
        u.aofs = 0; u.ovl = 0; u.sq0 = 0; u.tq0 = 0; u.slen = 0;
        if (PH == 1) {
            constexpr int UA = 144, UB = 80, UC = 16, UD = 10, ntot = UA + UB + UC + UD;
            if (q >= rep * ntot) return false;
            q %= ntot;
            if (q < UB) { const int grp = q / 20, rem = q - grp * 20, idx = rem >> 2, pmi = x + 8 * (grp * 4 + (rem & 3)); u.pm = (pmi >> 3) * 9 + 1 + (pmi & 7); u.pn = (idx < 4) ? 24 + idx : 40; return true; }
            q -= UB;
            if (q < UD) { const int bsel = q / 5, idx = q - bsel * 5; u.pm = (x + 8 * bsel) * 9; u.pn = (idx < 4) ? 24 + idx : 40; return true; }
            q -= UD;
            if (q < UA) { const int k = (q >> 4) * 2 + (q & 1), pi = (q & 15) >> 1, tau = x + 8 * k, b = tau / 9, j = tau - b * 9;
                u.pm = 0; u.pn = 16 + pi; u.ovl = 1; u.sq0 = b * TT + TC; u.tq0 = 254 * j - 1; u.slen = T; u.aofs = u.sq0 + u.tq0; return true; }
            q -= UA;
            { const int tau = x + 8 * (q & 3), pi = q >> 2, b = tau >> 1, j = tau & 1;
                u.pm = 0; u.pn = 20 + pi; u.ovl = 1; u.sq0 = b * TT; u.tq0 = 254 * j - 1; u.slen = TC; u.aofs = u.sq0 + u.tq0; return true; }
        }
        const int nl = 16 * nlat(), ntot = nl + 2 * nctx();
        if (q >= rep * ntot) return false;
        q %= ntot;
        int idx;
        if (q < nl) { const int grp = q / (4 * nlat()), rem = q - grp * 4 * nlat(); idx = rem >> 2; const int pmi = x + 8 * (grp * 4 + (rem & 3)); u.pm = (pmi >> 3) * 9 + 1 + (pmi & 7);
            if (PH == 0) u.pn = idx; else u.pn = (idx < 4) ? 12 + idx : 24 + idx;
            return true; }
        q -= nl; const int bsel = q / (nctx() > 0 ? nctx() : 1); idx = q - bsel * nctx(); u.pm = (x + 8 * bsel) * 9;
        u.pn = 4 + idx;
        return true;
    }
};
struct EpiProj {
    static constexpr bool PERM = true, AFTER_DRAIN = false;
    unsigned char* ws; const float* b_mgate; LAS unsigned char* lds; const float* cw; const float* cb; int pn_lds = -1;
    template <int CTRL> static __device__ __forceinline__ float dpp_f(float v) { return __builtin_bit_cast(float, __builtin_amdgcn_update_dpp(0, __builtin_bit_cast(int, v), CTRL, 0xF, 0xF, true)); }
    __device__ __forceinline__ void operator()(const f32x4 (&acc)[2][2][4][2], const Unit& u, int wr, int wc, int fr, int fq) const {
        const int pn = u.pn;
        if (u.ovl) {
            const int blk = pn >> 2, h = pn & 3; int cw0 = wc * 32 + 8 * fq;
            asm volatile("" : "+v"(cw0));
            LAS float* XB = (LAS float*)(lds + 131072);
#pragma unroll
            for (int ai = 0; ai < 2; ++ai) { const int gm = 2 * ai + wr;
                if (fr == 0) {
#pragma unroll
                    for (int bj = 0; bj < 2; ++bj) { LAS f32x4* d = (LAS f32x4*)(XB + (gm * 2 + 0) * 256 + bj * 128 + cw0); d[0] = acc[ai][bj][0][0]; d[1] = acc[ai][bj][0][1]; } }
                if (fr == 15) {
#pragma unroll
                    for (int bj = 0; bj < 2; ++bj) { LAS f32x4* d = (LAS f32x4*)(XB + (gm * 2 + 1) * 256 + bj * 128 + cw0); d[0] = acc[ai][bj][3][0]; d[1] = acc[ai][bj][3][1]; } } }
            asm volatile("s_waitcnt lgkmcnt(0)\n\ts_barrier" ::: "memory");
            bf16_t* dst = (bf16_t*)(ws + (blk == 4 ? WS_MQ : WS_MK));
            const float scl = (blk == 5) ? 0.0625f : 1.f, nl2e = (blk == 5) ? -16.f * 1.4426950408889634f : -1.4426950408889634f;
#pragma unroll
            for (int bj = 0; bj < 2; ++bj) {
                const int cg = (blk - 4) * 1024 + h * 256 + bj * 128 + cw0;
                f32x4 w0[2], w1[2], w2[2], bs[2];
                if (pn == pn_lds) {
                    LAS const float* WL = (LAS const float*)(lds + 139264) + bj * 128 + cw0;
#pragma unroll
                    for (int n = 0; n < 2; ++n) { w0[n] = *(LAS const f32x4*)(WL + 4 * n); w1[n] = *(LAS const f32x4*)(WL + 256 + 4 * n); w2[n] = *(LAS const f32x4*)(WL + 512 + 4 * n); bs[n] = *(LAS const f32x4*)(WL + 768 + 4 * n); }
                } else {
#pragma unroll
                    for (int n = 0; n < 2; ++n) { w0[n] = *(const f32x4*)(cw + cg + 4 * n) * scl; w1[n] = *(const f32x4*)(cw + 2048 + cg + 4 * n) * scl; w2[n] = *(const f32x4*)(cw + 4096 + cg + 4 * n) * scl; bs[n] = *(const f32x4*)(cb + cg + 4 * n) * scl; }
                }
#pragma unroll
                for (int ai = 0; ai < 2; ++ai) { const int gm = 2 * ai + wr;
#pragma unroll
                    for (int m = 0; m < 4; ++m) {
                        __builtin_amdgcn_sched_barrier(0);
                        const int rho = 128 * ai + 64 * wr + 16 * m + fr, t = u.tq0 + rho;
                        f32x4 hx[2];
                        if (m == 0) { hx[0] = *(LAS const f32x4*)(XB + ((gm > 0 ? gm - 1 : 0) * 2 + 1) * 256 + bj * 128 + cw0); hx[1] = *(LAS const f32x4*)(XB + ((gm > 0 ? gm - 1 : 0) * 2 + 1) * 256 + bj * 128 + cw0 + 4); }
                        if (m == 3) { hx[0] = *(LAS const f32x4*)(XB + ((gm < 3 ? gm + 1 : 3) * 2 + 0) * 256 + bj * 128 + cw0); hx[1] = *(LAS const f32x4*)(XB + ((gm < 3 ? gm + 1 : 3) * 2 + 0) * 256 + bj * 128 + cw0 + 4); }
                        unsigned pk[4];
#pragma unroll
                        for (int kp = 0; kp < 4; ++kp) { const int n = kp >> 1, j0 = (2 * kp) & 3;
                            f32x2 cur, pv, nv;
#pragma unroll
                            for (int jj = 0; jj < 2; ++jj) { const int j = j0 + jj;
                                const float cu = acc[ai][bj][m][n][j];
                                float xs = (fr == 15) ? (m == 0 ? hx[n][j] : acc[ai][bj][m > 0 ? m - 1 : 0][n][j]) : cu;
                                float ys = (fr == 0) ? (m == 3 ? hx[n][j] : acc[ai][bj][m < 3 ? m + 1 : 3][n][j]) : cu;
                                if (ai == 0 && m <= 1) { if (t == -1) xs = 0.f; if (t == u.slen) ys = 0.f; }
                                cur[jj] = cu; pv[jj] = dpp_f<0x121>(xs); nv[jj] = dpp_f<0x12F>(ys); }
                            const f32x2 a0 = {w0[n][j0], w0[n][j0 + 1]}, a1 = {w1[n][j0], w1[n][j0 + 1]}, a2 = {w2[n][j0], w2[n][j0 + 1]}, ab = {bs[n][j0], bs[n][j0 + 1]};
                            f32x2 z = __builtin_elementwise_fma(a1, cur, ab);
                            z = __builtin_elementwise_fma(a0, pv, z);
                            z = __builtin_elementwise_fma(a2, nv, z);
                            const f32x2 ez = z * nl2e;
                            f32x2 den = {__builtin_amdgcn_exp2f(ez[0]), __builtin_amdgcn_exp2f(ez[1])};
                            den = den + 1.f;
                            const f32x2 rc = {__builtin_amdgcn_rcpf(den[0]), __builtin_amdgcn_rcpf(den[1])};
                            const f32x2 o = z * rc;
                            pk[kp] = pk2(o[0], o[1]);
                        }
                        if (rho >= 1 && rho <= 254 && t < u.slen) *(u32x4*)(dst + (size_t)(u.sq0 + t) * D + h * 256 + bj * 128 + cw0) = (u32x4){pk[0], pk[1], pk[2], pk[3]};
                    }
                }
            }
            return;
        }
        if (pn == 40) {
            if (wc != 0 || fq >= 2) return;
            float* Gt = (float*)(ws + WS_G);
#pragma unroll
            for (int ai = 0; ai < 2; ++ai)
#pragma unroll
                for (int m = 0; m < 4; ++m) { const int r = u.pm * 256 + ai * 128 + wr * 64 + m * 16 + fr, b = r / TT, tt = r - b * TT;
#pragma unroll
                    for (int k = 0; k < 8; ++k) { const int c = 8 * fq + k; float v = acc[ai][0][m][k >> 2][k & 3] + b_mgate[c]; if ((c >> 2) & 1) v = logsigmoid_f(v);
                        Gt[((size_t)b * 16 + c) * TT + tt] = v; } }
            return;
        }
        const int blk = pn >> 2, h = pn & 3;
        if (blk < 2) {
            bf16_t* dst = (bf16_t*)(ws + (blk == 0 ? WS_RQ : WS_RK));
            const float* ROT = (const float*)(ws + WS_ROT);
            const float scl = (blk == 1) ? 0.0625f : 1.f;
            const int q = wc * 32 + 8 * fq, hb = q >> 6, i0 = q & 63;
#pragma unroll
            for (int ai = 0; ai < 2; ++ai)
#pragma unroll
                for (int m = 0; m < 4; ++m) { const int r = u.pm * 256 + ai * 128 + wr * 64 + m * 16 + fr, b = r / TT, tt = r - b * TT; const bool lat = tt >= TC; const int t = tt - TC;
                    float o1[8], o2[8];
                    if (lat) { const int pos = hb ? (t & 63) : (t >> 6); const f32x4* rp = (const f32x4*)(ROT + (size_t)(pos * 64 + i0) * 2);
#pragma unroll
                        for (int k2 = 0; k2 < 4; ++k2) { const f32x4 cs = rp[k2];
                            const float a0 = acc[ai][0][m][k2 >> 1][(2 * k2) & 3], a1 = acc[ai][0][m][k2 >> 1][(2 * k2 + 1) & 3], b0 = acc[ai][1][m][k2 >> 1][(2 * k2) & 3], b1 = acc[ai][1][m][k2 >> 1][(2 * k2 + 1) & 3];
                            o1[2 * k2] = a0 * cs[0] - b0 * cs[1]; o2[2 * k2] = a0 * cs[1] + b0 * cs[0]; o1[2 * k2 + 1] = a1 * cs[2] - b1 * cs[3]; o2[2 * k2 + 1] = a1 * cs[3] + b1 * cs[2]; } }
                    else {
#pragma unroll
                        for (int k = 0; k < 8; ++k) { o1[k] = acc[ai][0][m][k >> 2][k & 3]; o2[k] = acc[ai][1][m][k >> 2][k & 3]; } }
                    bf16_t* rowp = dst + (size_t)r * D + h * 256 + q;
                    *(u32x4*)(rowp) = (u32x4){pk2(o1[0] * scl, o1[1] * scl), pk2(o1[2] * scl, o1[3] * scl), pk2(o1[4] * scl, o1[5] * scl), pk2(o1[6] * scl, o1[7] * scl)};
                    *(u32x4*)(rowp + 128) = (u32x4){pk2(o2[0] * scl, o2[1] * scl), pk2(o2[2] * scl, o2[3] * scl), pk2(o2[4] * scl, o2[5] * scl), pk2(o2[6] * scl, o2[7] * scl)}; }
            return;
        }
        if (blk == 2 || blk == 6) {
            bf16_t* dst = (bf16_t*)(ws + (blk == 2 ? WS_RVT : WS_MVT));
#pragma unroll
            for (int ai = 0; ai < 2; ++ai)
#pragma unroll
                for (int m = 0; m < 4; ++m) { const int r = u.pm * 256 + ai * 128 + wr * 64 + m * 16 + fr, b = r / TT, tt = r - b * TT;
                    bf16_t* bp = dst + ((size_t)(b * 4 + h) * 256) * TT + tt;
#pragma unroll
                    for (int bj = 0; bj < 2; ++bj)
#pragma unroll
                        for (int k = 0; k < 8; ++k) { const int e = bj * 128 + wc * 32 + 8 * fq + k; bp[(size_t)e * TT] = f2bf(acc[ai][bj][m][k >> 2][k & 3]); } }
            return;
        }
        if (blk == 4 || blk == 5) {
            bf16_t* dst = (bf16_t*)(ws + (blk == 4 ? WS_MQRAW : WS_MKRAW));
#pragma unroll
            for (int ai = 0; ai < 2; ++ai)
#pragma unroll
                for (int m = 0; m < 4; ++m) { const int r = u.pm * 256 + ai * 128 + wr * 64 + m * 16 + fr;
#pragma unroll
                    for (int bj = 0; bj < 2; ++bj) { const f32x4 v0 = acc[ai][bj][m][0], v1 = acc[ai][bj][m][1]; const int c = h * 256 + bj * 128 + wc * 32 + 8 * fq;
                        *(u32x4*)(dst + (size_t)r * D + c) = (u32x4){pk2(v0[0], v0[1]), pk2(v0[2], v0[3]), pk2(v1[0], v1[1]), pk2(v1[2], v1[3])}; } }
            return;
        }
        {
            bf16_t* dst = (bf16_t*)(ws + (blk == 3 ? WS_RGA : (blk == 7 ? WS_MOA : (blk == 8 ? WS_GRA : WS_GMA))));
#pragma unroll
            for (int ai = 0; ai < 2; ++ai)
#pragma unroll
                for (int m = 0; m < 4; ++m) { const int r = u.pm * 256 + ai * 128 + wr * 64 + m * 16 + fr, b = r / TT, tt = r - b * TT; const int rl = b * T + (tt - TC);
#pragma unroll
                    for (int bj = 0; bj < 2; ++bj) { f32x4 v0 = acc[ai][bj][m][0], v1 = acc[ai][bj][m][1]; const int c = h * 256 + bj * 128 + wc * 32 + 8 * fq;
                        if (blk >= 8) { _Pragma("unroll") for (int j = 0; j < 4; ++j) { v0[j] = sigmoid_f(v0[j]); v1[j] = sigmoid_f(v1[j]); } }
                        if (tt >= TC) *(u32x4*)(dst + (size_t)rl * D + c) = (u32x4){pk2(v0[0], v0[1]), pk2(v0[2], v0[3]), pk2(v1[0], v1[1]), pk2(v1[2], v1[3])}; } }
        }
    }
};

__device__ __forceinline__ void phase_conv(const Params& p, int tid) {
    const bf16_t* QR = (const bf16_t*)(p.ws + WS_MQRAW); const bf16_t* KR = (const bf16_t*)(p.ws + WS_MKRAW);
    bf16_t* QO = (bf16_t*)(p.ws + WS_MQ); bf16_t* KO = (bf16_t*)(p.ws + WS_MK);
    const float* cw = p.in[I_CONVW]; const float* cb = p.in[I_CONVB];
    const int gt = blockIdx.x * NTHREADS + tid, nthr = gridDim.x * NTHREADS, ch = gt & 127;
    constexpr int NGRP = NROW / 8;
#pragma unroll 1
    for (int which = 0; which < 2; ++which) {
        const int c0 = which * 1024 + ch * 8; const float scl = which ? 0.0625f : 1.f;
        float w0[8], w1[8], w2[8], bs[8];
#pragma unroll
        for (int j = 0; j < 8; ++j) { w0[j] = cw[c0 + j]; w1[j] = cw[2048 + c0 + j]; w2[j] = cw[4096 + c0 + j]; bs[j] = cb[c0 + j]; }
        const bf16_t* srcb = (which ? KR : QR) + ch * 8; bf16_t* dstb = (which ? KO : QO) + ch * 8;
        for (int g = gt >> 7; g < NGRP; g += nthr >> 7) {
            const int R0 = g * 8, tt = R0 % TT;
            if (which == 0 && tt < TC) continue;
            const bool hasp = !(tt == 0 || tt == TC), hasn = !(tt + 7 == TC - 1 || tt + 7 == TT - 1);
            u32x4 rw[10];
            rw[0] = hasp ? ld_nt((const u32x4*)(srcb + (size_t)(R0 - 1) * D)) : (u32x4){0u, 0u, 0u, 0u};
#pragma unroll
            for (int i = 0; i < 8; ++i) rw[1 + i] = ld_nt((const u32x4*)(srcb + (size_t)(R0 + i) * D));
            rw[9] = hasn ? ld_nt((const u32x4*)(srcb + (size_t)(R0 + 8) * D)) : (u32x4){0u, 0u, 0u, 0u};
#pragma unroll
            for (int i = 0; i < 8; ++i) {
                float o[8];
#pragma unroll
                for (int j = 0; j < 4; ++j) {
                    const float a = w0[2 * j] * bflo(rw[i][j]) + w1[2 * j] * bflo(rw[i + 1][j]) + w2[2 * j] * bflo(rw[i + 2][j]) + bs[2 * j];
                    const float c = w0[2 * j + 1] * bfhi(rw[i][j]) + w1[2 * j + 1] * bfhi(rw[i + 1][j]) + w2[2 * j + 1] * bfhi(rw[i + 2][j]) + bs[2 * j + 1];
                    o[2 * j] = silu_f(a) * scl; o[2 * j + 1] = silu_f(c) * scl;
                }
                *(u32x4*)(dstb + (size_t)(R0 + i) * D) = (u32x4){pk2(o[0], o[1]), pk2(o[2], o[3]), pk2(o[4], o[5]), pk2(o[6], o[7])};
            }
        }
    }
}

struct ScanArgs { const bf16_t* Q; const bf16_t* K; const bf16_t* VT; const float* G; const float* decay; bf16_t* Of; bf16_t* Ob; int is_ml; };
constexpr int SC_S = 0;
constexpr int SC_ATT = 131072;
constexpr int ATT_LD = 72;
constexpr int SC_VEC = SC_ATT + 64 * ATT_LD * 2;
__device__ __forceinline__ void scan_phase(LAS unsigned char* lds, const ScanArgs a, int tid, int wave, int lane) {
    LAS float* Sm = (LAS float*)(lds + SC_S);
    LAS bf16_t* att = (LAS bf16_t*)(lds + SC_ATT);
    LAS float* vec = (LAS float*)(lds + SC_VEC);
    LAS float* rowv = vec, *colv = vec + 64, *aq = vec + 128, *kd = vec + 192, *emr = vec + 256, *cv = vec + 320, *av = vec + 384, *mxv = vec + 448, *qn = vec + 512, *denp = vec + 576, *nv = vec + 832, *scal = vec + 1088;
    const int fr = lane & 15, fq = lane >> 4;
    for (int item = blockIdx.x; item < 256; item += gridDim.x) {
        const int eh = item & 1, dir = (item >> 1) & 1, h = (item >> 2) & 3, b = item >> 4;
        __syncthreads();
        for (int i = tid; i < 256 * 128; i += NTHREADS) Sm[i] = 0.f;
        if (tid < 256) nv[tid] = 0.f;
        if (tid == 0) { scal[0] = 0.f;   scal[1] = 1.f;   }
        const float lg = a.is_ml ? 0.f : logsigmoid_f(a.decay[dir * 4 + h]);
        const float* Gi = a.G + ((size_t)b * 16 + (dir ? 8 : 0) + h) * TT;
        const float* Gf = a.G + ((size_t)b * 16 + (dir ? 12 : 4) + h) * TT;
        bf16_t* Oo = dir ? a.Ob : a.Of;
        __syncthreads();
        for (int st = 0; st < 36; ++st) {
            int tt0;
            if (st < 4) tt0 = (dir ? (3 - st) : st) * CH; else tt0 = TC + (dir ? (35 - st) : (st - 4)) * CH;
            const bool lat = st >= 4;
            const size_t R0 = (size_t)b * TT + tt0;
            if (a.is_ml) {
                if (tid == 0) {
                    const float mst = scal[0];
                    float run = 0.f;
                    if (dir == 0) { for (int l = 0; l < CH; ++l) { run += Gf[tt0 + l]; cv[l] = run; } }
                    else { for (int l = CH - 1; l >= 0; --l) { run += Gf[tt0 + l]; cv[l] = run; } }
                    const float ctot = run;
                    float mxr = -1e30f;
                    if (dir == 0) { for (int l = 0; l < CH; ++l) { const float x = Gi[tt0 + l] - cv[l]; av[l] = x; mxr = fmaxf(mxr, x); mxv[l] = mxr; } }
                    else { for (int l = CH - 1; l >= 0; --l) { mxv[l] = mxr; const float x = Gi[tt0 + l] - cv[l]; av[l] = x; mxr = fmaxf(mxr, x); } }
                    const float mnew = fmaxf(ctot + mst, ctot + mxr);
                    scal[1] = expf(ctot + mst - mnew); scal[2] = ctot; scal[3] = mnew; scal[4] = mst;
                }
                __syncthreads();
                if (tid < CH) { const int l = tid; const float mst = scal[4], ctot = scal[2], mnew = scal[3];
                    const float mrow = fmaxf(cv[l] + mxv[l], cv[l] + mst);
                    rowv[l] = cv[l] - mrow; colv[l] = av[l]; aq[l] = expf(cv[l] + mst - mrow); emr[l] = expf(-mrow); kd[l] = expf(ctot + av[l] - mnew); }
                if (tid == 0) scal[0] = scal[3];
            } else {
                if (tid < CH) { const int l = tid;
                    rowv[l] = (dir ? -(float)l : (float)l) * lg; colv[l] = (dir ? (float)l : -(float)l) * lg;
                    aq[l] = expf((float)(dir ? (CH - l) : (l + 1)) * lg); kd[l] = expf((float)(dir ? l : (CH - 1 - l)) * lg); emr[l] = 0.f; }
                if (tid == 0) scal[1] = expf((float)CH * lg);
            }
            __syncthreads();
            if (lat) {
#pragma unroll
                for (int tq = 0; tq < 2; ++tq) {
                    const int ti = wave * 2 + tq, lt = ti >> 2, mt = ti & 3, l0 = lt * 16, m0 = mt * 16;
                    f32x4 acc = (f32x4){0.f, 0.f, 0.f, 0.f};
                    const bf16_t* kp = a.K + (R0 + m0 + fr) * D + h * 256 + 8 * fq;
                    const bf16_t* qp = a.Q + (R0 + l0 + fr) * D + h * 256 + 8 * fq;
#pragma unroll
                    for (int d0 = 0; d0 < 256; d0 += 32) { const bf16x8 ka = *(const bf16x8*)(kp + d0), qb = *(const bf16x8*)(qp + d0); acc = MFMA16(ka, qb, acc); }
                    const int l = l0 + fr; const float rv = rowv[l]; float o[4]; float s = 0.f;
#pragma unroll
                    for (int r = 0; r < 4; ++r) { const int m = m0 + 4 * fq + r; const bool ok = dir ? (m > l) : (m <= l); const float w = ok ? __expf(rv + colv[m]) : 0.f; o[r] = acc[r] * w; s += o[r]; }
                    *(LAS u32x2*)(att + l * ATT_LD + m0 + 4 * fq) = (u32x2){pk2(o[0], o[1]), pk2(o[2], o[3])};
                    s += __shfl_xor(s, 16); s += __shfl_xor(s, 32);
                    if (fq == 0) denp[l * 4 + mt] = s;
                }
                if (a.is_ml && tid < CH) { const int l = tid; const bf16_t* qp = a.Q + (R0 + l) * D + h * 256; float s = 0.f;
                    for (int d = 0; d < 256; d += 8) { const u32x4 w = *(const u32x4*)(qp + d);
#pragma unroll
                        for (int j = 0; j < 4; ++j) s += bflo(w[j]) * nv[d + 2 * j] + bfhi(w[j]) * nv[d + 2 * j + 1]; }
                    qn[l] = s; }
            }
            __syncthreads();
            {
                const int ew = wave * 16; const float cdec = scal[1];
                const bf16_t* vp = a.VT + ((size_t)(b * 4 + h) * 256 + eh * 128 + ew + fr) * TT + tt0 + 8 * fq;
                const bf16x8 vf0 = *(const bf16x8*)(vp), vf1 = *(const bf16x8*)(vp + 32);
                if (lat) {
                    const int t0 = tt0 - TC;
#pragma unroll 1
                    for (int lt = 0; lt < 4; ++lt) {
                        f32x4 acc = (f32x4){0.f, 0.f, 0.f, 0.f};
                        const bf16_t* qp = a.Q + (R0 + lt * 16 + fr) * D + h * 256 + 8 * fq;
#pragma unroll
                        for (int d0 = 0; d0 < 256; d0 += 32) {
                            const bf16x8 qa = *(const bf16x8*)(qp + d0);
                            const LAS float* sp = Sm + (d0 + 8 * fq) * 128 + ew + fr;
                            u32x4 sb; sb.x = pk2(sp[0], sp[128]); sb.y = pk2(sp[256], sp[384]); sb.z = pk2(sp[512], sp[640]); sb.w = pk2(sp[768], sp[896]);
                            acc = MFMA16(qa, __builtin_bit_cast(bf16x8, sb), acc);
                        }
                        float hs[4];
#pragma unroll
                        for (int r = 0; r < 4; ++r) { const int l = lt * 16 + 4 * fq + r; acc[r] *= aq[l];
                            if (a.is_ml) { const float den = (denp[l * 4] + denp[l * 4 + 1]) + (denp[l * 4 + 2] + denp[l * 4 + 3]) + aq[l] * qn[l]; hs[r] = 1.f / fmaxf(fabsf(den), emr[l]); } else hs[r] = 1.f; }
                        const bf16x8 a0 = *(const LAS bf16x8*)(att + (lt * 16 + fr) * ATT_LD + 8 * fq), a1 = *(const LAS bf16x8*)(att + (lt * 16 + fr) * ATT_LD + 32 + 8 * fq);
                        acc = MFMA16(a0, vf0, acc); acc = MFMA16(a1, vf1, acc);
#pragma unroll
                        for (int r = 0; r < 4; ++r) { const int l = lt * 16 + 4 * fq + r; Oo[((size_t)b * T + t0 + l) * D + h * 256 + eh * 128 + ew + fr] = f2bf(acc[r] * hs[r]); }
                    }
                }
#pragma unroll 1
                for (int dt = 0; dt < 16; ++dt) {
                    const int d0 = dt * 16;
                    LAS float* sp = Sm + (d0 + 4 * fq) * 128 + ew + fr;
                    f32x4 acc; acc[0] = sp[0] * cdec; acc[1] = sp[128] * cdec; acc[2] = sp[256] * cdec; acc[3] = sp[384] * cdec;
#pragma unroll
                    for (int ks = 0; ks < 2; ++ks) {
                        const bf16_t* kp = a.K + (R0 + 32 * ks + 8 * fq) * D + h * 256 + d0 + fr;
                        float kk[8];
#pragma unroll
                        for (int j = 0; j < 8; ++j) kk[j] = bf2f(kp[(size_t)j * D]) * kd[32 * ks + 8 * fq + j];
                        u32x4 ka; ka.x = pk2(kk[0], kk[1]); ka.y = pk2(kk[2], kk[3]); ka.z = pk2(kk[4], kk[5]); ka.w = pk2(kk[6], kk[7]);
                        acc = MFMA16(__builtin_bit_cast(bf16x8, ka), ks ? vf1 : vf0, acc);
                    }
                    sp[0] = acc[0]; sp[128] = acc[1]; sp[256] = acc[2]; sp[384] = acc[3];
                }
                if (a.is_ml && tid < 256) { const int d = tid; const bf16_t* kp = a.K + R0 * D + h * 256 + d; float s = nv[d] * cdec;
                    for (int m = 0; m < CH; ++m) s += kd[m] * bf2f(kp[(size_t)m * D]);
                    nv[d] = s; }
            }
            __syncthreads();
        }
    }
}


typedef short v4i16_t __attribute__((ext_vector_type(4)));
__device__ __forceinline__ int swz_f(int row) { return ((row & 3) << 2) | ((row >> 2) & 3); }
__device__ __forceinline__ int img_chunk(int row, int half, int ch) { return half * 16384 + 256 * row + 16 * (ch ^ swz_f(row)); }
constexpr int S2_Q = 0, S2_K = 65536, S2_ATT = 131072, S2_VEC = S2_ATT + 64 * ATT_LD * 2;
__device__ __forceinline__ void scan_dma_tile(LAS unsigned char* dstbuf, const bf16_t* src, int wave, int lane) {
#pragma unroll
    for (int j = 0; j < 4; ++j) { const int ii = wave * 4 + j, half = ii >> 4, rg = ii & 15; const int row = 4 * rg + (lane >> 4), ch = (lane & 15) ^ swz_f(row);
        __builtin_amdgcn_global_load_lds((const unsigned*)(src + (size_t)row * D + half * 128 + 8 * ch), (LAS unsigned*)(dstbuf + half * 16384 + rg * 1024), 16, 0, 0); }
}
__device__ __forceinline__ float scan_incl_sum(float v, int lane) {
#pragma unroll
    for (int o = 1; o < 64; o <<= 1) { const float t = __shfl_up(v, o); if (lane >= o) v += t; }
    return v;
}
__device__ __forceinline__ float scan_incl_max(float v, int lane) {
#pragma unroll
    for (int o = 1; o < 64; o <<= 1) { const float t = __shfl_up(v, o); if (lane >= o) v = fmaxf(v, t); }
    return v;
}
__device__ __forceinline__ void scan_phase2(LAS unsigned char* lds, const ScanArgs a, int tid, int wave, int lane) {
    LAS bf16_t* att = (LAS bf16_t*)(lds + S2_ATT);
    LAS float* vec = (LAS float*)(lds + S2_VEC);
    LAS float* rowv = vec, *colv = vec + 64, *aq = vec + 128, *kd = vec + 192, *emr = vec + 256, *qn = vec + 320, *denp = vec + 384, *nv = vec + 640, *scal = vec + 896;
    const int fr = lane & 15, fq = lane >> 4;
    for (int item = blockIdx.x; item < 256; item += gridDim.x) {
        const int eh = item & 1, dir = (item >> 1) & 1, h = (item >> 2) & 3, b = item >> 4;
        const int ew = wave * 16;
        const int Ff = swz_f(fr), Fhp = Ff >> 2, Flp = Ff & 3;
        int X4[4];
#pragma unroll
        for (int c2 = 0; c2 < 4; ++c2) X4[c2] = 64 * (c2 ^ Fhp);
        const int LB1 = 256 * fr + 16 * (fq ^ Flp);
        const int LB2 = 256 * fr + 16 * ((fq >> 1) ^ Flp) + 8 * (fq & 1);
        const int LB3 = 256 * fr + 16 * (((fq >> 1) | 2) ^ Flp) + 8 * (fq & 1);
        const int q4 = (lane & 15) >> 2, p4 = lane & 3;
        const int TB0 = 256 * (8 * fq + q4) + 16 * (p4 >> 1) + 8 * (p4 & 1);
        const int TB1 = 256 * (8 * fq + q4 + 4) + 16 * ((p4 >> 1) ^ 1) + 8 * (p4 & 1);
        int W8[8];
#pragma unroll
        for (int i = 0; i < 8; ++i) W8[i] = 64 * ((i >> 1) ^ q4) + 32 * ((i & 1) ^ (fq & 1));
        __syncthreads();
        f32x4 S[16];
#pragma unroll
        for (int i = 0; i < 16; ++i) S[i] = (f32x4){0.f, 0.f, 0.f, 0.f};
        if (tid < 256) nv[tid] = 0.f;
        if (tid == 0) { scal[0] = 0.f; scal[1] = 1.f; }
        const float* Gi = a.G + ((size_t)b * 16 + (dir ? 8 : 0) + h) * TT;
        const float* Gf = a.G + ((size_t)b * 16 + (dir ? 12 : 4) + h) * TT;
        bf16_t* Oo = dir ? a.Ob : a.Of;
        const bf16_t* Qh = a.Q + (size_t)b * TT * D + h * 256;
        const bf16_t* Kh = a.K + (size_t)b * TT * D + h * 256;
        const bf16_t* Vw = a.VT + ((size_t)(b * 4 + h) * 256 + eh * 128 + ew + fr) * TT + 8 * fq;
        if (!a.is_ml) {
            const float lg = logsigmoid_f(a.decay[dir * 4 + h]);
            if (tid < CH) { const int l = tid;
                rowv[l] = (dir ? -(float)l : (float)l) * lg; colv[l] = (dir ? (float)l : -(float)l) * lg;
                aq[l] = expf((float)(dir ? (CH - l) : (l + 1)) * lg); kd[l] = expf((float)(dir ? l : (CH - 1 - l)) * lg); emr[l] = 0.f; }
            if (tid == 0) scal[1] = expf((float)CH * lg);
        }
        { const int tt0 = (dir ? 3 : 0) * CH; scan_dma_tile(lds + S2_K, Kh + (size_t)tt0 * D, wave, lane); }
        const int sidx = dir ? 63 - lane : lane;
        float gf_n = 0.f, gi_n = 0.f;
        if (a.is_ml && wave == 0) { const int tt0 = (dir ? 3 : 0) * CH; gf_n = Gf[tt0 + sidx]; gi_n = Gi[tt0 + sidx]; }
        asm volatile("s_waitcnt vmcnt(0)" ::: "memory");
        __syncthreads();
        for (int st = 0; st < 36; ++st) {
            int tt0, ttn;
            if (st < 4) tt0 = (dir ? (3 - st) : st) * CH; else tt0 = TC + (dir ? (35 - st) : (st - 4)) * CH;
            { const int sn = st + 1; if (sn < 4) ttn = (dir ? (3 - sn) : sn) * CH; else ttn = TC + (dir ? (35 - sn) : (sn - 4)) * CH; }
            const bool lat = st >= 4, latn = (st + 1) >= 4, hasn = (st + 1) < 36;
            int frs = fr, fqs = fq; asm volatile("" : "+v"(frs), "+v"(fqs));
            LAS unsigned char* Qb = lds + S2_Q + (st & 1) * 32768;
            LAS unsigned char* Kb = lds + S2_K + (st & 1) * 32768;
            const bf16x8 vf0 = *(const bf16x8*)(Vw + tt0), vf1 = *(const bf16x8*)(Vw + tt0 + 32);
            if (a.is_ml) {
                if (wave == 0) {
                    const float f = gf_n, ig = gi_n, mst = scal[0];
                    const float cc = scan_incl_sum(f, lane);
                    const float ctot = __shfl(cc, 63);
                    const float av = ig - cc;
                    const float mi = scan_incl_max(av, lane);
                    float mx = mi;
                    if (dir) { mx = __shfl_up(mi, 1); if (lane == 0) mx = -1e30f; }
                    const float gmax = __shfl(mi, 63);
                    const float mnew = fmaxf(ctot + mst, ctot + gmax);
                    const float mrow = fmaxf(cc + mx, cc + mst);
                    rowv[sidx] = cc - mrow; colv[sidx] = av; aq[sidx] = expf(cc + mst - mrow); emr[sidx] = expf(-mrow); kd[sidx] = expf(ctot + av - mnew);
                    if (lane == 0) { scal[1] = expf(ctot + mst - mnew); scal[0] = mnew; }
                    if (hasn) { gf_n = Gf[ttn + sidx]; gi_n = Gi[ttn + sidx]; }
                }
                __syncthreads();
            }
            if (lat) {
#pragma unroll
                for (int tq = 0; tq < 2; ++tq) {
                    const int ti = wave * 2 + tq, lt = ti >> 2, mt = ti & 3;
                    f32x4 acc = (f32x4){0.f, 0.f, 0.f, 0.f};
#pragma unroll
                    for (int k8 = 0; k8 < 8; ++k8) {
                        const bf16x8 ka = *(const LAS bf16x8*)(Kb + (LB1 + X4[k8 & 3] + mt * 4096) + (k8 >> 2) * 16384);
                        const bf16x8 qb = *(const LAS bf16x8*)(Qb + (LB1 + X4[k8 & 3] + lt * 4096) + (k8 >> 2) * 16384);
                        acc = MFMA16(ka, qb, acc);
                    }
                    const int l = lt * 16 + frs; const float rv = rowv[l]; float o[4]; float s = 0.f;
#pragma unroll
                    for (int r = 0; r < 4; ++r) { const int m = mt * 16 + 4 * fqs + r; const bool ok = dir ? (m > l) : (m <= l); const float w = ok ? __expf(rv + colv[m]) : 0.f; o[r] = acc[r] * w; s += o[r]; }
                    *(LAS u32x2*)(att + l * ATT_LD + mt * 16 + 4 * fqs) = (u32x2){pk2(o[0], o[1]), pk2(o[2], o[3])};
                    s += __shfl_xor(s, 16); s += __shfl_xor(s, 32);
                    if (fqs == 0) denp[l * 4 + mt] = s;
                }
                if (a.is_ml) {
                    const int l = tid >> 3, part = tid & 7; float s = 0.f;
#pragma unroll
                    for (int cc = 0; cc < 4; ++cc) { const int cg = part * 4 + cc; const u32x4 w = *(const LAS u32x4*)(Qb + img_chunk(l, cg >> 4, cg & 15)); const LAS float* np = nv + cg * 8;
#pragma unroll
                        for (int j = 0; j < 4; ++j) s += bflo(w[j]) * np[2 * j] + bfhi(w[j]) * np[2 * j + 1]; }
                    s += __shfl_xor(s, 1); s += __shfl_xor(s, 2); s += __shfl_xor(s, 4);
                    if (part == 0) qn[l] = s;
                }
            }
            __syncthreads();
            if (hasn) {
                scan_dma_tile(lds + S2_K + ((st + 1) & 1) * 32768, Kh + (size_t)ttn * D, wave, lane);
                if (latn) scan_dma_tile(lds + S2_Q + ((st + 1) & 1) * 32768, Qh + (size_t)ttn * D, wave, lane);
            }
            const float cdec = scal[1];
            if (lat) {
                const int t0 = tt0 - TC;
                f32x4 oacc[4];
#pragma unroll
                for (int lt = 0; lt < 4; ++lt) oacc[lt] = (f32x4){0.f, 0.f, 0.f, 0.f};
#pragma unroll
                for (int kb = 0; kb < 8; ++kb) {
                    u32x4 w; w.x = pk2(S[2 * kb][0], S[2 * kb][1]); w.y = pk2(S[2 * kb][2], S[2 * kb][3]); w.z = pk2(S[2 * kb + 1][0], S[2 * kb + 1][1]); w.w = pk2(S[2 * kb + 1][2], S[2 * kb + 1][3]);
                    const bf16x8 sbk = __builtin_bit_cast(bf16x8, w);
#pragma unroll
                    for (int lt = 0; lt < 4; ++lt) {
                        const u32x2 lo = *(const LAS u32x2*)(Qb + (LB2 + X4[kb & 3]) + lt * 4096 + (kb >> 2) * 16384);
                        const u32x2 hi = *(const LAS u32x2*)(Qb + (LB3 + X4[kb & 3]) + lt * 4096 + (kb >> 2) * 16384);
                        const u32x4 qa = (u32x4){lo.x, lo.y, hi.x, hi.y};
                        oacc[lt] = MFMA16(__builtin_bit_cast(bf16x8, qa), sbk, oacc[lt]);
                    }
                    if (kb & 1) __builtin_amdgcn_sched_barrier(0);
                }
#pragma unroll
                for (int lt = 0; lt < 4; ++lt) {
                    f32x4 acc = oacc[lt];
                    float hs[4];
#pragma unroll
                    for (int r = 0; r < 4; ++r) { const int l = lt * 16 + 4 * fqs + r; acc[r] *= aq[l];
                        if (a.is_ml) { const float den = (denp[l * 4] + denp[l * 4 + 1]) + (denp[l * 4 + 2] + denp[l * 4 + 3]) + aq[l] * qn[l]; hs[r] = 1.f / fmaxf(fabsf(den), emr[l]); } else hs[r] = 1.f; }
                    const bf16x8 a0 = *(const LAS bf16x8*)(att + (lt * 16 + frs) * ATT_LD + 8 * fqs), a1 = *(const LAS bf16x8*)(att + (lt * 16 + frs) * ATT_LD + 32 + 8 * fqs);
                    acc = MFMA16(a0, vf0, acc); acc = MFMA16(a1, vf1, acc);
#pragma unroll
                    for (int r = 0; r < 4; ++r) { const int l = lt * 16 + 4 * fqs + r; Oo[((size_t)b * T + t0 + l) * D + h * 256 + eh * 128 + ew + frs] = f2bf(acc[r] * hs[r]); }
                    __builtin_amdgcn_sched_barrier(0);
                }
            }
            {
                bf16x8 vs[2];
#pragma unroll
                for (int ks = 0; ks < 2; ++ks) { const u32x4 vw = __builtin_bit_cast(u32x4, ks ? vf1 : vf0); const LAS float* kp = kd + 32 * ks + 8 * fqs; u32x4 o;
#pragma unroll
                    for (int j = 0; j < 4; ++j) o[j] = pk2(bflo(vw[j]) * kp[2 * j], bfhi(vw[j]) * kp[2 * j + 1]);
                    vs[ks] = __builtin_bit_cast(bf16x8, o); }
#pragma unroll
                for (int dt = 0; dt < 16; ++dt) {
                    f32x4 acc = S[dt] * cdec;
#pragma unroll
                    for (int ks = 0; ks < 2; ++ks) {
                        const v4i16_t lo = __builtin_amdgcn_ds_read_tr16_b64_v4i16((LAS v4i16_t*)(Kb + (TB0 + W8[dt & 7]) + (dt >> 3) * 16384 + ks * 8192));
                        const v4i16_t hi = __builtin_amdgcn_ds_read_tr16_b64_v4i16((LAS v4i16_t*)(Kb + (TB1 + W8[dt & 7]) + (dt >> 3) * 16384 + ks * 8192));
                        const bf16x8 ka = __builtin_shufflevector(lo, hi, 0, 1, 2, 3, 4, 5, 6, 7);
                        acc = MFMA16(ka, vs[ks], acc);
                    }
                    S[dt] = acc;
                    if ((dt & 1) == 1) __builtin_amdgcn_sched_barrier(0);
                }
                if (a.is_ml && tid < 256) { const int d = tid; float s = nv[d] * cdec;
#pragma unroll 4
                    for (int m = 0; m < CH; ++m) s += kd[m] * bf2f(*(const LAS bf16_t*)(Kb + img_chunk(m, d >> 7, (d & 127) >> 3) + (d & 7) * 2));
                    nv[d] = s; }
            }
            asm volatile("s_waitcnt vmcnt(0)" ::: "memory");
            __syncthreads();
        }
    }
}


constexpr int S3_SET = 328;
template <int VAR> __device__ __forceinline__ void scan_phase3(LAS unsigned char* lds, const ScanArgs a, int tid, int wave, int lane) {
    LAS bf16_t* att = (LAS bf16_t*)(lds + S2_ATT);
    LAS float* vec = (LAS float*)(lds + S2_VEC);
    LAS float* qn2 = vec + 2 * S3_SET, *denp = qn2 + 128;
    const int fr = lane & 15, fq = lane >> 4;
    for (int item = blockIdx.x; item < 256; item += gridDim.x) {
        const int eh = item & 1, dir = (item >> 1) & 1, h = (item >> 2) & 3, b = item >> 4;
        const int ew = wave * 16;
        const int Ff = swz_f(fr), Fhp = Ff >> 2, Flp = Ff & 3;
        int X4[4];
#pragma unroll
        for (int c2 = 0; c2 < 4; ++c2) X4[c2] = 64 * (c2 ^ Fhp);
        const int LB1 = 256 * fr + 16 * (fq ^ Flp);
        const int LB2 = 256 * fr + 16 * ((fq >> 1) ^ Flp) + 8 * (fq & 1);
        const int LB3 = 256 * fr + 16 * (((fq >> 1) | 2) ^ Flp) + 8 * (fq & 1);
        const int q4 = (lane & 15) >> 2, p4 = lane & 3;
        const int TB0 = 256 * (8 * fq + q4) + 16 * (p4 >> 1) + 8 * (p4 & 1);
        const int TB1 = 256 * (8 * fq + q4 + 4) + 16 * ((p4 >> 1) ^ 1) + 8 * (p4 & 1);
        int W8[8];
#pragma unroll
        for (int i = 0; i < 8; ++i) W8[i] = 64 * ((i >> 1) ^ q4) + 32 * ((i & 1) ^ (fq & 1));
        __syncthreads();
        f32x4 S[16];
#pragma unroll
        for (int i = 0; i < 16; ++i) S[i] = (f32x4){0.f, 0.f, 0.f, 0.f};
        if (tid < 128) qn2[tid] = 0.f;
        f32x4 nA[2]; nA[0] = (f32x4){0.f, 0.f, 0.f, 0.f}; nA[1] = nA[0];
        const float* Gi = a.G + ((size_t)b * 16 + (dir ? 8 : 0) + h) * TT;
        const float* Gf = a.G + ((size_t)b * 16 + (dir ? 12 : 4) + h) * TT;
        bf16_t* Oo = (dir ? a.Ob : a.Of) + (size_t)b * T * D + h * 256 + eh * 128 + ew;
        const bf16_t* Qh = a.Q + (size_t)b * TT * D + h * 256;
        const bf16_t* Kh = a.K + (size_t)b * TT * D + h * 256;
        const bf16_t* Vw = a.VT + ((size_t)(b * 4 + h) * 256 + eh * 128 + ew + fr) * TT + 8 * fq;
        const int sidx = dir ? 63 - lane : lane;
        if (!a.is_ml) {
            const float lg = logsigmoid_f(a.decay[dir * 4 + h]);
            if (tid < 2 * CH) { const int l = tid & 63; LAS float* v = vec + (tid >> 6) * S3_SET;
                v[l] = (dir ? -(float)l : (float)l) * lg; v[64 + l] = (dir ? (float)l : -(float)l) * lg;
                v[128 + l] = expf((float)(dir ? (CH - l) : (l + 1)) * lg); v[192 + l] = expf((float)(dir ? l : (CH - 1 - l)) * lg); v[256 + l] = 0.f;
                if (l == 0) v[321] = expf((float)CH * lg); }
        }
#define S3_STAGE1(SET, f_, ig_) do { LAS float* v_ = vec + (SET) * S3_SET; \
            const float cc_ = scan_incl_sum((f_), lane); const float ctot_ = __shfl(cc_, 63); const float av_ = (ig_) - cc_; \
            const float mi_ = scan_incl_max(av_, lane); float mx_ = mi_; if (dir) { mx_ = __shfl_up(mi_, 1); if (lane == 0) mx_ = -1e30f; } \
            const float gmax_ = __shfl(mi_, 63); const float mnew_ = fmaxf(ctot_ + mst, ctot_ + gmax_); const float mrow_ = fmaxf(cc_ + mx_, cc_ + mst); \
            v_[sidx] = cc_ - mrow_; v_[64 + sidx] = av_; v_[128 + sidx] = __expf(cc_ + mst - mrow_); v_[256 + sidx] = __expf(-mrow_); v_[192 + sidx] = __expf(ctot_ + av_ - mnew_); \
            if (lane == 0) v_[321] = __expf(ctot_ + mst - mnew_); mst = mnew_; } while (0)
        float mst = 0.f, gf_n = 0.f, gi_n = 0.f;
        const int tt_first = (dir ? 3 : 0) * CH;
        if (!(VAR & 1)) scan_dma_tile(lds + S2_K, Kh + (size_t)tt_first * D, wave, lane);
        bf16x8 vf0 = *(const bf16x8*)(Vw + tt_first), vf1 = *(const bf16x8*)(Vw + tt_first + 32);
        if (a.is_ml && wave == 0) {
            const float f0 = Gf[tt_first + sidx], i0 = Gi[tt_first + sidx];
            S3_STAGE1(0, f0, i0);
            const int tt1 = (dir ? 2 : 1) * CH; gf_n = Gf[tt1 + sidx]; gi_n = Gi[tt1 + sidx];
        }
        unsigned outp[8];
#pragma unroll
        for (int i = 0; i < 8; ++i) outp[i] = 0u;
        int tprev = -1;
        asm volatile("s_waitcnt vmcnt(0)" ::: "memory");
        __syncthreads();
        for (int st = 0; st < 36; ++st) {
            int tt0, ttn, ttnn;
            if (st < 4) tt0 = (dir ? (3 - st) : st) * CH; else tt0 = TC + (dir ? (35 - st) : (st - 4)) * CH;
            { const int sn = st + 1; if (sn < 4) ttn = (dir ? (3 - sn) : sn) * CH; else ttn = TC + (dir ? (35 - sn) : (sn - 4)) * CH; }
            { const int sn = st + 2; if (sn < 4) ttnn = (dir ? (3 - sn) : sn) * CH; else ttnn = TC + (dir ? (35 - sn) : (sn - 4)) * CH; }
            const bool lat = st >= 4, latn = (st + 1) >= 4, hasn = (st + 1) < 36, hasnn = (st + 2) < 36;
            int frs = fr, fqs = fq; asm volatile("" : "+v"(frs), "+v"(fqs));
            LAS unsigned char* Qb = lds + S2_Q + (st & 1) * 32768;
            LAS unsigned char* Kb = lds + S2_K + (st & 1) * 32768;
            LAS float* vs_ = vec + ((a.is_ml ? st : 0) & 1) * S3_SET;
            LAS float* rowv = vs_, *colv = vs_ + 64, *aq = vs_ + 128, *kd = vs_ + 192, *emr = vs_ + 256;
            LAS float* qn = qn2 + (st & 1) * 64;
            bf16x8 vfn0 = vf0, vfn1 = vf1;
            if (tprev >= 0) {
#pragma unroll
                for (int lt = 0; lt < 4; ++lt)
#pragma unroll
                    for (int r = 0; r < 4; ++r) Oo[(size_t)(tprev + lt * 16 + 4 * fqs + r) * D + frs] = (bf16_t)((r & 1) ? (outp[lt * 2 + (r >> 1)] >> 16) : (outp[lt * 2 + (r >> 1)] & 0xffffu));
            }
            f32x4 oacc[4];
#pragma unroll
            for (int lt = 0; lt < 4; ++lt) oacc[lt] = (f32x4){0.f, 0.f, 0.f, 0.f};
            if (lat) {
                if (!(VAR & 2)) {
                {
                    int lts[2], mts[2];
#pragma unroll
                    for (int tq = 0; tq < 2; ++tq) { const int ti = wave * 2 + tq;
                        const int ta = (int)((0x3333222110211000ull >> (4 * ti)) & 15ull), tb = (int)((0x3210210100332321ull >> (4 * ti)) & 15ull);
                        lts[tq] = dir ? tb : ta; mts[tq] = dir ? ta : tb; }
                    f32x4 accs[2]; accs[0] = (f32x4){0.f, 0.f, 0.f, 0.f}; accs[1] = accs[0];
                    if (wave >= 3) {
#pragma unroll
                        for (int k8 = 0; k8 < 8; ++k8) {
#pragma unroll
                            for (int tq = 0; tq < 2; ++tq) {
                                const bf16x8 ka = *(const LAS bf16x8*)(Kb + (LB1 + X4[k8 & 3] + mts[tq] * 4096) + (k8 >> 2) * 16384);
                                const bf16x8 qb = *(const LAS bf16x8*)(Qb + (LB1 + X4[k8 & 3] + lts[tq] * 4096) + (k8 >> 2) * 16384);
                                accs[tq] = MFMA16(ka, qb, accs[tq]);
                            }
                        }
                    }
#pragma unroll
                    for (int tq = 0; tq < 2; ++tq) {
                        const int lt = lts[tq], mt = mts[tq]; const f32x4 acc = accs[tq];
                        const int l = lt * 16 + frs; const float rv = rowv[l]; float o[4]; float s = 0.f;
#pragma unroll
                        for (int r = 0; r < 4; ++r) { const int m = mt * 16 + 4 * fqs + r; const bool ok = dir ? (m > l) : (m <= l); const float w = ok ? __expf(rv + colv[m]) : 0.f; o[r] = acc[r] * w; s += o[r]; }
                        *(LAS u32x2*)(att + l * ATT_LD + mt * 16 + 4 * fqs) = (u32x2){pk2(o[0], o[1]), pk2(o[2], o[3])};
                        s += __shfl_xor(s, 16); s += __shfl_xor(s, 32);
                        if (fqs == 0) denp[l * 4 + mt] = s;
                    }
                }
                }
            }
            asm volatile("" : "+v"(vf0), "+v"(vf1), "+v"(gf_n), "+v"(gi_n));
            if (hasn) { vfn0 = *(const bf16x8*)(Vw + ttn); vfn1 = *(const bf16x8*)(Vw + ttn + 32); }
            if (hasn) {
                scan_dma_tile(lds + S2_K + ((st + 1) & 1) * 32768, Kh + (size_t)ttn * D, wave, lane);
                if (latn) scan_dma_tile(lds + S2_Q + ((st + 1) & 1) * 32768, Qh + (size_t)ttn * D, wave, lane);
            }
            if (lat) {
                __builtin_amdgcn_sched_barrier(0);
                if (!(VAR & 4)) {
                bf16x8 nfr;
                { u32x4 w; w.x = pk2(nA[0][0], nA[0][1]); w.y = pk2(nA[0][2], nA[0][3]); w.z = pk2(nA[1][0], nA[1][1]); w.w = pk2(nA[1][2], nA[1][3]); nfr = __builtin_bit_cast(bf16x8, w); }
                u32x2 qlA[4], qhA[4], qlB[4], qhB[4];
#define S3_QISSUE(kb_, ql_, qh_) do { const unsigned alo = (unsigned)(size_t)(Qb + (LB2 + X4[(kb_) & 3]) + ((kb_) >> 2) * 16384), ahi = (unsigned)(size_t)(Qb + (LB3 + X4[(kb_) & 3]) + ((kb_) >> 2) * 16384); \
                    asm volatile("ds_read_b64 %0, %8\n\tds_read_b64 %1, %9\n\tds_read_b64 %2, %8 offset:4096\n\tds_read_b64 %3, %9 offset:4096\n\t" \
                                 "ds_read_b64 %4, %8 offset:8192\n\tds_read_b64 %5, %9 offset:8192\n\tds_read_b64 %6, %8 offset:12288\n\tds_read_b64 %7, %9 offset:12288" \
                                 : "=&v"(ql_[0]), "=&v"(qh_[0]), "=&v"(ql_[1]), "=&v"(qh_[1]), "=&v"(ql_[2]), "=&v"(qh_[2]), "=&v"(ql_[3]), "=&v"(qh_[3]) : "v"(alo), "v"(ahi) : "memory"); } while (0)
#define S3_QWAIT(N_, ql_, qh_) asm volatile("s_waitcnt lgkmcnt(" #N_ ")" : "+v"(ql_[0]), "+v"(qh_[0]), "+v"(ql_[1]), "+v"(qh_[1]), "+v"(ql_[2]), "+v"(qh_[2]), "+v"(ql_[3]), "+v"(qh_[3]) :: "memory")
                S3_QISSUE(0, qlA, qhA);
#pragma unroll
                for (int kb = 0; kb < 8; ++kb) {
                    u32x4 w; w.x = pk2(S[2 * kb][0], S[2 * kb][1]); w.y = pk2(S[2 * kb][2], S[2 * kb][3]); w.z = pk2(S[2 * kb + 1][0], S[2 * kb + 1][1]); w.w = pk2(S[2 * kb + 1][2], S[2 * kb + 1][3]);
                    const bf16x8 sbk = __builtin_bit_cast(bf16x8, w);
                    if (kb & 1) { if (kb < 7) { S3_QISSUE(kb + 1, qlA, qhA); S3_QWAIT(8, qlB, qhB); } else S3_QWAIT(0, qlB, qhB); }
                    else { S3_QISSUE(kb + 1, qlB, qhB); S3_QWAIT(8, qlA, qhA); }
#pragma unroll
                    for (int lt = 0; lt < 4; ++lt) {
                        const u32x2 lo = (kb & 1) ? qlB[lt] : qlA[lt], hi = (kb & 1) ? qhB[lt] : qhA[lt];
                        const u32x4 qa = (u32x4){lo.x, lo.y, hi.x, hi.y};
                        oacc[lt] = MFMA16(__builtin_bit_cast(bf16x8, qa), sbk, oacc[lt]);
                    }
                }
#undef S3_QISSUE
#undef S3_QWAIT
                if (a.is_ml) {
                    u32x2 ql[4], qh[4];
                    { const int xw = 64 * ((wave & 3) ^ Fhp) + (wave >> 2) * 16384; const unsigned alo = (unsigned)(size_t)(Qb + LB2 + xw), ahi = (unsigned)(size_t)(Qb + LB3 + xw);
                      asm volatile("ds_read_b64 %0, %8\n\tds_read_b64 %1, %9\n\tds_read_b64 %2, %8 offset:4096\n\tds_read_b64 %3, %9 offset:4096\n\t"
                                   "ds_read_b64 %4, %8 offset:8192\n\tds_read_b64 %5, %9 offset:8192\n\tds_read_b64 %6, %8 offset:12288\n\tds_read_b64 %7, %9 offset:12288\n\ts_waitcnt lgkmcnt(0)"
                                   : "=&v"(ql[0]), "=&v"(qh[0]), "=&v"(ql[1]), "=&v"(qh[1]), "=&v"(ql[2]), "=&v"(qh[2]), "=&v"(ql[3]), "=&v"(qh[3]) : "v"(alo), "v"(ahi) : "memory"); }
#pragma unroll
                    for (int lt = 0; lt < 4; ++lt) {
                        const u32x4 qa = (u32x4){ql[lt].x, ql[lt].y, qh[lt].x, qh[lt].y};
                        const f32x4 qp = MFMA16(__builtin_bit_cast(bf16x8, qa), nfr, ((f32x4){0.f, 0.f, 0.f, 0.f}));
                        if (frs == 0) {
                            const unsigned qa_ = (unsigned)(size_t)(qn + lt * 16 + 4 * fqs);
                            asm volatile("s_nop 7\n\ts_nop 7\n\tds_add_f32 %0, %1\n\tds_add_f32 %0, %2 offset:4\n\tds_add_f32 %0, %3 offset:8\n\tds_add_f32 %0, %4 offset:12" :: "v"(qa_), "v"(qp[0]), "v"(qp[1]), "v"(qp[2]), "v"(qp[3]) : "memory");
                        }
                    }
                }
                }
            }
            if (a.is_ml && wave == 0 && hasn) {
                S3_STAGE1((st + 1) & 1, gf_n, gi_n);
                if (hasnn) { gf_n = Gf[ttnn + sidx]; gi_n = Gi[ttnn + sidx]; }
            }
            const float cdec = vs_[321];
            if (!(VAR & 8)) {
                bf16x8 vs[2];
#pragma unroll
                for (int ks = 0; ks < 2; ++ks) { const u32x4 vw = __builtin_bit_cast(u32x4, ks ? vf1 : vf0); const LAS float* kp = kd + 32 * ks + 8 * fqs; u32x4 o;
#pragma unroll
                    for (int j = 0; j < 4; ++j) o[j] = pk2(bflo(vw[j]) * kp[2 * j], bfhi(vw[j]) * kp[2 * j + 1]);
                    vs[ks] = __builtin_bit_cast(bf16x8, o); }
                bf16x8 kdf[2];
                if (a.is_ml) {
#pragma unroll
                    for (int ks = 0; ks < 2; ++ks) { const LAS float* kp = kd + 32 * ks + 8 * fqs; u32x4 o;
#pragma unroll
                        for (int j = 0; j < 4; ++j) o[j] = pk2(kp[2 * j], kp[2 * j + 1]);
                        kdf[ks] = __builtin_bit_cast(bf16x8, o); }
                    nA[0] = nA[0] * cdec; nA[1] = nA[1] * cdec;
                }
#pragma unroll
                for (int g = 0; g < 8; ++g) {
                    v4i16_t t0, t1, t2, t3, t4, t5, t6, t7;
                    const unsigned a00 = (unsigned)(size_t)(Kb + (TB0 + W8[(2 * g) & 7]) + ((2 * g) >> 3) * 16384), a01 = (unsigned)(size_t)(Kb + (TB1 + W8[(2 * g) & 7]) + ((2 * g) >> 3) * 16384);
                    const unsigned a10 = (unsigned)(size_t)(Kb + (TB0 + W8[(2 * g + 1) & 7]) + ((2 * g + 1) >> 3) * 16384), a11 = (unsigned)(size_t)(Kb + (TB1 + W8[(2 * g + 1) & 7]) + ((2 * g + 1) >> 3) * 16384);
                    asm volatile("ds_read_b64_tr_b16 %0, %8\n\tds_read_b64_tr_b16 %1, %9\n\tds_read_b64_tr_b16 %2, %8 offset:8192\n\tds_read_b64_tr_b16 %3, %9 offset:8192\n\t"
                                 "ds_read_b64_tr_b16 %4, %10\n\tds_read_b64_tr_b16 %5, %11\n\tds_read_b64_tr_b16 %6, %10 offset:8192\n\tds_read_b64_tr_b16 %7, %11 offset:8192\n\ts_waitcnt lgkmcnt(0)"
                                 : "=&v"(t0), "=&v"(t1), "=&v"(t2), "=&v"(t3), "=&v"(t4), "=&v"(t5), "=&v"(t6), "=&v"(t7) : "v"(a00), "v"(a01), "v"(a10), "v"(a11) : "memory");
#define S3_UPD(dt_, lo0_, hi0_, lo1_, hi1_) do { f32x4 acc = S[dt_] * cdec; \
                        const bf16x8 ka0 = __builtin_shufflevector(lo0_, hi0_, 0, 1, 2, 3, 4, 5, 6, 7), ka1 = __builtin_shufflevector(lo1_, hi1_, 0, 1, 2, 3, 4, 5, 6, 7); \
                        acc = MFMA16(ka0, vs[0], acc); acc = MFMA16(ka1, vs[1], acc); \
                        S[dt_] = acc; } while (0)
                    S3_UPD(2 * g, t0, t1, t2, t3); S3_UPD(2 * g + 1, t4, t5, t6, t7);
#undef S3_UPD
                    __builtin_amdgcn_sched_barrier(0);
                }
                if (a.is_ml) {
#pragma unroll
                    for (int t = 0; t < 2; ++t) {
                        const int w8 = 64 * ((wave & 3) ^ q4) + 32 * (t ^ (fq & 1)) + (wave >> 2) * 16384;
                        v4i16_t t0, t1, t2, t3; const unsigned a0 = (unsigned)(size_t)(Kb + TB0 + w8), a1 = (unsigned)(size_t)(Kb + TB1 + w8);
                        asm volatile("ds_read_b64_tr_b16 %0, %4\n\tds_read_b64_tr_b16 %1, %5\n\tds_read_b64_tr_b16 %2, %4 offset:8192\n\tds_read_b64_tr_b16 %3, %5 offset:8192\n\ts_waitcnt lgkmcnt(0)"
                                     : "=&v"(t0), "=&v"(t1), "=&v"(t2), "=&v"(t3) : "v"(a0), "v"(a1) : "memory");
                        const bf16x8 ka0 = __builtin_shufflevector(t0, t1, 0, 1, 2, 3, 4, 5, 6, 7), ka1 = __builtin_shufflevector(t2, t3, 0, 1, 2, 3, 4, 5, 6, 7);
                        nA[t] = MFMA16(ka0, kdf[0], nA[t]); nA[t] = MFMA16(ka1, kdf[1], nA[t]);
                    }
                }
            }
            asm volatile("s_waitcnt lgkmcnt(0)" ::: "memory"); __builtin_amdgcn_s_barrier(); asm volatile("" ::: "memory");
            const bf16x8 av0 = vf0, av1 = vf1;
            if (lat && !(VAR & 16)) {
#pragma unroll
                for (int lt = 0; lt < 4; ++lt) {
                    f32x4 acc = oacc[lt];
                    float hs[4];
#pragma unroll
                    for (int r = 0; r < 4; ++r) { const int l = lt * 16 + 4 * fqs + r; acc[r] *= aq[l];
                        if (a.is_ml) { const float den = (denp[l * 4] + denp[l * 4 + 1]) + (denp[l * 4 + 2] + denp[l * 4 + 3]) + aq[l] * qn[l]; hs[r] = 1.f / fmaxf(fabsf(den), emr[l]); } else hs[r] = 1.f; }
                    const bf16x8 a0 = *(const LAS bf16x8*)(att + (lt * 16 + frs) * ATT_LD + 8 * fqs), a1 = *(const LAS bf16x8*)(att + (lt * 16 + frs) * ATT_LD + 32 + 8 * fqs);
                    acc = MFMA16(a0, av0, acc); acc = MFMA16(a1, av1, acc);
#pragma unroll
                    for (int r = 0; r < 4; r += 2) outp[lt * 2 + (r >> 1)] = pk2(acc[r] * hs[r], acc[r + 1] * hs[r + 1]);
                }
                tprev = tt0 - TC;
            } else tprev = -1;
            if (a.is_ml) {
                if (tid >= 448) qn2[((st + 1) & 1) * 64 + (tid - 448)] = 0.f;
            }
            asm volatile("s_waitcnt vmcnt(0)" ::: "memory");
            __syncthreads();
            vf0 = vfn0; vf1 = vfn1;
        }
        if (tprev >= 0) {
#pragma unroll
            for (int lt = 0; lt < 4; ++lt)
#pragma unroll
                for (int r = 0; r < 4; ++r) Oo[(size_t)(tprev + lt * 16 + 4 * fq + r) * D + fr] = (bf16_t)((r & 1) ? (outp[lt * 2 + (r >> 1)] >> 16) : (outp[lt * 2 + (r >> 1)] & 0xffffu));
        }
#undef S3_STAGE1
    }
}

template <int ACT  > __device__ __forceinline__ void phase4_one(const bf16_t* Of, const bf16_t* Ob, const bf16_t* Ga, bf16_t* Out, int wave, int lane) {
    const int gw = blockIdx.x * NWAVES + wave, NGW = gridDim.x * NWAVES;
    u32x4 f[2], bb[2], gg[2], nf[2], nb[2], ng[2];
    if (gw < NLAT) {
#pragma unroll
        for (int j = 0; j < 2; ++j) { f[j] = ld_nt((const u32x4*)(Of + (size_t)gw * D) + lane + 64 * j); bb[j] = ld_nt((const u32x4*)(Ob + (size_t)gw * D) + lane + 64 * j); gg[j] = ld_nt((const u32x4*)(Ga + (size_t)gw * D) + lane + 64 * j); } }
    for (int R = gw; R < NLAT; R += NGW) {
        const int Rn = R + NGW;
        if (Rn < NLAT) {
#pragma unroll
            for (int j = 0; j < 2; ++j) { nf[j] = ld_nt((const u32x4*)(Of + (size_t)Rn * D) + lane + 64 * j); nb[j] = ld_nt((const u32x4*)(Ob + (size_t)Rn * D) + lane + 64 * j); ng[j] = ld_nt((const u32x4*)(Ga + (size_t)Rn * D) + lane + 64 * j); } }
        u32x4* op = (u32x4*)(Out + (size_t)R * D);
#pragma unroll
        for (int j = 0; j < 2; ++j) {
            float v[8]; float s = 0.f;
#pragma unroll
            for (int i = 0; i < 4; ++i) { v[2 * i] = bflo(f[j][i]) + bflo(bb[j][i]); v[2 * i + 1] = bfhi(f[j][i]) + bfhi(bb[j][i]); s += v[2 * i] + v[2 * i + 1]; }
            const float mean = half_sum(s) * (1.f / 256.f); float s2 = 0.f;
#pragma unroll
            for (int i = 0; i < 8; ++i) { v[i] -= mean; s2 += v[i] * v[i]; }
            const float rstd = 1.f / sqrtf(half_sum(s2) * (1.f / 256.f) + LN_EPS);
            u32x4 o;
#pragma unroll
            for (int i = 0; i < 4; ++i) { const float ga = bflo(gg[j][i]), gb = bfhi(gg[j][i]); o[i] = pk2(v[2 * i] * rstd * (ACT ? sigmoid_f(ga) : silu_f(ga)), v[2 * i + 1] * rstd * (ACT ? sigmoid_f(gb) : silu_f(gb))); }
            op[lane + 64 * j] = o;
        }
#pragma unroll
        for (int j = 0; j < 2; ++j) { f[j] = nf[j]; bb[j] = nb[j]; gg[j] = ng[j]; }
    }
}

struct SchedDense { int G, c, nM, nN, rep; __device__ __forceinline__ void a_ready(const Unit&) const {} __device__ __forceinline__ void done(const Unit&) const {}
    __device__ __forceinline__ bool next(int i, Unit& u) const {
        const int x = c & 7, y = c >> 3, nxc = G >> 3; int q = i * nxc + y; const int ntot = (nM >> 3) * 4; if (q >= rep * ntot) return false; q %= ntot; u.pm = x + 8 * (q >> 2); u.pn = q & 3; return true; } };
struct EpiY {
    static constexpr bool PERM = true, AFTER_DRAIN = false;
    bf16_t* Y; const bf16_t* gate; int pass;
    __device__ __forceinline__ void operator()(const f32x4 (&acc)[2][2][4][2], const Unit& u, int wr, int wc, int fr, int fq) const {
#pragma unroll
        for (int ai = 0; ai < 2; ++ai)
#pragma unroll
            for (int m = 0; m < 4; ++m) { const int r = u.pm * 256 + ai * 128 + wr * 64 + m * 16 + fr;
#pragma unroll
                for (int bj = 0; bj < 2; ++bj) { const size_t off = (size_t)r * D + u.pn * 256 + bj * 128 + wc * 32 + 8 * fq; const f32x4 v0 = acc[ai][bj][m][0], v1 = acc[ai][bj][m][1];
                    const u32x4 g = *(const u32x4*)(gate + off);
                    float o[8] = {bflo(g.x) * v0[0], bfhi(g.x) * v0[1], bflo(g.y) * v0[2], bfhi(g.y) * v0[3], bflo(g.z) * v1[0], bfhi(g.z) * v1[1], bflo(g.w) * v1[2], bfhi(g.w) * v1[3]};
                    if (pass) { const u32x4 y = *(const u32x4*)(Y + off); o[0] += bflo(y.x); o[1] += bfhi(y.x); o[2] += bflo(y.y); o[3] += bfhi(y.y); o[4] += bflo(y.z); o[5] += bfhi(y.z); o[6] += bflo(y.w); o[7] += bfhi(y.w); }
                    *(u32x4*)(Y + off) = (u32x4){pk2(o[0], o[1]), pk2(o[2], o[3]), pk2(o[4], o[5]), pk2(o[6], o[7])}; } }
    }
};
struct EpiY2 {
    static constexpr bool PERM = true, AFTER_DRAIN = false;
    bf16_t* Y2;
    __device__ __forceinline__ void operator()(const f32x4 (&acc)[2][2][4][2], const Unit& u, int wr, int wc, int fr, int fq) const {
#pragma unroll
        for (int ai = 0; ai < 2; ++ai)
#pragma unroll
            for (int m = 0; m < 4; ++m) { const int r = u.pm * 256 + ai * 128 + wr * 64 + m * 16 + fr;
#pragma unroll
                for (int bj = 0; bj < 2; ++bj) { const f32x4 v0 = acc[ai][bj][m][0], v1 = acc[ai][bj][m][1];
                    *(u32x4*)(Y2 + (size_t)r * D + u.pn * 256 + bj * 128 + wc * 32 + 8 * fq) = (u32x4){pk2(v0[0], v0[1]), pk2(v0[2], v0[3]), pk2(v1[0], v1[1]), pk2(v1[2], v1[3])}; } }
    }
};
struct EpiZ {
    static constexpr bool PERM = false, AFTER_DRAIN = false;
    const float* x; const float* MOD; float* Z;
    __device__ __forceinline__ void operator()(const f32x4 (&acc)[2][2][4][2], const Unit& u, int wr, int wc, int fr, int fq) const {
#pragma unroll
        for (int ai = 0; ai < 2; ++ai)
#pragma unroll
            for (int m = 0; m < 4; ++m) { const int r = u.pm * 256 + ai * 128 + wr * 64 + m * 16 + fr, b = r >> 11;
#pragma unroll
                for (int bj = 0; bj < 2; ++bj)
#pragma unroll
                    for (int n = 0; n < 2; ++n) { const int c = u.pn * 256 + bj * 128 + wc * 32 + n * 16 + 4 * fq; const size_t off = (size_t)r * D + c;
                        const f32x4 xv = *(const f32x4*)(x + off), gv = *(const f32x4*)(MOD + (size_t)b * 6144 + 2048 + c);
                        *(f32x4*)(Z + off) = xv * DN_ALPHA + gv * acc[ai][bj][m][n]; } }
    }
};

constexpr int P7_U2F = 0, P7_LD = 1028, P7_PART = 16 * P7_LD * 4, P7_LOG = P7_PART + 8 * 16 * 48 * 4, P7_CNT = P7_LOG + 16 * 48 * 4;
__device__ __forceinline__ void phase7(const Params& p, LAS unsigned char* lds, int tid, int wave, int lane) {
    const int G = gridDim.x, gw = blockIdx.x * NWAVES + wave, NGW = G * NWAVES;
    LAS float* u2f = (LAS float*)(lds + P7_U2F); LAS float* part = (LAS float*)(lds + P7_PART); LAS float* logt = (LAS float*)(lds + P7_LOG);
    LAS int* lcnt = (LAS int*)(lds + P7_CNT);
    if (tid < 32) lcnt[tid] = 0;
    __syncthreads();
    const float* MOD = (const float*)(p.ws + WS_MOD); const float* WR = (const float*)(p.ws + WS_WRT);
    bf16_t* U2 = (bf16_t*)(p.ws + WS_U2); int* rec = (int*)(p.ws + WS_TOKREC);
    const float* g1 = p.in[I_LN1G]; const float* b1 = p.in[I_LN1B];
    const int fr = lane & 15, fq = lane >> 4;
    float wreg[32][3];
    { const float* bp = WR + (size_t)(wave * 128 + fq) * 48 + fr;
#pragma unroll
      for (int kk = 0; kk < 32; ++kk)
#pragma unroll
          for (int nt = 0; nt < 3; ++nt) wreg[kk][nt] = bp[(size_t)kk * 4 * 48 + 16 * nt]; }
    const bf16_t* Y2 = (const bf16_t*)(p.ws + WS_Y2); const float* xin = p.in[I_X];
    f32x4 zn[2][4]; u32x2 yn[2][4];
    if ((int)blockIdx.x < NLAT / 16) {
#pragma unroll
        for (int rr = 0; rr < 2; ++rr)
#pragma unroll
            for (int j = 0; j < 4; ++j) { const size_t R = (size_t)(blockIdx.x * 16 + wave * 2 + rr); zn[rr][j] = ld_nt((const f32x4*)(xin + R * D) + lane + 64 * j); yn[rr][j] = ld_nt((const u32x2*)(Y2 + R * D) + lane + 64 * j); } }
    for (int bi = blockIdx.x; bi < NLAT / 16; bi += G) {
#pragma unroll
        for (int rr = 0; rr < 2; ++rr) {
            const int rl = wave * 2 + rr, R = bi * 16 + rl, b = R >> 11;
            f32x4 zc[4];
            { const float* gv = MOD + (size_t)b * 6144 + 2048;
#pragma unroll
              for (int j = 0; j < 4; ++j) { const f32x4 g = *(const f32x4*)(gv + 4 * lane + 256 * j); const u32x2 y = yn[rr][j];
                  zc[j] = zn[rr][j] * DN_ALPHA + g * (f32x4){bflo(y.x), bfhi(y.x), bflo(y.y), bfhi(y.y)}; } }
            if (bi + G < NLAT / 16) {
#pragma unroll
                for (int j = 0; j < 4; ++j) { const size_t Rn = (size_t)((bi + G) * 16 + rl); zn[rr][j] = ld_nt((const f32x4*)(xin + Rn * D) + lane + 64 * j); yn[rr][j] = ld_nt((const u32x2*)(Y2 + Rn * D) + lane + 64 * j); } }
            float* zr = p.out + (size_t)R * D;
            f32x4 v[4]; float s = 0.f;
#pragma unroll
            for (int j = 0; j < 4; ++j) { v[j] = zc[j]; s += (v[j].x + v[j].y) + (v[j].z + v[j].w); }
            float mean = wave_sum(s) * (1.f / D); float s2 = 0.f;
#pragma unroll
            for (int j = 0; j < 4; ++j) { v[j] = v[j] - mean; s2 += (v[j].x * v[j].x + v[j].y * v[j].y) + (v[j].z * v[j].z + v[j].w * v[j].w); }
            float rstd = 1.f / sqrtf(wave_sum(s2) * (1.f / D) + LN_EPS);
            s = 0.f;
#pragma unroll
            for (int j = 0; j < 4; ++j) { const int col = 4 * lane + 256 * j; v[j] = v[j] * rstd * *(const f32x4*)(g1 + col) + *(const f32x4*)(b1 + col); st_nt((f32x4*)zr + lane + 64 * j, v[j]); s += (v[j].x + v[j].y) + (v[j].z + v[j].w); }
            mean = wave_sum(s) * (1.f / D); s2 = 0.f;
#pragma unroll
            for (int j = 0; j < 4; ++j) { v[j] = v[j] - mean; s2 += (v[j].x * v[j].x + v[j].y * v[j].y) + (v[j].z * v[j].z + v[j].w * v[j].w); }
            rstd = 1.f / sqrtf(wave_sum(s2) * (1.f / D) + LN_EPS);
            const float* sh = MOD + (size_t)b * 6144 + 3072; const float* sc = sh + 1024;
            u32x2* o8 = (u32x2*)(U2 + (size_t)R * D);
#pragma unroll
            for (int j = 0; j < 4; ++j) { const int col = 4 * lane + 256 * j; v[j] = v[j] * rstd * (*(const f32x4*)(sc + col) + 1.f) + *(const f32x4*)(sh + col);
                o8[lane + 64 * j] = (u32x2){pk2(v[j].x, v[j].y), pk2(v[j].z, v[j].w)};
                *(LAS f32x4*)(u2f + rl * P7_LD + col) = v[j]; }
        }
        __syncthreads();
        {
            f32x4 acc[3];
#pragma unroll
            for (int nt = 0; nt < 3; ++nt) acc[nt] = (f32x4){0.f, 0.f, 0.f, 0.f};
            const LAS float* ap = u2f + fr * P7_LD + wave * 128 + fq;
#pragma unroll
            for (int kk = 0; kk < 32; ++kk) {
                const float av = ap[4 * kk];
#pragma unroll
                for (int nt = 0; nt < 3; ++nt) acc[nt] = __builtin_amdgcn_mfma_f32_16x16x4f32(av, wreg[kk][nt], acc[nt], 0, 0, 0);
            }
#pragma unroll
            for (int nt = 0; nt < 3; ++nt)
#pragma unroll
                for (int r = 0; r < 4; ++r) part[(wave * 16 + 4 * fq + r) * 48 + 16 * nt + fr] = acc[nt][r];
        }
        __syncthreads();
        for (int i = tid; i < 16 * 48; i += NTHREADS) { float q = 0.f;
#pragma unroll
            for (int w = 0; w < 8; ++w) q += part[w * 16 * 48 + i];
            logt[i] = q; }
        __syncthreads();
        if (tid < 16) {
            const int R = bi * 16 + tid; const LAS float* lg = logt + tid * 48;
            float gl[4];
#pragma unroll
            for (int i = 0; i < 4; ++i) gl[i] = lg[i] + p.in[I_BRG][i];
            int gi = 0; float gm = gl[0];
#pragma unroll
            for (int i = 1; i < 4; ++i) if (gl[i] > gm) { gm = gl[i]; gi = i; }
            float gsum = 0.f;
#pragma unroll
            for (int i = 0; i < 4; ++i) gsum += expf(gl[i] - gm);
            const float pg = 1.f / gsum;
            int e0 = 0, e1 = -1; float m0 = -3.0e38f, m1 = -3.0e38f;
            for (int j = 0; j < 8; ++j) { const float x = lg[4 + gi * 8 + j] + p.in[I_BRE][gi * 8 + j];
                if (x > m0) { m1 = m0; e1 = e0; m0 = x; e0 = j; } else if (x > m1) { m1 = x; e1 = j; } }
            const float p1 = expf(m1 - m0); const float w0 = pg / (1.f + p1), w1 = pg * p1 / (1.f + p1);
            const int E0 = gi * 8 + e0, E1 = gi * 8 + e1;
            const int r0 = atomicAdd((int*)&lcnt[E0], 1), r1 = atomicAdd((int*)&lcnt[E1], 1);
            int* rr = rec + (size_t)R * 8; rr[0] = E0; rr[1] = E1; rr[2] = r0; rr[3] = r1; rr[4] = __float_as_int(w0); rr[5] = __float_as_int(w1); rr[6] = (int)blockIdx.x; rr[7] = 0;
        }
    }
    __syncthreads();
    if (tid < 32) { const int base = atomicAdd((int*)(p.ws + WS_CTL) + tid, lcnt[tid]); ((int*)(p.ws + WS_BASE))[blockIdx.x * 32 + tid] = base; }
    {
        LAS float* scr = (LAS float*)(lds + wave * 8448);
        constexpr int I13 = 16 * 16, I2 = 8 * 32;
        for (int it = gw; it < 32 * (2 * I13 + I2); it += NGW) {
            const int e = it / (2 * I13 + I2); int r = it % (2 * I13 + I2);
            bf16_t* w13 = (bf16_t*)(p.ws + WS_W13T) + (size_t)e * 1024 * 1024; bf16_t* w2 = (bf16_t*)(p.ws + WS_W2T) + (size_t)e * 1024 * 512;
            if (r < I13) { transpose_item<2>(p.in[I_WE1] + (size_t)e * 1024 * 512, 1024, 512, w13, scr, r, lane); continue; } r -= I13;
            if (r < I13) { transpose_item<3>(p.in[I_WE3] + (size_t)e * 1024 * 512, 1024, 512, w13, scr, r, lane); continue; } r -= I13;
            transpose_item<0>(p.in[I_WE2] + (size_t)e * 512 * 1024, 512, 1024, w2, scr, r, lane);
        }
    }
}

__device__ __forceinline__ void phase8(const Params& p, LAS unsigned char* lds, int tid, int wave, int lane) {
    const int G = gridDim.x, gw = blockIdx.x * NWAVES + wave, NGW = G * NWAVES;
    LAS int* poff = (LAS int*)lds;
    if (tid == 0) { const int* gc = (const int*)(p.ws + WS_CTL); int off = 0;
        for (int e = 0; e < 32; ++e) { const int c = gc[e]; poff[e] = off; poff[32 + e] = c; off += ((c + 255) >> 8) << 8; }
        poff[64] = off >> 8; }
    __syncthreads();
    const int ntiles = poff[64];
    if (blockIdx.x == 0) {
        int* te = (int*)(p.ws + WS_TILEEXP);
        for (int t = tid; t < 288; t += NTHREADS) { int ex = 31; for (int e = 0; e < 32; ++e) { const int c = poff[32 + e]; const int pe = poff[e] + (((c + 255) >> 8) << 8); if (t * 256 < pe) { ex = e; break; } } te[t] = ex; }
        if (tid == 0) ((int*)(p.ws + WS_CTL))[64] = ntiles;
    }
    const int* rec = (const int*)(p.ws + WS_TOKREC); const int* base = (const int*)(p.ws + WS_BASE);
    const bf16_t* U2 = (const bf16_t*)(p.ws + WS_U2); bf16_t* Xs = (bf16_t*)(p.ws + WS_XS); int* ts = (int*)(p.ws + WS_TOKSLOT);
    {
        int E0 = 0, E1 = 0, lr0 = 0, lr1 = 0, w0b = 0, w1b = 0, blk = 0; u32x4 ua = (u32x4){0u, 0u, 0u, 0u}, uc = ua;
        if (gw < NLAT) { const int* rr = rec + (size_t)gw * 8; E0 = rr[0]; E1 = rr[1]; lr0 = rr[2]; lr1 = rr[3]; w0b = rr[4]; w1b = rr[5]; blk = rr[6];
            const u32x4* src = (const u32x4*)(U2 + (size_t)gw * D); ua = ld_nt(src + lane); uc = ld_nt(src + lane + 64); }
        for (int R = gw; R < NLAT; R += NGW) {
            const int Rn = R + NGW; int nE0 = 0, nE1 = 0, nlr0 = 0, nlr1 = 0, nw0 = 0, nw1 = 0, nblk = 0; u32x4 na = ua, nc = uc;
            if (Rn < NLAT) { const int* rr = rec + (size_t)Rn * 8; nE0 = rr[0]; nE1 = rr[1]; nlr0 = rr[2]; nlr1 = rr[3]; nw0 = rr[4]; nw1 = rr[5]; nblk = rr[6];
                const u32x4* src = (const u32x4*)(U2 + (size_t)Rn * D); na = ld_nt(src + lane); nc = ld_nt(src + lane + 64); }
            const int s0 = poff[E0] + base[blk * 32 + E0] + lr0, s1 = poff[E1] + base[blk * 32 + E1] + lr1;
            u32x4* d0 = (u32x4*)(Xs + (size_t)s0 * D); u32x4* d1 = (u32x4*)(Xs + (size_t)s1 * D);
            d0[lane] = ua; d0[lane + 64] = uc; d1[lane] = ua; d1[lane + 64] = uc;
            if (lane == 0) { int* t4 = ts + (size_t)R * 4; t4[0] = s0; t4[1] = s1; t4[2] = w0b; t4[3] = w1b; }
            E0 = nE0; E1 = nE1; lr0 = nlr0; lr1 = nlr1; w0b = nw0; w1b = nw1; blk = nblk; ua = na; uc = nc;
        }
    }
    for (int e = 0; e < 32; ++e) { const int c = poff[32 + e]; const int lo = poff[e] + c, hi = poff[e] + (((c + 255) >> 8) << 8);
        for (int r = lo + gw; r < hi; r += NGW) { u32x4* d = (u32x4*)(Xs + (size_t)r * D); d[lane] = (u32x4){0u, 0u, 0u, 0u}; d[lane + 64] = (u32x4){0u, 0u, 0u, 0u}; } }
}

struct SchedMoe { int G, c; const int* tile_exp; int ntiles, rep; __device__ __forceinline__ void a_ready(const Unit&) const {} __device__ __forceinline__ void done(const Unit&) const {}
    __device__ __forceinline__ bool next(int i, Unit& u) const {
        const int x = c & 7, y = c >> 3, nxc = G >> 3; int q = i * nxc + y; const int t0 = (x * ntiles) >> 3, t1 = ((x + 1) * ntiles) >> 3, ntot = (t1 - t0) * 4; if (q >= rep * ntot) return false; q %= ntot;
        const int t = t0 + (q >> 2); u.pm = t; u.pn = tile_exp[t] * 4 + (q & 3); return true; } };
struct EpiH {
    static constexpr bool PERM = true, AFTER_DRAIN = false;
    bf16_t* Hs;
    __device__ __forceinline__ void operator()(const f32x4 (&acc)[2][2][4][2], const Unit& u, int wr, int wc, int fr, int fq) const {
        const int j = u.pn & 3;
#pragma unroll
        for (int ai = 0; ai < 2; ++ai)
#pragma unroll
            for (int m = 0; m < 4; ++m) { const int r = u.pm * 256 + ai * 128 + wr * 64 + m * 16 + fr; float o[8];
#pragma unroll
                for (int k = 0; k < 8; ++k) o[k] = silu_f(acc[ai][0][m][k >> 2][k & 3]) * acc[ai][1][m][k >> 2][k & 3];
                *(u32x4*)(Hs + (size_t)r * DE + j * 128 + wc * 32 + 8 * fq) = (u32x4){pk2(o[0], o[1]), pk2(o[2], o[3]), pk2(o[4], o[5]), pk2(o[6], o[7])}; }
    }
};
struct EpiYs {
    static constexpr bool PERM = true, AFTER_DRAIN = false;
    bf16_t* Ys;
    __device__ __forceinline__ void operator()(const f32x4 (&acc)[2][2][4][2], const Unit& u, int wr, int wc, int fr, int fq) const {
        const int j = u.pn & 3;
#pragma unroll
        for (int ai = 0; ai < 2; ++ai)
#pragma unroll
            for (int m = 0; m < 4; ++m) { const int r = u.pm * 256 + ai * 128 + wr * 64 + m * 16 + fr;
#pragma unroll
                for (int bj = 0; bj < 2; ++bj) { const f32x4 v0 = acc[ai][bj][m][0], v1 = acc[ai][bj][m][1];
                    *(u32x4*)(Ys + (size_t)r * D + j * 256 + bj * 128 + wc * 32 + 8 * fq) = (u32x4){pk2(v0[0], v0[1]), pk2(v0[2], v0[3]), pk2(v1[0], v1[1]), pk2(v1[2], v1[3])}; } }
    }
};

__device__ __forceinline__ void phase11(const Params& p, int wave, int lane) {
    const int gw = blockIdx.x * NWAVES + wave, NGW = gridDim.x * NWAVES;
    const float* MOD = (const float*)(p.ws + WS_MOD); const bf16_t* Ys = (const bf16_t*)(p.ws + WS_YS); const int* ts = (const int*)(p.ws + WS_TOKSLOT);
    const float* g2 = p.in[I_LN2G]; const float* b2 = p.in[I_LN2B];
    f32x4 x1[4], nx1[4]; u32x2 ya[4], yc[4], nya[4], nyc[4]; float w0 = 0.f, w1 = 0.f, nw0 = 0.f, nw1 = 0.f;
    if (gw < NLAT) { const int* t4 = ts + (size_t)gw * 4; const int s0 = t4[0], s1 = t4[1]; w0 = __int_as_float(t4[2]); w1 = __int_as_float(t4[3]);
#pragma unroll
        for (int j = 0; j < 4; ++j) { x1[j] = ld_nt((const f32x4*)(p.out + (size_t)gw * D) + lane + 64 * j); ya[j] = ld_nt((const u32x2*)(Ys + (size_t)s0 * D) + lane + 64 * j); yc[j] = ld_nt((const u32x2*)(Ys + (size_t)s1 * D) + lane + 64 * j); } }
    for (int R = gw; R < NLAT; R += NGW) {
        const int Rn = R + NGW;
        if (Rn < NLAT) { const int* t4 = ts + (size_t)Rn * 4; const int s0 = t4[0], s1 = t4[1]; nw0 = __int_as_float(t4[2]); nw1 = __int_as_float(t4[3]);
#pragma unroll
            for (int j = 0; j < 4; ++j) { nx1[j] = ld_nt((const f32x4*)(p.out + (size_t)Rn * D) + lane + 64 * j); nya[j] = ld_nt((const u32x2*)(Ys + (size_t)s0 * D) + lane + 64 * j); nyc[j] = ld_nt((const u32x2*)(Ys + (size_t)s1 * D) + lane + 64 * j); } }
        const int b = R >> 11; float* xr = p.out + (size_t)R * D; const float* gg = MOD + (size_t)b * 6144 + 5120;
        f32x4 v[4]; float s = 0.f;
#pragma unroll
        for (int j = 0; j < 4; ++j) { const int col = 4 * lane + 256 * j; const u32x2 a = ya[j], c = yc[j];
            f32x4 f; f.x = w0 * bflo(a.x) + w1 * bflo(c.x); f.y = w0 * bfhi(a.x) + w1 * bfhi(c.x); f.z = w0 * bflo(a.y) + w1 * bflo(c.y); f.w = w0 * bfhi(a.y) + w1 * bfhi(c.y);
            v[j] = x1[j] * DN_ALPHA + *(const f32x4*)(gg + col) * f; s += (v[j].x + v[j].y) + (v[j].z + v[j].w); }
        const float mean = wave_sum(s) * (1.f / D); float s2 = 0.f;
#pragma unroll
        for (int j = 0; j < 4; ++j) { v[j] = v[j] - mean; s2 += (v[j].x * v[j].x + v[j].y * v[j].y) + (v[j].z * v[j].z + v[j].w * v[j].w); }
        const float rstd = 1.f / sqrtf(wave_sum(s2) * (1.f / D) + LN_EPS);
#pragma unroll
        for (int j = 0; j < 4; ++j) { const int col = 4 * lane + 256 * j; st_nt((f32x4*)xr + lane + 64 * j, v[j] * rstd * *(const f32x4*)(g2 + col) + *(const f32x4*)(b2 + col)); }
#pragma unroll
        for (int j = 0; j < 4; ++j) { x1[j] = nx1[j]; ya[j] = nya[j]; yc[j] = nyc[j]; }
        w0 = nw0; w1 = nw1;
    }
}

#define XB_TMO      128
#define XB_XCNT(j)  (256  + 64 * (j))
#define XB_XSUB(j)  (1280 + 64 * (j))
#define XB_XGEN(j)  (2304 + 64 * (j))
#define XB_TOP      3328
#define XB_TOPGEN   3392
#define XCD_BAR_WORDS 3456
#define XB_SPIN_CAP (1u << 18)

__device__ __forceinline__ unsigned xb_ld(unsigned* p)              { return __hip_atomic_load(p, __ATOMIC_RELAXED, __HIP_MEMORY_SCOPE_AGENT); }
__device__ __forceinline__ unsigned xb_add(unsigned* p, unsigned v) { return __hip_atomic_fetch_add(p, v, __ATOMIC_RELAXED, __HIP_MEMORY_SCOPE_AGENT); }
__device__ __forceinline__ unsigned xb_xcc_id() { return (unsigned)__builtin_amdgcn_s_getreg((3 << 11) | 20) & 0xFu; }
#define XB_SPIN(cond, bar) do { unsigned _sp = 0; while (cond) { __builtin_amdgcn_s_sleep(1); \
    if ((++_sp & 255u) == 0u) { if (xb_ld(&(bar)[XB_TMO])) break; if (_sp > XB_SPIN_CAP) { atomicAdd(&(bar)[XB_TMO], 1u); break; } } } } while (0)

struct XcdBarrier {
    unsigned* bar; unsigned x;
    volatile LAS unsigned* st;
};

__device__ __forceinline__ XcdBarrier xcd_barrier_post(unsigned* bar, volatile LAS unsigned* st) {
    XcdBarrier b; b.bar = bar; b.x = xb_xcc_id(); b.st = st;
    if (threadIdx.x == 0) (void)xb_add(&bar[XB_XCNT(b.x)], 1u);
    return b;
}
__device__ __forceinline__ void xcd_barrier_complete(unsigned* bar, unsigned x, unsigned& nloc, unsigned& nx) {
    const unsigned G = gridDim.x * gridDim.y * gridDim.z;
    unsigned sum, cnt, mine, sp = 0u;
    for (;;) {
        sum = 0u; cnt = 0u; mine = 0u;
#pragma unroll
        for (unsigned j = 0; j < 16; ++j) { const unsigned c = xb_ld(&bar[XB_XCNT(j)]); sum += c; cnt += (c > 0u) ? 1u : 0u; mine = (j == x) ? c : mine; }
        if (sum == G) break;
        __builtin_amdgcn_s_sleep(1);
        if ((++sp & 255u) == 0u) { if (xb_ld(&bar[XB_TMO])) break; if (sp > XB_SPIN_CAP) { atomicAdd(&bar[XB_TMO], 1u); break; } }
    }
    nloc = mine > 0u ? mine : 1u; nx = cnt > 0u ? cnt : 1u;
}

__device__ __forceinline__ void xcd_barrier(const XcdBarrier& b) {
    asm volatile("s_waitcnt vmcnt(0)" ::: "memory");
    __syncthreads();
    if (threadIdx.x == 0) {
        unsigned* bar = b.bar;
        __builtin_amdgcn_s_waitcnt(0);
        unsigned nloc = b.st[0], nx = b.st[1];
        if (nloc == 0u) { xcd_barrier_complete(bar, b.x, nloc, nx); b.st[0] = nloc; b.st[1] = nx; }
        const unsigned old = xb_add(&bar[XB_XSUB(b.x)], 1u);
        const unsigned gen = old / nloc;
        if (old + 1u == (gen + 1u) * nloc) {
            __builtin_amdgcn_fence(__ATOMIC_RELEASE, "agent");
            asm volatile("s_waitcnt vmcnt(0)" ::: "memory");
            const unsigned og = xb_add(&bar[XB_TOP], 1u);
            const unsigned tg = og / nx;
            if (og + 1u == (tg + 1u) * nx) xb_add(&bar[XB_TOPGEN], 1u);
            else XB_SPIN(xb_ld(&bar[XB_TOPGEN]) == tg, bar);
            __builtin_amdgcn_fence(__ATOMIC_ACQUIRE, "agent");
            xb_add(&bar[XB_XGEN(b.x)], 1u);
            asm volatile("s_waitcnt vmcnt(0)" ::: "memory");
        } else {
            XB_SPIN(xb_ld(&bar[XB_XGEN(b.x)]) == gen, bar);
            __builtin_amdgcn_fence(__ATOMIC_ACQUIRE, "agent");
            asm volatile("s_waitcnt vmcnt(0)" ::: "memory");
        }
    }
    __syncthreads();
}

#ifdef USE_SIMPLE_GEMM
#define GEMM_CALL(g, S, E) gemm_simple(g, S, E)
#else
#define GEMM_CALL(g, S, E) pg8::gemm_phase<decltype(E), decltype(S), true, true>(lds, g, S, E)
#endif
#ifdef USE_SIMPLE_SCAN
#define SCAN_CALL scan_phase
#else
#ifdef USE_SCAN2
#define SCAN_CALL scan_phase2
#else
#define SCAN_CALL scan_phase3<0>
#endif
#endif
constexpr int NPHASE = 15;
__global__ void __launch_bounds__(NTHREADS) mega(Params p) {
    extern __shared__ __attribute__((aligned(16))) unsigned char lds_raw[];
    LAS unsigned char* lds = (LAS unsigned char*)lds_raw;
    cg::grid_group grid = cg::this_grid();
    const int tid = threadIdx.x, lane = tid & 63, wave = __builtin_amdgcn_readfirstlane(tid >> 6);
    unsigned char* ws = p.ws;
    const int G = gridDim.x, c = blockIdx.x;
    volatile LAS unsigned* xst = (volatile LAS unsigned*)(lds + LDS_BYTES - 16);
    if (tid < 2) xst[tid] = 0u;
    __syncthreads();
    XcdBarrier xbar; xbar.bar = (unsigned*)(ws + WS_BAR); xbar.x = 0; xbar.st = xst;
#ifndef PHMASK
#define PHMASK 0x7fff
#endif
#define IN(k) (((PHMASK >> (k)) & 1) && p.ph_lo <= (k) && (k) < p.ph_hi)
#define GSYNC() xcd_barrier(xbar)
#define SEAM(k) do { if (IN(k) && IN((k) + 1)) { if ((k) == 0) { grid.sync(); xbar = xcd_barrier_post((unsigned*)(ws + WS_BAR), xst); } else GSYNC(); } } while (0)
#ifndef REPMASK
#define REPMASK 0
#endif
#ifndef REPN
#define REPN 2
#endif
#define GEMMPH ((1 << 2) | (1 << 4) | (1 << 7) | (1 << 9) | (1 << 10) | (1 << 13))
#define GREP(k) ((((REPMASK) >> (k)) & 1) ? REPN : 1)
#define PHASE(k) for (int rep_ = 0; rep_ < (IN(k) ? (((((REPMASK) & ~GEMMPH) >> (k)) & 1) ? REPN : 1) : 0); ++rep_) if (rep_ ? (GSYNC(), true) : true)
    PHASE(0) phase0(p, lds, tid, wave, lane);
    SEAM(0);
    PHASE(1) phase1(p, wave, lane);
    SEAM(1);
    PHASE(2) { Gemm g{(const bf16_t*)(ws + WS_U), (const bf16_t*)(ws + WS_WT_IN), NROW, IN_PHYS, D}; SchedProj<0> S{G, c, GREP(2)}; EpiProj E{ws, p.in[I_BMG], lds, p.in[I_CONVW], p.in[I_CONVB]}; GEMM_CALL(g, S, E); }
    SEAM(2);
    PHASE(3) { ScanArgs a{(const bf16_t*)(ws + WS_RQ), (const bf16_t*)(ws + WS_RK), (const bf16_t*)(ws + WS_RVT), (const float*)(ws + WS_G), p.in[I_DECAY], (bf16_t*)p.out, (bf16_t*)p.out + (size_t)NLAT * D, 0}; SCAN_CALL(lds, a, tid, wave, lane); }
#ifdef SCANPROBE
    if (IN(3)) { GSYNC(); ScanArgs a{(const bf16_t*)(ws + WS_RQ), (const bf16_t*)(ws + WS_RK), (const bf16_t*)(ws + WS_RVT), (const float*)(ws + WS_G), p.in[I_DECAY], (bf16_t*)(ws + WS_X0), (bf16_t*)(ws + WS_X0 + 64 * MiB), 0}; scan_phase3<SCANPROBE>(lds, a, tid, wave, lane); }
#endif
    SEAM(3);
    PHASE(4) { Gemm g{(const bf16_t*)(ws + WS_U), (const bf16_t*)(ws + WS_WT_IN), NROW, IN_PHYS, D}; SchedProj<1> S{G, c, GREP(4)};
        const int pnl = 16 + ((((c >> 3) + 6) & 15) >> 1);
        { LAS float* WL = (LAS float*)(lds + 139264); const float* cwp = p.in[I_CONVW]; const float* cbp = p.in[I_CONVB]; const int cg0 = ((pnl >> 2) - 4) * 1024 + (pnl & 3) * 256;
          for (int i = tid; i < 1024; i += NTHREADS) { const int k = i >> 8, col = i & 255; WL[i] = ((k < 3) ? cwp[k * 2048 + cg0 + col] : cbp[cg0 + col]) * ((pnl >> 2) == 5 ? 0.0625f : 1.f); }
          __syncthreads(); }
        EpiProj E{ws, p.in[I_BMG], lds, p.in[I_CONVW], p.in[I_CONVB], pnl}; GEMM_CALL(g, S, E); }
    if (IN(4) && IN(6)) GSYNC();
    PHASE(6) { ScanArgs a{(const bf16_t*)(ws + WS_MQ), (const bf16_t*)(ws + WS_MK), (const bf16_t*)(ws + WS_MVT), (const float*)(ws + WS_G), p.in[I_DECAY], (bf16_t*)(ws + WS_OMF), (bf16_t*)(ws + WS_OMB), 1}; SCAN_CALL(lds, a, tid, wave, lane); }
    SEAM(6);
    PHASE(7) { Gemm g{(const bf16_t*)(ws + WS_U), (const bf16_t*)(ws + WS_WT_IN), NROW, IN_PHYS, D}; SchedProj<2> S{G, c, GREP(7)}; EpiProj E{ws, p.in[I_BMG], lds, p.in[I_CONVW], p.in[I_CONVB]}; GEMM_CALL(g, S, E); }
    SEAM(7);
    PHASE(8) {
        phase4_one<0>((const bf16_t*)p.out, (const bf16_t*)p.out + (size_t)NLAT * D, (const bf16_t*)(ws + WS_RGA), (bf16_t*)p.out, wave, lane);
        phase4_one<1>((const bf16_t*)(ws + WS_OMF), (const bf16_t*)(ws + WS_OMB), (const bf16_t*)(ws + WS_MOA), (bf16_t*)(ws + WS_M), wave, lane);
    }
    SEAM(8);
    PHASE(9) {
        SchedDense S{G, c, 128, 4, 1}; SchedDense S1{G, c, 128, 4, GREP(9)};
        { Gemm g{(const bf16_t*)p.out, (const bf16_t*)(ws + WS_WT_R), NLAT, D, D}; EpiY E{(bf16_t*)(ws + WS_Y), (const bf16_t*)(ws + WS_GRA), 0}; GEMM_CALL(g, S1, E); }
        { Gemm g{(const bf16_t*)(ws + WS_M), (const bf16_t*)(ws + WS_WT_M), NLAT, D, D}; EpiY E{(bf16_t*)(ws + WS_Y), (const bf16_t*)(ws + WS_GMA), 1}; GEMM_CALL(g, S, E); }
    }
    SEAM(9);
    PHASE(10) { SchedDense S{G, c, 128, 4, GREP(10)}; Gemm g{(const bf16_t*)(ws + WS_Y), (const bf16_t*)(ws + WS_WT_O), NLAT, D, D}; EpiY2 E{(bf16_t*)(ws + WS_Y2)}; GEMM_CALL(g, S, E); }
    SEAM(10);
    PHASE(11) phase7(p, lds, tid, wave, lane);
    SEAM(11);
    PHASE(12) phase8(p, lds, tid, wave, lane);
    SEAM(12);
    PHASE(13) {
        const int ntiles = ((const int*)(ws + WS_CTL))[64];
        SchedMoe S{G, c, (const int*)(ws + WS_TILEEXP), ntiles, GREP(13)};
        Gemm g{(const bf16_t*)(ws + WS_XS), (const bf16_t*)(ws + WS_W13T), MAXSLOT, 32 * 1024, D}; EpiH E{(bf16_t*)(ws + WS_HS)}; GEMM_CALL(g, S, E);
        GSYNC();
        Gemm g2{(const bf16_t*)(ws + WS_HS), (const bf16_t*)(ws + WS_W2T), MAXSLOT, 32 * 1024, DE}; EpiYs E2{(bf16_t*)(ws + WS_YS)}; GEMM_CALL(g2, S, E2);
    }
    SEAM(13);
    PHASE(14) phase11(p, wave, lane);
#undef IN
#undef SEAM
}

extern "C" void kernel_launch(void* const* d_in, const int* in_sizes, int n_in, void* d_out, int out_size, void* d_ws, size_t ws_size, hipStream_t stream) {
    static int grid = 0;
    if (grid == 0) {
        if (n_in != 25 || out_size != NLAT * D || ws_size < WS_NEED) { fprintf(stderr, "kernel_launch: unexpected shapes n_in %d out %d ws %zu; nothing launched\n", n_in, out_size, ws_size); grid = -1; return; }
        int dev = 0, cus = 0, per_cu = 0;
        if (hipGetDevice(&dev) != hipSuccess || hipDeviceGetAttribute(&cus, hipDeviceAttributeMultiprocessorCount, dev) != hipSuccess) { grid = -1; return; }
        if (hipFuncSetAttribute((const void*)mega, hipFuncAttributeMaxDynamicSharedMemorySize, LDS_BYTES) != hipSuccess) { fprintf(stderr, "kernel_launch: hipFuncSetAttribute failed\n"); grid = -1; return; }
        if (hipOccupancyMaxActiveBlocksPerMultiprocessor(&per_cu, (const void*)mega, NTHREADS, LDS_BYTES) != hipSuccess || per_cu < 1) { fprintf(stderr, "kernel_launch: occupancy query says %d\n", per_cu); per_cu = 1; }
        (void)hipGetLastError();
        grid = cus * 1;
        (void)per_cu;
    }
    if (grid < 0) return;
    Params p{};
    for (int i = 0; i < 25; ++i) p.in[i] = (const float*)d_in[i];
    p.out = (float*)d_out; p.ws = (unsigned char*)d_ws; p.ph_lo = 0; p.ph_hi = NPHASE;
    void* args[] = {&p};
    hipError_t e = hipLaunchCooperativeKernel((const void*)mega, dim3(grid), dim3(NTHREADS), args, LDS_BYTES, stream);
    if (e != hipSuccess) fprintf(stderr, "kernel_launch: cooperative launch failed: %s (grid %d)\n", hipGetErrorString(e), grid);
}
```

```cpp
#include <hip/hip_runtime.h>
#include <hip/hip_cooperative_groups.h>
#include <cstdio>
#include <cstdint>
namespace cg = cooperative_groups;

#define LAS __attribute__((address_space(3)))
typedef unsigned short bf16_t;
typedef short bf16x8 __attribute__((ext_vector_type(8)));
typedef float f32x4 __attribute__((ext_vector_type(4)));
typedef float f32x2 __attribute__((ext_vector_type(2)));
typedef unsigned u32x4 __attribute__((ext_vector_type(4)));
typedef unsigned u32x2 __attribute__((ext_vector_type(2)));
typedef __bf16 bf16x2_t __attribute__((ext_vector_type(2)));

constexpr int D = 1024, NB = 16, T = 2048, TC = 256, TT = T + TC;
constexpr int NROW = NB * TT;
constexpr int NLAT = NB * T;
constexpr int NH = 4, DH = 256;
constexpr int IN_COLS = 10256, IN_PHYS = 10496;
constexpr int NE = 32, DE = 512;
constexpr int CH = 64;
constexpr float LN_EPS = 1e-5f;
constexpr float DN_ALPHA = 1.189207115002721f;
constexpr int MAXSLOT = 73728;

constexpr size_t MiB = 1u << 20;
constexpr size_t WS_CTL = 0;
constexpr size_t WS_BAR = 16384;
constexpr size_t WS_WT_IN = 1 * MiB;
constexpr size_t WS_WT_R = 22 * MiB, WS_WT_M = 24 * MiB, WS_WT_O = 26 * MiB;
constexpr size_t WS_MOD = 28 * MiB;
constexpr size_t WS_ROT = 29 * MiB;
constexpr size_t WS_G = 30 * MiB;
constexpr size_t WS_WRT = 33 * MiB;
constexpr size_t WS_TOKREC = 34 * MiB;
constexpr size_t WS_TOKSLOT = 35 * MiB;
constexpr size_t WS_TILEEXP = 36 * MiB;
constexpr size_t WS_BASE = 37 * MiB;
constexpr size_t WS_U = 40 * MiB;
constexpr size_t WS_HS = 40 * MiB;
constexpr size_t WS_X0 = 112 * MiB;
constexpr size_t WS_RQ = 296 * MiB, WS_RK = 368 * MiB, WS_RVT = 440 * MiB;
constexpr size_t WS_MVT = 296 * MiB, WS_MQRAW = 112 * MiB, WS_MKRAW = 184 * MiB;
constexpr size_t WS_MQ = 368 * MiB, WS_MK = 440 * MiB;
constexpr size_t WS_OMF = 112 * MiB, WS_OMB = 176 * MiB;
constexpr size_t WS_RGA = 240 * MiB, WS_MOA = 304 * MiB, WS_GRA = 368 * MiB, WS_GMA = 432 * MiB;
constexpr size_t WS_M = 112 * MiB;
constexpr size_t WS_Y = 176 * MiB;
constexpr size_t WS_Y2 = 112 * MiB;
constexpr size_t WS_U2 = 176 * MiB;
constexpr size_t WS_W13T = 240 * MiB;
constexpr size_t WS_W2T = 304 * MiB;
constexpr size_t WS_XS = 336 * MiB;
constexpr size_t WS_YS = 336 * MiB;
constexpr size_t WS_NEED = 512 * MiB;

constexpr int LDS_BYTES = 151552;
constexpr int NTHREADS = 512, NWAVES = 8;

struct Params { const float* in[25]; float* out; unsigned char* ws; int ph_lo, ph_hi; };
enum { I_X = 0, I_C, I_CTX, I_CCTX, I_WADA, I_BADA, I_WIN, I_BMG, I_CONVW, I_CONVB, I_DECAY, I_WRB, I_WMB, I_WOUT, I_LN1G, I_LN1B,
       I_WRG, I_BRG, I_WRE, I_BRE, I_WE1, I_WE3, I_WE2, I_LN2G, I_LN2B };

__device__ __forceinline__ unsigned pk2(float lo, float hi) { f32x2 v = {lo, hi}; bf16x2_t b = __builtin_convertvector(v, bf16x2_t); return __builtin_bit_cast(unsigned, b); }
__device__ __forceinline__ float bflo(unsigned w) { return __uint_as_float(w << 16); }
__device__ __forceinline__ float bfhi(unsigned w) { return __uint_as_float(w & 0xffff0000u); }
__device__ __forceinline__ float bf2f(bf16_t h) { return __uint_as_float(((unsigned)h) << 16); }
__device__ __forceinline__ bf16_t f2bf(float f) { return (bf16_t)(pk2(f, 0.f) & 0xffffu); }
__device__ __forceinline__ float wave_sum(float v) {
#pragma unroll
    for (int o = 1; o < 64; o <<= 1) v += __shfl_xor(v, o);
    return v;
}
__device__ __forceinline__ float half_sum(float v) {
#pragma unroll
    for (int o = 1; o < 32; o <<= 1) v += __shfl_xor(v, o);
    return v;
}
template <class T> __device__ __forceinline__ T ld_nt(const T* p) { return __builtin_nontemporal_load(p); }
template <class T> __device__ __forceinline__ void st_nt(T* p, const T& v) { __builtin_nontemporal_store(v, p); }
__device__ __forceinline__ float silu_f(float x) { return x / (1.f + __expf(-x)); }
__device__ __forceinline__ float sigmoid_f(float x) { return 1.f / (1.f + __expf(-x)); }
__device__ __forceinline__ float logsigmoid_f(float x) { return fminf(x, 0.f) - log1pf(expf(-fabsf(x))); }
#define MFMA16(a, b, c) __builtin_amdgcn_mfma_f32_16x16x32_bf16((a), (b), (c), 0, 0, 0)

template <int MODE> __device__ __forceinline__ int rowmap(int n) {
    if (MODE == 0) return n;
    if (MODE == 1) {
        if (n < 2048) { const int blk = n >> 10, w = n & 1023, h = w >> 8, dd = w & 255, hb = dd >> 7, part = (dd >> 6) & 1, i = dd & 63; return blk * 1024 + h * 256 + part * 128 + hb * 64 + i; }
        if (n < 8192) return n;
        if (n < 8208) return 10240 + (n - 8192);
        return n - 16;
    }
    if (MODE == 2) return (n >> 7) * 256 + (n & 127);
    return (n >> 7) * 256 + 128 + (n & 127);
}
template <int MODE> __device__ __forceinline__ void transpose_item(const float* W, int K, int N, bf16_t* WT, LAS float* scr, int item, int lane) {
    const int nblk = (N + 31) / 32, kb = item / nblk, nb = item % nblk, k0 = 64 * kb, n0 = 32 * nb;
    const int nn = n0 + (lane & 31);
#pragma unroll 8
    for (int i = 0; i < 32; ++i) { const int kk = 2 * i + (lane >> 5); scr[kk * 33 + (lane & 31)] = (nn < N) ? ld_nt(W + (size_t)(k0 + kk) * N + nn) : 0.f; }
    asm volatile("s_waitcnt lgkmcnt(0)" ::: "memory");
    const int c = lane & 7;
#pragma unroll
    for (int j = 0; j < 4; ++j) { const int n = (lane >> 3) + 8 * j; const LAS float* s = scr + (8 * c) * 33 + n;
        u32x4 o; o.x = pk2(s[0 * 33], s[1 * 33]); o.y = pk2(s[2 * 33], s[3 * 33]); o.z = pk2(s[4 * 33], s[5 * 33]); o.w = pk2(s[6 * 33], s[7 * 33]);
        if (n0 + n < N) *(u32x4*)(WT + (size_t)rowmap<MODE>(n0 + n) * K + k0 + 8 * c) = o; }
    asm volatile("s_waitcnt lgkmcnt(0)" ::: "memory");
}

__device__ __forceinline__ void phase0(const Params& p, LAS unsigned char* lds, int tid, int wave, int lane) {
    const int G = gridDim.x, gw = blockIdx.x * NWAVES + wave, NGW = G * NWAVES;
    unsigned char* ws = p.ws;
    if (blockIdx.x == 0) { if (tid < 64) ((int*)(ws + WS_CTL))[tid] = 0; for (int i = tid; i < 3456; i += NTHREADS) ((unsigned*)(ws + WS_BAR))[i] = 0u; }
    {
        LAS float* scr = (LAS float*)(lds + wave * 8448);
        constexpr int I_IN = 16 * 321, I_SQ = 16 * 32;
        for (int it = gw; it < I_IN + 3 * I_SQ; it += NGW) {
            int r = it;
            if (r < I_IN) { transpose_item<1>(p.in[I_WIN], 1024, IN_COLS, (bf16_t*)(ws + WS_WT_IN), scr, r, lane); continue; } r -= I_IN;
            if (r < I_SQ) { transpose_item<0>(p.in[I_WRB], 1024, 1024, (bf16_t*)(ws + WS_WT_R), scr, r, lane); continue; } r -= I_SQ;
            if (r < I_SQ) { transpose_item<0>(p.in[I_WMB], 1024, 1024, (bf16_t*)(ws + WS_WT_M), scr, r, lane); continue; } r -= I_SQ;
            transpose_item<0>(p.in[I_WOUT], 1024, 1024, (bf16_t*)(ws + WS_WT_O), scr, r, lane);
        }
        u32x4* z = (u32x4*)(ws + WS_WT_IN + (size_t)10256 * 1024 * 2);
        const int nz = 240 * 1024 * 2 / 16;
        for (int i = blockIdx.x * NTHREADS + tid; i < nz; i += G * NTHREADS) z[i] = (u32x4){0u, 0u, 0u, 0u};
    }
    for (int i = blockIdx.x * NTHREADS + tid; i < 4096; i += G * NTHREADS) {
        const int pos = i >> 6, fi = i & 63; const float freq = powf(10000.f, -((float)fi / 64.f)); const float ang = (float)pos * freq;
        ((f32x2*)(ws + WS_ROT))[i] = (f32x2){cosf(ang), sinf(ang)};
    }
    for (int i = blockIdx.x * NTHREADS + tid; i < 48 * 1024; i += G * NTHREADS) {
        const int k = i / 48, o = i - k * 48;
        ((float*)(ws + WS_WRT))[i] = (o < 4) ? p.in[I_WRG][k * 4 + o] : ((o < 36) ? p.in[I_WRE][k * 32 + (o - 4)] : 0.f);
    }
    __syncthreads();
    if ((int)blockIdx.x < 96) {
        LAS float* sl = (LAS float*)lds;
        LAS float* red = (LAS float*)(lds + 17 * 1024 * 4);
        for (int i = tid; i < 17 * 1024; i += NTHREADS) { const int r = i >> 10, k = i & 1023; const float v = (r < 16) ? p.in[I_C][r * 1024 + k] : p.in[I_CCTX][k]; sl[i] = v / (1.f + expf(-v)); }
        __syncthreads();
        for (int it = blockIdx.x; it < 96; it += G) {
            const int col = it * 64 + lane; float acc[17];
#pragma unroll
            for (int r = 0; r < 17; ++r) acc[r] = 0.f;
            const float* wp = p.in[I_WADA] + col;
#pragma unroll 1
            for (int kb = 0; kb < 8; ++kb) {
                const int k0 = wave * 128 + kb * 16; float wv[16];
#pragma unroll
                for (int kk = 0; kk < 16; ++kk) wv[kk] = wp[(size_t)(k0 + kk) * 6144];
#pragma unroll
                for (int kk = 0; kk < 16; ++kk) {
#pragma unroll
                    for (int r = 0; r < 17; ++r) acc[r] += sl[r * 1024 + k0 + kk] * wv[kk];
                    if ((kk & 3) == 3) __builtin_amdgcn_sched_barrier(0);
                }
            }
#pragma unroll
            for (int r = 0; r < 17; ++r) red[(wave * 17 + r) * 64 + lane] = acc[r];
            __syncthreads();
            for (int i = tid; i < 17 * 64; i += NTHREADS) { const int r = i >> 6, l = i & 63; float s = 0.f;
#pragma unroll
                for (int w = 0; w < 8; ++w) s += red[(w * 17 + r) * 64 + l];
                ((float*)(ws + WS_MOD))[r * 6144 + it * 64 + l] = s + p.in[I_BADA][it * 64 + l]; }
            __syncthreads();
        }
    }
}

__device__ __forceinline__ const float* p1_src(const Params& p, int R, int& mr) {
    const int b = R / TT, tt = R - b * TT;
    if (tt < TC) { mr = 16; return p.in[I_CTX] + ((size_t)b * TC + tt) * D; }
    mr = b; return p.in[I_X] + ((size_t)b * T + (tt - TC)) * D;
}
__device__ __forceinline__ void phase1(const Params& p, int wave, int lane) {
    const int gw = blockIdx.x * NWAVES + wave, NGW = gridDim.x * NWAVES;
    const float* MOD = (const float*)(p.ws + WS_MOD); bf16_t* U = (bf16_t*)(p.ws + WS_U);
    f32x4 v[4], nx[4]; int mr = 0, mrn = 0;
    if (gw < NROW) { const float* src = p1_src(p, gw, mr);
#pragma unroll
        for (int j = 0; j < 4; ++j) v[j] = ld_nt((const f32x4*)src + lane + 64 * j); }
    for (int R = gw; R < NROW; R += NGW) {
        const int Rn = R + NGW;
        if (Rn < NROW) { const float* src = p1_src(p, Rn, mrn);
#pragma unroll
            for (int j = 0; j < 4; ++j) nx[j] = ld_nt((const f32x4*)src + lane + 64 * j); }
        const float* sh = MOD + (size_t)mr * 6144; const float* sc = sh + 1024;
        float s = 0.f;
#pragma unroll
        for (int j = 0; j < 4; ++j) s += (v[j].x + v[j].y) + (v[j].z + v[j].w);
        const float mean = wave_sum(s) * (1.f / D); float s2 = 0.f;
#pragma unroll
        for (int j = 0; j < 4; ++j) { v[j] = v[j] - mean; s2 += (v[j].x * v[j].x + v[j].y * v[j].y) + (v[j].z * v[j].z + v[j].w * v[j].w); }
        const float rstd = 1.f / sqrtf(wave_sum(s2) * (1.f / D) + LN_EPS);
        u32x2* o8 = (u32x2*)(U + (size_t)R * D);
#pragma unroll
        for (int j = 0; j < 4; ++j) { const int col = 4 * lane + 256 * j; const f32x4 a = *(const f32x4*)(sh + col), m = *(const f32x4*)(sc + col);
            const f32x4 y = v[j] * rstd * (m + 1.f) + a; o8[lane + 64 * j] = (u32x2){pk2(y.x, y.y), pk2(y.z, y.w)}; }
#pragma unroll
        for (int j = 0; j < 4; ++j) v[j] = nx[j];
        mr = mrn;
    }
}

struct Unit { int pm, pn; int aofs = 0, ovl = 0, rend = 0; };
struct Gemm { const bf16_t* A; const bf16_t* Bt; int M, N, K; };
template <class Epi, class Sched>
__device__ __forceinline__ void gemm_simple(const Gemm g, const Sched& S, const Epi& E) {
    const int tid = threadIdx.x, wid = __builtin_amdgcn_readfirstlane(tid >> 6), lane = tid & 63, wr = wid >> 2, wc = wid & 3, fr = lane & 15, fq = lane >> 4;
    const int K = g.K;
    Unit u;
    for (int it = 0; S.next(it, u); ++it) {
        f32x4 acc[2][2][4][2];
#pragma unroll
        for (int a = 0; a < 2; ++a)
#pragma unroll
            for (int b = 0; b < 2; ++b)
#pragma unroll
                for (int m = 0; m < 4; ++m)
#pragma unroll
                    for (int n = 0; n < 2; ++n) acc[a][b][m][n] = (f32x4){0.f, 0.f, 0.f, 0.f};
        const bf16_t* Ab = g.A + ((size_t)u.pm * 256 + wr * 64 + fr) * K + 8 * fq;
        const bf16_t* Bb = g.Bt + ((size_t)u.pn * 256 + wc * 32 + fr) * K + 8 * fq;
        for (int k0 = 0; k0 < K; k0 += 32) {
            bf16x8 At[2][4], Bf[2][2];
#pragma unroll
            for (int a = 0; a < 2; ++a)
#pragma unroll
                for (int m = 0; m < 4; ++m) At[a][m] = *(const bf16x8*)(Ab + (size_t)(a * 128 + m * 16) * K + k0);
#pragma unroll
            for (int b = 0; b < 2; ++b)
#pragma unroll
                for (int n = 0; n < 2; ++n) Bf[b][n] = *(const bf16x8*)(Bb + (size_t)(b * 128 + n * 16) * K + k0);
#pragma unroll
            for (int a = 0; a < 2; ++a)
#pragma unroll
                for (int b = 0; b < 2; ++b)
#pragma unroll
                    for (int m = 0; m < 4; ++m)
#pragma unroll
                        for (int n = 0; n < 2; ++n) acc[a][b][m][n] = MFMA16(Bf[b][n], At[a][m], acc[a][b][m][n]);
        }
        E(acc, u, wr, wc, fr, fq);
    }
}


namespace pg8 {
#define PG8_LAS LAS
constexpr int BM = 256, BK = 64, HALF = 128, HTB = HALF * BK * 2  , STAGE_BYTES = 8 * HTB, NXCD = 8, WGM = 8;

__host__ __device__ __forceinline__ int lds_byte(int r, int c) { const int st = (r >> 4) * 2 + (c >> 5), rr = r & 15, cc = c & 31, ob = rr * 64 + cc * 2; return st * 1024 + (ob ^ (((ob >> 9) & 1) << 5)); }
__host__ __device__ __forceinline__ void stage_rc(int b, int& R, int& C) { const int st = b / 1024, sb = b % 1024, swz = sb ^ (((sb >> 9) & 1) << 5); R = (st >> 1) * 16 + swz / 64; C = (st & 1) * 32 + (swz % 64) / 2; }
__host__ __device__ __forceinline__ int perm32(int rho) { const int n = rho >> 4, i = rho & 15; return 8 * (i >> 2) + 4 * n + (i & 3); }
template <class Epi, class Sched, bool ALIGN_EPI = false, bool SP2 = false>
__device__ __forceinline__ void gemm_phase(PG8_LAS unsigned char* lds, const Gemm g, const Sched& S, const Epi& E) {
    const int tid = threadIdx.x, wid = __builtin_amdgcn_readfirstlane(tid >> 6), lane = tid & 63, wr = wid >> 2, wc = wid & 3, fr = lane & 15, fq = lane >> 4;
    const int K = g.K, nt = K / BK;
    unsigned voffA[2], voffB[2];
#pragma unroll
    for (int i = 0; i < 2; ++i) { int R, C; stage_rc(tid * 16 + i * 8192, R, C); const int Rb = Epi::PERM ? ((R & ~31) + perm32(R & 31)) : R;
        voffA[i] = (unsigned)(R * K + C) * 2u; voffB[i] = (unsigned)(Rb * K + C) * 2u; }
    const size_t kstep = (size_t)(BK * 2);
    const size_t hstep = (size_t)HALF * K * 2;
    const size_t tstep = 2 * hstep;
    const unsigned ldsw = (unsigned)wid * 1024u;
    const int aoff = lds_byte(wr * 64 + fr, fq * 8), boff = lds_byte(wc * 32 + fr, fq * 8);
#define PG8_SA(b, h) (((b) * 2 + (h)) * HTB)
#define PG8_SB(b, h) ((4 + (b) * 2 + (h)) * HTB)
#define PG8_STAGE(bufoff, gbase, voff) do { _Pragma("unroll") for (int _i = 0; _i < 2; ++_i) \
        __builtin_amdgcn_global_load_lds((const unsigned*)((const char*)(gbase) + (voff)[_i]), (PG8_LAS unsigned*)(lds + (bufoff) + ldsw + _i * 8192), 16, 0, 0); } while (0)
#define PG8_LDA(dst, b, h) do { _Pragma("unroll") for (int m = 0; m < 4; ++m) _Pragma("unroll") for (int k = 0; k < 2; ++k) dst[m][k] = *(const PG8_LAS bf16x8*)(lds + PG8_SA(b, h) + aoff + m * 2048 + k * 1024); } while (0)
#define PG8_LDB(dst, b, h) do { _Pragma("unroll") for (int n = 0; n < 2; ++n) _Pragma("unroll") for (int k = 0; k < 2; ++k) dst[n][k] = *(const PG8_LAS bf16x8*)(lds + PG8_SB(b, h) + boff + n * 2048 + k * 1024); } while (0)
#define PG8_MMA(ai, bj, At, Bt) do { __builtin_amdgcn_s_setprio(1); _Pragma("unroll") for (int m = 0; m < 4; ++m) _Pragma("unroll") for (int n = 0; n < 2; ++n) _Pragma("unroll") for (int k = 0; k < 2; ++k) \
        acc[ai][bj][m][n] = __builtin_amdgcn_mfma_f32_16x16x32_bf16(Bt[n][k], At[m][k], acc[ai][bj][m][n], 0, 0, 0); __builtin_amdgcn_s_setprio(0); } while (0)
#define PG8_WAIT_V(n) asm volatile("s_waitcnt vmcnt(" #n ")" ::: "memory")
#define PG8_WAIT_L(n) asm volatile("s_waitcnt lgkmcnt(" #n ")" ::: "memory")
#define PG8_BAR __builtin_amdgcn_s_barrier()
#define PG8_SCHED __builtin_amdgcn_sched_barrier(0)
    Unit cur, nxt; int ui = 0;
    if (!S.next(0, cur)) return;
    f32x4 acc[2][2][4][2];
#pragma unroll
    for (int a = 0; a < 2; ++a)
#pragma unroll
        for (int b = 0; b < 2; ++b)
#pragma unroll
            for (int m = 0; m < 4; ++m)
#pragma unroll
                for (int n = 0; n < 2; ++n) acc[a][b][m][n] = (f32x4){0.f, 0.f, 0.f, 0.f};
    bf16x8 At[4][2], B0[2][2], B1[2][2];
    const char* cA = (const char*)g.A + (ptrdiff_t)cur.pm * (ptrdiff_t)tstep + (ptrdiff_t)cur.aofs * (ptrdiff_t)(g.K * 2); const char* cB = (const char*)g.Bt + (size_t)cur.pn * tstep;
    S.a_ready(cur);
    if constexpr (SP2) {
        PG8_STAGE(PG8_SB(0, 0), cB, voffB); PG8_STAGE(PG8_SB(0, 1), cB + hstep, voffB); PG8_STAGE(PG8_SA(0, 0), cA, voffA); PG8_STAGE(PG8_SA(0, 1), cA + hstep, voffA);
        if (wr == 1) PG8_BAR;
        PG8_WAIT_V(2); PG8_BAR;
        PG8_STAGE(PG8_SB(1, 0), cB + kstep, voffB); PG8_STAGE(PG8_SA(1, 0), cA + kstep, voffA); PG8_STAGE(PG8_SB(1, 1), cB + hstep + kstep, voffB);
        PG8_WAIT_V(6); PG8_BAR;
    } else {
        PG8_STAGE(PG8_SB(0, 0), cB, voffB); PG8_STAGE(PG8_SA(0, 0), cA, voffA); PG8_STAGE(PG8_SB(0, 1), cB + hstep, voffB); PG8_STAGE(PG8_SA(0, 1), cA + hstep, voffA);
        if (wr == 1) PG8_BAR;
        PG8_WAIT_V(4); PG8_BAR;
        PG8_STAGE(PG8_SB(1, 0), cB + kstep, voffB); PG8_STAGE(PG8_SA(1, 0), cA + kstep, voffA); PG8_STAGE(PG8_SB(1, 1), cB + hstep + kstep, voffB);
        PG8_WAIT_V(6); PG8_BAR;
    }
    for (;;) {
        const bool has_next = S.next(ui + 1, nxt);
        const char* nA = has_next ? (const char*)g.A + (ptrdiff_t)nxt.pm * (ptrdiff_t)tstep + (ptrdiff_t)nxt.aofs * (ptrdiff_t)(g.K * 2) : cA; const char* nB = has_next ? (const char*)g.Bt + (size_t)nxt.pn * tstep : cB;
        for (int t = 0; t < nt; t += 2) {
            const bool last = (t == nt - 2);
            const char* a1 = cA + (size_t)(t + 1) * kstep;
            const char* a2 = last ? nA : cA + (size_t)(t + 2) * kstep; const char* b2 = last ? nB : cB + (size_t)(t + 2) * kstep;
            const char* a3 = a2 + kstep; const char* b3 = b2 + kstep;
            if (last && has_next) S.a_ready(nxt);
            if constexpr (SP2) {
            PG8_LDB(B0, 0, 0); PG8_LDB(B1, 0, 1); PG8_SCHED; PG8_LDA(At, 0, 0); PG8_STAGE(PG8_SA(1, 1), a1 + hstep, voffA);
            PG8_WAIT_V(8); PG8_WAIT_L(0); PG8_BAR; PG8_MMA(0, 0, At, B0); PG8_MMA(0, 1, At, B1); PG8_BAR; PG8_SCHED;
            PG8_LDA(At, 0, 1); PG8_STAGE(PG8_SB(0, 0), b2, voffB); PG8_STAGE(PG8_SB(0, 1), b2 + hstep, voffB); PG8_STAGE(PG8_SA(0, 0), a2, voffA);
            PG8_WAIT_V(8); PG8_WAIT_L(0); PG8_BAR; PG8_MMA(1, 0, At, B0); PG8_MMA(1, 1, At, B1); PG8_BAR; PG8_SCHED;
            PG8_LDB(B0, 1, 0); PG8_LDB(B1, 1, 1); PG8_SCHED; PG8_LDA(At, 1, 0); PG8_STAGE(PG8_SA(0, 1), a2 + hstep, voffA);
            PG8_WAIT_V(8); PG8_WAIT_L(0); PG8_BAR; PG8_MMA(0, 0, At, B0); PG8_MMA(0, 1, At, B1); PG8_BAR; PG8_SCHED;
            PG8_LDA(At, 1, 1); PG8_STAGE(PG8_SB(1, 0), b3, voffB); PG8_STAGE(PG8_SB(1, 1), b3 + hstep, voffB); PG8_STAGE(PG8_SA(1, 0), a3, voffA);
            PG8_WAIT_V(8); PG8_WAIT_L(0); PG8_BAR; PG8_MMA(1, 0, At, B0); PG8_MMA(1, 1, At, B1); PG8_BAR; PG8_SCHED;
            } else {
            PG8_LDB(B0, 0, 0); PG8_SCHED; PG8_LDA(At, 0, 0); PG8_STAGE(PG8_SA(1, 1), a1 + hstep, voffA);
            PG8_WAIT_L(8); PG8_BAR; PG8_WAIT_L(0); PG8_MMA(0, 0, At, B0); PG8_BAR; PG8_SCHED;
            PG8_LDB(B1, 0, 1); PG8_STAGE(PG8_SB(0, 0), b2, voffB);
            PG8_BAR; PG8_WAIT_L(0); PG8_MMA(0, 1, At, B1); PG8_BAR;
            PG8_LDA(At, 0, 1); PG8_STAGE(PG8_SA(0, 0), a2, voffA);
            PG8_BAR; PG8_WAIT_L(0); PG8_MMA(1, 0, At, B0); PG8_BAR; PG8_SCHED;
            PG8_STAGE(PG8_SB(0, 1), b2 + hstep, voffB);
            PG8_WAIT_V(6); PG8_BAR; PG8_MMA(1, 1, At, B1); PG8_BAR;
            PG8_LDB(B0, 1, 0); PG8_SCHED; PG8_LDA(At, 1, 0); PG8_STAGE(PG8_SA(0, 1), a2 + hstep, voffA);
            PG8_WAIT_L(8); PG8_BAR; PG8_WAIT_L(0); PG8_MMA(0, 0, At, B0); PG8_BAR; PG8_SCHED;
            PG8_LDB(B1, 1, 1); PG8_STAGE(PG8_SB(1, 0), b3, voffB);
            PG8_BAR; PG8_WAIT_L(0); PG8_MMA(0, 1, At, B1); PG8_BAR;
            PG8_LDA(At, 1, 1); PG8_STAGE(PG8_SA(1, 0), a3, voffA);
            PG8_BAR; PG8_WAIT_L(0); PG8_MMA(1, 0, At, B0); PG8_BAR; PG8_SCHED;
            PG8_STAGE(PG8_SB(1, 1), b3 + hstep, voffB);
            PG8_WAIT_V(6); PG8_BAR; PG8_MMA(1, 1, At, B1); PG8_BAR;
            }
        }
        if constexpr (ALIGN_EPI) { if (wr == 0) PG8_BAR; }
        if constexpr (!Epi::AFTER_DRAIN) { E(acc, cur, wr, wc, fr, fq); S.done(cur); }
        if (!has_next) break;
#pragma unroll
        for (int a = 0; a < 2; ++a)
#pragma unroll
            for (int b = 0; b < 2; ++b)
#pragma unroll
                for (int m = 0; m < 4; ++m)
#pragma unroll
                    for (int n = 0; n < 2; ++n) acc[a][b][m][n] = (f32x4){0.f, 0.f, 0.f, 0.f};
        cur = nxt; cA = nA; cB = nB; ++ui;
        if constexpr (ALIGN_EPI) { if (wr == 1) PG8_BAR; }
    }
    PG8_WAIT_V(0);
    if constexpr (!ALIGN_EPI) { if (wr == 0) PG8_BAR; }
    PG8_BAR;
    if constexpr (Epi::AFTER_DRAIN) { E.fused(acc, cur, wr, wc, fr, fq, lds, wid, lane); S.done(cur); }
#undef PG8_SA
#undef PG8_SB
#undef PG8_STAGE
#undef PG8_LDA
#undef PG8_LDB
#undef PG8_MMA
#undef PG8_WAIT_V
#undef PG8_WAIT_L
#undef PG8_BAR
#undef PG8_SCHED
}
}

template <int PH> struct SchedProj {
    int G, c, rep;
    __device__ __forceinline__ void a_ready(const Unit&) const {}
    __device__ __forceinline__ void done(const Unit&) const {}
    static __device__ __forceinline__ int nlat() { return PH == 0 ? 13 : 16; }
    static __device__ __forceinline__ int nctx() { return PH == 0 ? 8 : 0; }
    __device__ __forceinline__ bool next(int i, Unit& u) const {
        const int x = c & 7, y = c >> 3, nxc = G >> 3;
        int q = i * nxc + y;
        u.aofs = 0; u.ovl = 0; u.rend = 0;
        if (PH == 1) {
            const int nk = (x < 2) ? 19 : 18;
            const int ntot = 64 + 10 + 72 + 4 * nk;
            if (q >= rep * ntot) return false;
            q %= ntot;
            if (q < 64) { const int grp = q >> 4, rem = q & 15, idx = rem >> 2, pmi = x + 8 * (grp * 4 + (rem & 3)); u.pm = (pmi >> 3) * 9 + 1 + (pmi & 7); u.pn = 24 + idx; return true; }
            q -= 64;
            if (q < 10) { const int bsel = q / 5, idx = q - bsel * 5; u.pm = (x + 8 * bsel) * 9; u.pn = (idx < 4) ? 24 + idx : 40; return true; }
            q -= 10;
            if (q < 72) { const int k = (q >> 3) * 2 + (q & 1), pi = (q & 7) >> 1, tau = x + 8 * k, b = tau / 9, j = tau - b * 9;
                u.pm = 0; u.pn = 16 + pi; u.ovl = 1; u.aofs = b * TT + TC + 254 * j - 1; u.rend = (b + 1) * TT; return true; }
            q -= 72;
            { int k, pi; if (q < 72) { k = (q >> 3) * 2 + (q & 1); pi = (q & 7) >> 1; } else { k = 18; pi = q - 72; }
                u.pm = 0; u.pn = 20 + pi; u.ovl = 1; u.aofs = 254 * (x + 8 * k) - 1; u.rend = NROW; return true; }
        }
        const int nl = 16 * nlat(), ntot = nl + 2 * nctx();
        if (q >= rep * ntot) return false;
        q %= ntot;
        int idx;
        if (q < nl) { const int grp = q / (4 * nlat()), rem = q - grp * 4 * nlat(); idx = rem >> 2; const int pmi = x + 8 * (grp * 4 + (rem & 3)); u.pm = (pmi >> 3) * 9 + 1 + (pmi & 7);
            if (PH == 0) u.pn = (idx < 12) ? idx : 40; else u.pn = (idx < 4) ? 12 + idx : 24 + idx;
            return true; }
        q -= nl; const int bsel = q / (nctx() > 0 ? nctx() : 1); idx = q - bsel * nctx(); u.pm = (x + 8 * bsel) * 9;
        u.pn = 4 + idx;
        return true;
    }
};
struct EpiProj {
    static constexpr bool PERM = true, AFTER_DRAIN = false;
    unsigned char* ws; const float* b_mgate; LAS unsigned char* lds; const float* cw; const float* cb; int pn_lds = -1;
    template <int CTRL> static __device__ __forceinline__ float dpp_f(float v) { return __builtin_bit_cast(float, __builtin_amdgcn_update_dpp(0, __builtin_bit_cast(int, v), CTRL, 0xF, 0xF, true)); }
    __device__ __forceinline__ void operator()(const f32x4 (&acc)[2][2][4][2], const Unit& u, int wr, int wc, int fr, int fq) const {
        const int pn = u.pn;
        if (u.ovl) {
            const int blk = pn >> 2, h = pn & 3; int cw0 = wc * 32 + 8 * fq;
            asm volatile("" : "+v"(cw0));
            LAS float* XB = (LAS float*)(lds + 131072);
#pragma unroll
            for (int ai = 0; ai < 2; ++ai) { const int gm = 2 * ai + wr;
                if (fr == 0) {
#pragma unroll
                    for (int bj = 0; bj < 2; ++bj) { LAS f32x4* d = (LAS f32x4*)(XB + (gm * 2 + 0) * 256 + bj * 128 + cw0); d[0] = acc[ai][bj][0][0]; d[1] = acc[ai][bj][0][1]; } }
                if (fr == 15) {
#pragma unroll
                    for (int bj = 0; bj < 2; ++bj) { LAS f32x4* d = (LAS f32x4*)(XB + (gm * 2 + 1) * 256 + bj * 128 + cw0); d[0] = acc[ai][bj][3][0]; d[1] = acc[ai][bj][3][1]; } } }
            asm volatile("s_waitcnt lgkmcnt(0)\n\ts_barrier" ::: "memory");
            bf16_t* dst = (bf16_t*)(ws + (blk == 4 ? WS_MQ : WS_MK));
            const float scl = (blk == 5) ? 0.0625f : 1.f, nl2e = (blk == 5) ? -16.f * 1.4426950408889634f : -1.4426950408889634f;
#pragma unroll
            for (int bj = 0; bj < 2; ++bj) {
                const int cg = (blk - 4) * 1024 + h * 256 + bj * 128 + cw0;
                f32x4 w0[2], w1[2], w2[2], bs[2];
                if ((pn & 3) == pn_lds) {
                    LAS const float* WL = (LAS const float*)(lds + 139264) + (blk - 4) * 1024 + bj * 128 + cw0;
#pragma unroll
                    for (int n = 0; n < 2; ++n) { w0[n] = *(LAS const f32x4*)(WL + 4 * n); w1[n] = *(LAS const f32x4*)(WL + 256 + 4 * n); w2[n] = *(LAS const f32x4*)(WL + 512 + 4 * n); bs[n] = *(LAS const f32x4*)(WL + 768 + 4 * n); }
                } else {
#pragma unroll
                    for (int n = 0; n < 2; ++n) { w0[n] = *(const f32x4*)(cw + cg + 4 * n) * scl; w1[n] = *(const f32x4*)(cw + 2048 + cg + 4 * n) * scl; w2[n] = *(const f32x4*)(cw + 4096 + cg + 4 * n) * scl; bs[n] = *(const f32x4*)(cb + cg + 4 * n) * scl; }
                }
#pragma unroll
                for (int ai = 0; ai < 2; ++ai) { const int gm = 2 * ai + wr;
#pragma unroll
                    for (int m = 0; m < 4; ++m) {
                        __builtin_amdgcn_sched_barrier(0);
                        const int rho = 128 * ai + 64 * wr + 16 * m + fr, row = u.aofs + rho, tt = row - (row / TT) * TT;
                        const bool zp = (tt == 0) || (tt == TC), zn = (tt == TC - 1) || (tt == TT - 1);
                        f32x4 hx[2];
                        if (m == 0) { hx[0] = *(LAS const f32x4*)(XB + ((gm > 0 ? gm - 1 : 0) * 2 + 1) * 256 + bj * 128 + cw0); hx[1] = *(LAS const f32x4*)(XB + ((gm > 0 ? gm - 1 : 0) * 2 + 1) * 256 + bj * 128 + cw0 + 4); }
                        if (m == 3) { hx[0] = *(LAS const f32x4*)(XB + ((gm < 3 ? gm + 1 : 3) * 2 + 0) * 256 + bj * 128 + cw0); hx[1] = *(LAS const f32x4*)(XB + ((gm < 3 ? gm + 1 : 3) * 2 + 0) * 256 + bj * 128 + cw0 + 4); }
                        unsigned pk[4];
#pragma unroll
                        for (int kp = 0; kp < 4; ++kp) { const int n = kp >> 1, j0 = (2 * kp) & 3;
                            f32x2 cur, pv, nv;
#pragma unroll
                            for (int jj = 0; jj < 2; ++jj) { const int j = j0 + jj;
                                const float cu = acc[ai][bj][m][n][j];
                                float xs = (fr == 15) ? (m == 0 ? hx[n][j] : acc[ai][bj][m > 0 ? m - 1 : 0][n][j]) : cu;
                                float ys = (fr == 0) ? (m == 3 ? hx[n][j] : acc[ai][bj][m < 3 ? m + 1 : 3][n][j]) : cu;
                                cur[jj] = cu; pv[jj] = zp ? 0.f : dpp_f<0x121>(xs); nv[jj] = zn ? 0.f : dpp_f<0x12F>(ys); }
                            const f32x2 a0 = {w0[n][j0], w0[n][j0 + 1]}, a1 = {w1[n][j0], w1[n][j0 + 1]}, a2 = {w2[n][j0], w2[n][j0 + 1]}, ab = {bs[n][j0], bs[n][j0 + 1]};
                            f32x2 z = __builtin_elementwise_fma(a1, cur, ab);
                            z = __builtin_elementwise_fma(a0, pv, z);
                            z = __builtin_elementwise_fma(a2, nv, z);
                            const f32x2 ez = z * nl2e;
                            f32x2 den = {__builtin_amdgcn_exp2f(ez[0]), __builtin_amdgcn_exp2f(ez[1])};
                            den = den + 1.f;
                            const f32x2 rc = {__builtin_amdgcn_rcpf(den[0]), __builtin_amdgcn_rcpf(den[1])};
                            const f32x2 o = z * rc;
                            pk[kp] = pk2(o[0], o[1]);
                        }
                        if (rho >= 1 && rho <= 254 && row < u.rend) *(u32x4*)(dst + (size_t)row * D + h * 256 + bj * 128 + cw0) = (u32x4){pk[0], pk[1], pk[2], pk[3]};
                    }
                }
            }
            return;
        }
        if (pn == 40) {
            if (wc != 0 || fq >= 2) return;
            float* Gt = (float*)(ws + WS_G);
#pragma unroll
            for (int ai = 0; ai < 2; ++ai)
#pragma unroll
                for (int m = 0; m < 4; ++m) { const int r = u.pm * 256 + ai * 128 + wr * 64 + m * 16 + fr, b = r / TT, tt = r - b * TT;
#pragma unroll
                    for (int k = 0; k < 8; ++k) { const int c = 8 * fq + k; float v = acc[ai][0][m][k >> 2][k & 3] + b_mgate[c]; if ((c >> 2) & 1) v = logsigmoid_f(v);
                        Gt[((size_t)b * 16 + c) * TT + tt] = v; } }
            return;
        }
        const int blk = pn >> 2, h = pn & 3;
        if (blk < 2) {
            bf16_t* dst = (bf16_t*)(ws + (blk == 0 ? WS_RQ : WS_RK));
            const float* ROT = (const float*)(ws + WS_ROT);
            const float scl = (blk == 1) ? 0.0625f : 1.f;
            const int q = wc * 32 + 8 * fq, hb = q >> 6, i0 = q & 63;
#pragma unroll
            for (int ai = 0; ai < 2; ++ai)
#pragma unroll
                for (int m = 0; m < 4; ++m) { const int r = u.pm * 256 + ai * 128 + wr * 64 + m * 16 + fr, b = r / TT, tt = r - b * TT; const bool lat = tt >= TC; const int t = tt - TC;
                    float o1[8], o2[8];
                    if (lat) { const int pos = hb ? (t & 63) : (t >> 6); const f32x4* rp = (const f32x4*)(ROT + (size_t)(pos * 64 + i0) * 2);
#pragma unroll
                        for (int k2 = 0; k2 < 4; ++k2) { const f32x4 cs = rp[k2];
                            const float a0 = acc[ai][0][m][k2 >> 1][(2 * k2) & 3], a1 = acc[ai][0][m][k2 >> 1][(2 * k2 + 1) & 3], b0 = acc[ai][1][m][k2 >> 1][(2 * k2) & 3], b1 = acc[ai][1][m][k2 >> 1][(2 * k2 + 1) & 3];
                            o1[2 * k2] = a0 * cs[0] - b0 * cs[1]; o2[2 * k2] = a0 * cs[1] + b0 * cs[0]; o1[2 * k2 + 1] = a1 * cs[2] - b1 * cs[3]; o2[2 * k2 + 1] = a1 * cs[3] + b1 * cs[2]; } }
                    else {
#pragma unroll
                        for (int k = 0; k < 8; ++k) { o1[k] = acc[ai][0][m][k >> 2][k & 3]; o2[k] = acc[ai][1][m][k >> 2][k & 3]; } }
                    bf16_t* rowp = dst + (size_t)r * D + h * 256 + q;
                    *(u32x4*)(rowp) = (u32x4){pk2(o1[0] * scl, o1[1] * scl), pk2(o1[2] * scl, o1[3] * scl), pk2(o1[4] * scl, o1[5] * scl), pk2(o1[6] * scl, o1[7] * scl)};
                    *(u32x4*)(rowp + 128) = (u32x4){pk2(o2[0] * scl, o2[1] * scl), pk2(o2[2] * scl, o2[3] * scl), pk2(o2[4] * scl, o2[5] * scl), pk2(o2[6] * scl, o2[7] * scl)}; }
            return;
        }
        if (blk == 2 || blk == 6) {
            bf16_t* dst = (bf16_t*)(ws + (blk == 2 ? WS_RVT : WS_MVT));
#pragma unroll
            for (int ai = 0; ai < 2; ++ai)
#pragma unroll
                for (int m = 0; m < 4; ++m) { const int r = u.pm * 256 + ai * 128 + wr * 64 + m * 16 + fr, b = r / TT, tt = r - b * TT;
                    bf16_t* bp = dst + ((size_t)(b * 4 + h) * 256) * TT + tt;
#pragma unroll
                    for (int bj = 0; bj < 2; ++bj)
#pragma unroll
                        for (int k = 0; k < 8; ++k) { const int e = bj * 128 + wc * 32 + 8 * fq + k; bp[(size_t)e * TT] = f2bf(acc[ai][bj][m][k >> 2][k & 3]); } }
            return;
        }
        if (blk == 4 || blk == 5) {
            bf16_t* dst = (bf16_t*)(ws + (blk == 4 ? WS_MQRAW : WS_MKRAW));
#pragma unroll
            for (int ai = 0; ai < 2; ++ai)
#pragma unroll
                for (int m = 0; m < 4; ++m) { const int r = u.pm * 256 + ai * 128 + wr * 64 + m * 16 + fr;
#pragma unroll
                    for (int bj = 0; bj < 2; ++bj) { const f32x4 v0 = acc[ai][bj][m][0], v1 = acc[ai][bj][m][1]; const int c = h * 256 + bj * 128 + wc * 32 + 8 * fq;
                        *(u32x4*)(dst + (size_t)r * D + c) = (u32x4){pk2(v0[0], v0[1]), pk2(v0[2], v0[3]), pk2(v1[0], v1[1]), pk2(v1[2], v1[3])}; } }
            return;
        }
        {
            bf16_t* dst = (bf16_t*)(ws + (blk == 3 ? WS_RGA : (blk == 7 ? WS_MOA : (blk == 8 ? WS_GRA : WS_GMA))));
#pragma unroll
            for (int ai = 0; ai < 2; ++ai)
#pragma unroll
                for (int m = 0; m < 4; ++m) { const int r = u.pm * 256 + ai * 128 + wr * 64 + m * 16 + fr, b = r / TT, tt = r - b * TT; const int rl = b * T + (tt - TC);
#pragma unroll
                    for (int bj = 0; bj < 2; ++bj) { f32x4 v0 = acc[ai][bj][m][0], v1 = acc[ai][bj][m][1]; const int c = h * 256 + bj * 128 + wc * 32 + 8 * fq;
                        if (blk >= 8) { _Pragma("unroll") for (int j = 0; j < 4; ++j) { v0[j] = sigmoid_f(v0[j]); v1[j] = sigmoid_f(v1[j]); } }
                        if (tt >= TC) *(u32x4*)(dst + (size_t)rl * D + c) = (u32x4){pk2(v0[0], v0[1]), pk2(v0[2], v0[3]), pk2(v1[0], v1[1]), pk2(v1[2], v1[3])}; } }
        }
    }
};

__device__ __forceinline__ void phase_conv(const Params& p, int tid) {
    const bf16_t* QR = (const bf16_t*)(p.ws + WS_MQRAW); const bf16_t* KR = (const bf16_t*)(p.ws + WS_MKRAW);
    bf16_t* QO = (bf16_t*)(p.ws + WS_MQ); bf16_t* KO = (bf16_t*)(p.ws + WS_MK);
    const float* cw = p.in[I_CONVW]; const float* cb = p.in[I_CONVB];
    const int gt = blockIdx.x * NTHREADS + tid, nthr = gridDim.x * NTHREADS, ch = gt & 127;
    constexpr int NGRP = NROW / 8;
#pragma unroll 1
    for (int which = 0; which < 2; ++which) {
        const int c0 = which * 1024 + ch * 8; const float scl = which ? 0.0625f : 1.f;
        float w0[8], w1[8], w2[8], bs[8];
#pragma unroll
        for (int j = 0; j < 8; ++j) { w0[j] = cw[c0 + j]; w1[j] = cw[2048 + c0 + j]; w2[j] = cw[4096 + c0 + j]; bs[j] = cb[c0 + j]; }
        const bf16_t* srcb = (which ? KR : QR) + ch * 8; bf16_t* dstb = (which ? KO : QO) + ch * 8;
        for (int g = gt >> 7; g < NGRP; g += nthr >> 7) {
            const int R0 = g * 8, tt = R0 % TT;
            if (which == 0 && tt < TC) continue;
            const bool hasp = !(tt == 0 || tt == TC), hasn = !(tt + 7 == TC - 1 || tt + 7 == TT - 1);
            u32x4 rw[10];
            rw[0] = hasp ? ld_nt((const u32x4*)(srcb + (size_t)(R0 - 1) * D)) : (u32x4){0u, 0u, 0u, 0u};
#pragma unroll
            for (int i = 0; i < 8; ++i) rw[1 + i] = ld_nt((const u32x4*)(srcb + (size_t)(R0 + i) * D));
            rw[9] = hasn ? ld_nt((const u32x4*)(srcb + (size_t)(R0 + 8) * D)) : (u32x4){0u, 0u, 0u, 0u};
#pragma unroll
            for (int i = 0; i < 8; ++i) {
                float o[8];
#pragma unroll
                for (int j = 0; j < 4; ++j) {
                    const float a = w0[2 * j] * bflo(rw[i][j]) + w1[2 * j] * bflo(rw[i + 1][j]) + w2[2 * j] * bflo(rw[i + 2][j]) + bs[2 * j];
                    const float c = w0[2 * j + 1] * bfhi(rw[i][j]) + w1[2 * j + 1] * bfhi(rw[i + 1][j]) + w2[2 * j + 1] * bfhi(rw[i + 2][j]) + bs[2 * j + 1];
                    o[2 * j] = silu_f(a) * scl; o[2 * j + 1] = silu_f(c) * scl;
                }
                *(u32x4*)(dstb + (size_t)(R0 + i) * D) = (u32x4){pk2(o[0], o[1]), pk2(o[2], o[3]), pk2(o[4], o[5]), pk2(o[6], o[7])};
            }
        }
    }
}

struct ScanArgs { const bf16_t* Q; const bf16_t* K; const bf16_t* VT; const float* G; const float* decay; bf16_t* Of; bf16_t* Ob; int is_ml; };
constexpr int SC_S = 0;
constexpr int SC_ATT = 131072;
constexpr int ATT_LD = 72;
constexpr int SC_VEC = SC_ATT + 64 * ATT_LD * 2;
__device__ __forceinline__ void scan_phase(LAS unsigned char* lds, const ScanArgs a, int tid, int wave, int lane) {
    LAS float* Sm = (LAS float*)(lds + SC_S);
    LAS bf16_t* att = (LAS bf16_t*)(lds + SC_ATT);
    LAS float* vec = (LAS float*)(lds + SC_VEC);
    LAS float* rowv = vec, *colv = vec + 64, *aq = vec + 128, *kd = vec + 192, *emr = vec + 256, *cv = vec + 320, *av = vec + 384, *mxv = vec + 448, *qn = vec + 512, *denp = vec + 576, *nv = vec + 832, *scal = vec + 1088;
    const int fr = lane & 15, fq = lane >> 4;
    for (int item = blockIdx.x; item < 256; item += gridDim.x) {
        const int eh = item & 1, dir = (item >> 1) & 1, h = (item >> 2) & 3, b = item >> 4;
        __syncthreads();
        for (int i = tid; i < 256 * 128; i += NTHREADS) Sm[i] = 0.f;
        if (tid < 256) nv[tid] = 0.f;
        if (tid == 0) { scal[0] = 0.f;   scal[1] = 1.f;   }
        const float lg = a.is_ml ? 0.f : logsigmoid_f(a.decay[dir * 4 + h]);
        const float* Gi = a.G + ((size_t)b * 16 + (dir ? 8 : 0) + h) * TT;
        const float* Gf = a.G + ((size_t)b * 16 + (dir ? 12 : 4) + h) * TT;
        bf16_t* Oo = dir ? a.Ob : a.Of;
        __syncthreads();
        for (int st = 0; st < 36; ++st) {
            int tt0;
            if (st < 4) tt0 = (dir ? (3 - st) : st) * CH; else tt0 = TC + (dir ? (35 - st) : (st - 4)) * CH;
            const bool lat = st >= 4;
            const size_t R0 = (size_t)b * TT + tt0;
            if (a.is_ml) {
                if (tid == 0) {
                    const float mst = scal[0];
                    float run = 0.f;
                    if (dir == 0) { for (int l = 0; l < CH; ++l) { run += Gf[tt0 + l]; cv[l] = run; } }
                    else { for (int l = CH - 1; l >= 0; --l) { run += Gf[tt0 + l]; cv[l] = run; } }
                    const float ctot = run;
                    float mxr = -1e30f;
                    if (dir == 0) { for (int l = 0; l < CH; ++l) { const float x = Gi[tt0 + l] - cv[l]; av[l] = x; mxr = fmaxf(mxr, x); mxv[l] = mxr; } }
                    else { for (int l = CH - 1; l >= 0; --l) { mxv[l] = mxr; const float x = Gi[tt0 + l] - cv[l]; av[l] = x; mxr = fmaxf(mxr, x); } }
                    const float mnew = fmaxf(ctot + mst, ctot + mxr);
                    scal[1] = expf(ctot + mst - mnew); scal[2] = ctot; scal[3] = mnew; scal[4] = mst;
                }
                __syncthreads();
                if (tid < CH) { const int l = tid; const float mst = scal[4], ctot = scal[2], mnew = scal[3];
                    const float mrow = fmaxf(cv[l] + mxv[l], cv[l] + mst);
                    rowv[l] = cv[l] - mrow; colv[l] = av[l]; aq[l] = expf(cv[l] + mst - mrow); emr[l] = expf(-mrow); kd[l] = expf(ctot + av[l] - mnew); }
                if (tid == 0) scal[0] = scal[3];
            } else {
                if (tid < CH) { const int l = tid;
                    rowv[l] = (dir ? -(float)l : (float)l) * lg; colv[l] = (dir ? (float)l : -(float)l) * lg;
                    aq[l] = expf((float)(dir ? (CH - l) : (l + 1)) * lg); kd[l] = expf((float)(dir ? l : (CH - 1 - l)) * lg); emr[l] = 0.f; }
                if (tid == 0) scal[1] = expf((float)CH * lg);
            }
            __syncthreads();
            if (lat) {
#pragma unroll
                for (int tq = 0; tq < 2; ++tq) {
                    const int ti = wave * 2 + tq, lt = ti >> 2, mt = ti & 3, l0 = lt * 16, m0 = mt * 16;
                    f32x4 acc = (f32x4){0.f, 0.f, 0.f, 0.f};
                    const bf16_t* kp = a.K + (R0 + m0 + fr) * D + h * 256 + 8 * fq;
                    const bf16_t* qp = a.Q + (R0 + l0 + fr) * D + h * 256 + 8 * fq;
#pragma unroll
                    for (int d0 = 0; d0 < 256; d0 += 32) { const bf16x8 ka = *(const bf16x8*)(kp + d0), qb = *(const bf16x8*)(qp + d0); acc = MFMA16(ka, qb, acc); }
                    const int l = l0 + fr; const float rv = rowv[l]; float o[4]; float s = 0.f;
#pragma unroll
                    for (int r = 0; r < 4; ++r) { const int m = m0 + 4 * fq + r; const bool ok = dir ? (m > l) : (m <= l); const float w = ok ? __expf(rv + colv[m]) : 0.f; o[r] = acc[r] * w; s += o[r]; }
                    *(LAS u32x2*)(att + l * ATT_LD + m0 + 4 * fq) = (u32x2){pk2(o[0], o[1]), pk2(o[2], o[3])};
                    s += __shfl_xor(s, 16); s += __shfl_xor(s, 32);
                    if (fq == 0) denp[l * 4 + mt] = s;
                }
                if (a.is_ml && tid < CH) { const int l = tid; const bf16_t* qp = a.Q + (R0 + l) * D + h * 256; float s = 0.f;
                    for (int d = 0; d < 256; d += 8) { const u32x4 w = *(const u32x4*)(qp + d);
#pragma unroll
                        for (int j = 0; j < 4; ++j) s += bflo(w[j]) * nv[d + 2 * j] + bfhi(w[j]) * nv[d + 2 * j + 1]; }
                    qn[l] = s; }
            }
            __syncthreads();
            {
                const int ew = wave * 16; const float cdec = scal[1];
                const bf16_t* vp = a.VT + ((size_t)(b * 4 + h) * 256 + eh * 128 + ew + fr) * TT + tt0 + 8 * fq;
                const bf16x8 vf0 = *(const bf16x8*)(vp), vf1 = *(const bf16x8*)(vp + 32);
                if (lat) {
                    const int t0 = tt0 - TC;
#pragma unroll 1
                    for (int lt = 0; lt < 4; ++lt) {
                        f32x4 acc = (f32x4){0.f, 0.f, 0.f, 0.f};
                        const bf16_t* qp = a.Q + (R0 + lt * 16 + fr) * D + h * 256 + 8 * fq;
#pragma unroll
                        for (int d0 = 0; d0 < 256; d0 += 32) {
                            const bf16x8 qa = *(const bf16x8*)(qp + d0);
                            const LAS float* sp = Sm + (d0 + 8 * fq) * 128 + ew + fr;
                            u32x4 sb; sb.x = pk2(sp[0], sp[128]); sb.y = pk2(sp[256], sp[384]); sb.z = pk2(sp[512], sp[640]); sb.w = pk2(sp[768], sp[896]);
                            acc = MFMA16(qa, __builtin_bit_cast(bf16x8, sb), acc);
                        }
                        float hs[4];
#pragma unroll
                        for (int r = 0; r < 4; ++r) { const int l = lt * 16 + 4 * fq + r; acc[r] *= aq[l];
                            if (a.is_ml) { const float den = (denp[l * 4] + denp[l * 4 + 1]) + (denp[l * 4 + 2] + denp[l * 4 + 3]) + aq[l] * qn[l]; hs[r] = 1.f / fmaxf(fabsf(den), emr[l]); } else hs[r] = 1.f; }
                        const bf16x8 a0 = *(const LAS bf16x8*)(att + (lt * 16 + fr) * ATT_LD + 8 * fq), a1 = *(const LAS bf16x8*)(att + (lt * 16 + fr) * ATT_LD + 32 + 8 * fq);
                        acc = MFMA16(a0, vf0, acc); acc = MFMA16(a1, vf1, acc);
#pragma unroll
                        for (int r = 0; r < 4; ++r) { const int l = lt * 16 + 4 * fq + r; Oo[((size_t)b * T + t0 + l) * D + h * 256 + eh * 128 + ew + fr] = f2bf(acc[r] * hs[r]); }
                    }
                }
#pragma unroll 1
                for (int dt = 0; dt < 16; ++dt) {
                    const int d0 = dt * 16;
                    LAS float* sp = Sm + (d0 + 4 * fq) * 128 + ew + fr;
                    f32x4 acc; acc[0] = sp[0] * cdec; acc[1] = sp[128] * cdec; acc[2] = sp[256] * cdec; acc[3] = sp[384] * cdec;
#pragma unroll
                    for (int ks = 0; ks < 2; ++ks) {
                        const bf16_t* kp = a.K + (R0 + 32 * ks + 8 * fq) * D + h * 256 + d0 + fr;
                        float kk[8];
#pragma unroll
                        for (int j = 0; j < 8; ++j) kk[j] = bf2f(kp[(size_t)j * D]) * kd[32 * ks + 8 * fq + j];
                        u32x4 ka; ka.x = pk2(kk[0], kk[1]); ka.y = pk2(kk[2], kk[3]); ka.z = pk2(kk[4], kk[5]); ka.w = pk2(kk[6], kk[7]);
                        acc = MFMA16(__builtin_bit_cast(bf16x8, ka), ks ? vf1 : vf0, acc);
                    }
                    sp[0] = acc[0]; sp[128] = acc[1]; sp[256] = acc[2]; sp[384] = acc[3];
                }
                if (a.is_ml && tid < 256) { const int d = tid; const bf16_t* kp = a.K + R0 * D + h * 256 + d; float s = nv[d] * cdec;
                    for (int m = 0; m < CH; ++m) s += kd[m] * bf2f(kp[(size_t)m * D]);
                    nv[d] = s; }
            }
            __syncthreads();
        }
    }
}


typedef short v4i16_t __attribute__((ext_vector_type(4)));
__device__ __forceinline__ int swz_f(int row) { return ((row & 3) << 2) | ((row >> 2) & 3); }
__device__ __forceinline__ int img_chunk(int row, int half, int ch) { return half * 16384 + 256 * row + 16 * (ch ^ swz_f(row)); }
constexpr int S2_Q = 0, S2_K = 65536, S2_ATT = 131072, S2_VEC = S2_ATT + 64 * ATT_LD * 2;
__device__ __forceinline__ void scan_dma_tile(LAS unsigned char* dstbuf, const bf16_t* src, int wave, int lane) {
#pragma unroll
    for (int j = 0; j < 4; ++j) { const int ii = wave * 4 + j, half = ii >> 4, rg = ii & 15; const int row = 4 * rg + (lane >> 4), ch = (lane & 15) ^ swz_f(row);
        __builtin_amdgcn_global_load_lds((const unsigned*)(src + (size_t)row * D + half * 128 + 8 * ch), (LAS unsigned*)(dstbuf + half * 16384 + rg * 1024), 16, 0, 0); }
}
__device__ __forceinline__ float scan_incl_sum(float v, int lane) {
#pragma unroll
    for (int o = 1; o < 64; o <<= 1) { const float t = __shfl_up(v, o); if (lane >= o) v += t; }
    return v;
}
__device__ __forceinline__ float scan_incl_max(float v, int lane) {
#pragma unroll
    for (int o = 1; o < 64; o <<= 1) { const float t = __shfl_up(v, o); if (lane >= o) v = fmaxf(v, t); }
    return v;
}
__device__ __forceinline__ void scan_phase2(LAS unsigned char* lds, const ScanArgs a, int tid, int wave, int lane) {
    LAS bf16_t* att = (LAS bf16_t*)(lds + S2_ATT);
    LAS float* vec = (LAS float*)(lds + S2_VEC);
    LAS float* rowv = vec, *colv = vec + 64, *aq = vec + 128, *kd = vec + 192, *emr = vec + 256, *qn = vec + 320, *denp = vec + 384, *nv = vec + 640, *scal = vec + 896;
    const int fr = lane & 15, fq = lane >> 4;
    for (int item = blockIdx.x; item < 256; item += gridDim.x) {
        const int eh = item & 1, dir = (item >> 1) & 1, h = (item >> 2) & 3, b = item >> 4;
        const int ew = wave * 16;
        const int Ff = swz_f(fr), Fhp = Ff >> 2, Flp = Ff & 3;
        int X4[4];
#pragma unroll
        for (int c2 = 0; c2 < 4; ++c2) X4[c2] = 64 * (c2 ^ Fhp);
        const int LB1 = 256 * fr + 16 * (fq ^ Flp);
        const int LB2 = 256 * fr + 16 * ((fq >> 1) ^ Flp) + 8 * (fq & 1);
        const int LB3 = 256 * fr + 16 * (((fq >> 1) | 2) ^ Flp) + 8 * (fq & 1);
        const int q4 = (lane & 15) >> 2, p4 = lane & 3;
        const int TB0 = 256 * (8 * fq + q4) + 16 * (p4 >> 1) + 8 * (p4 & 1);
        const int TB1 = 256 * (8 * fq + q4 + 4) + 16 * ((p4 >> 1) ^ 1) + 8 * (p4 & 1);
        int W8[8];
#pragma unroll
        for (int i = 0; i < 8; ++i) W8[i] = 64 * ((i >> 1) ^ q4) + 32 * ((i & 1) ^ (fq & 1));
        __syncthreads();
        f32x4 S[16];
#pragma unroll
        for (int i = 0; i < 16; ++i) S[i] = (f32x4){0.f, 0.f, 0.f, 0.f};
        if (tid < 256) nv[tid] = 0.f;
        if (tid == 0) { scal[0] = 0.f; scal[1] = 1.f; }
        const float* Gi = a.G + ((size_t)b * 16 + (dir ? 8 : 0) + h) * TT;
        const float* Gf = a.G + ((size_t)b * 16 + (dir ? 12 : 4) + h) * TT;
        bf16_t* Oo = dir ? a.Ob : a.Of;
        const bf16_t* Qh = a.Q + (size_t)b * TT * D + h * 256;
        const bf16_t* Kh = a.K + (size_t)b * TT * D + h * 256;
        const bf16_t* Vw = a.VT + ((size_t)(b * 4 + h) * 256 + eh * 128 + ew + fr) * TT + 8 * fq;
        if (!a.is_ml) {
            const float lg = logsigmoid_f(a.decay[dir * 4 + h]);
            if (tid < CH) { const int l = tid;
                rowv[l] = (dir ? -(float)l : (float)l) * lg; colv[l] = (dir ? (float)l : -(float)l) * lg;
                aq[l] = expf((float)(dir ? (CH - l) : (l + 1)) * lg); kd[l] = expf((float)(dir ? l : (CH - 1 - l)) * lg); emr[l] = 0.f; }
            if (tid == 0) scal[1] = expf((float)CH * lg);
        }
        { const int tt0 = (dir ? 3 : 0) * CH; scan_dma_tile(lds + S2_K, Kh + (size_t)tt0 * D, wave, lane); }
        const int sidx = dir ? 63 - lane : lane;
        float gf_n = 0.f, gi_n = 0.f;
        if (a.is_ml && wave == 0) { const int tt0 = (dir ? 3 : 0) * CH; gf_n = Gf[tt0 + sidx]; gi_n = Gi[tt0 + sidx]; }
        asm volatile("s_waitcnt vmcnt(0)" ::: "memory");
        __syncthreads();
        for (int st = 0; st < 36; ++st) {
            int tt0, ttn;
            if (st < 4) tt0 = (dir ? (3 - st) : st) * CH; else tt0 = TC + (dir ? (35 - st) : (st - 4)) * CH;
            { const int sn = st + 1; if (sn < 4) ttn = (dir ? (3 - sn) : sn) * CH; else ttn = TC + (dir ? (35 - sn) : (sn - 4)) * CH; }
            const bool lat = st >= 4, latn = (st + 1) >= 4, hasn = (st + 1) < 36;
            int frs = fr, fqs = fq; asm volatile("" : "+v"(frs), "+v"(fqs));
            LAS unsigned char* Qb = lds + S2_Q + (st & 1) * 32768;
            LAS unsigned char* Kb = lds + S2_K + (st & 1) * 32768;
            const bf16x8 vf0 = *(const bf16x8*)(Vw + tt0), vf1 = *(const bf16x8*)(Vw + tt0 + 32);
            if (a.is_ml) {
                if (wave == 0) {
                    const float f = gf_n, ig = gi_n, mst = scal[0];
                    const float cc = scan_incl_sum(f, lane);
                    const float ctot = __shfl(cc, 63);
                    const float av = ig - cc;
                    const float mi = scan_incl_max(av, lane);
                    float mx = mi;
                    if (dir) { mx = __shfl_up(mi, 1); if (lane == 0) mx = -1e30f; }
                    const float gmax = __shfl(mi, 63);
                    const float mnew = fmaxf(ctot + mst, ctot + gmax);
                    const float mrow = fmaxf(cc + mx, cc + mst);
                    rowv[sidx] = cc - mrow; colv[sidx] = av; aq[sidx] = expf(cc + mst - mrow); emr[sidx] = expf(-mrow); kd[sidx] = expf(ctot + av - mnew);
                    if (lane == 0) { scal[1] = expf(ctot + mst - mnew); scal[0] = mnew; }
                    if (hasn) { gf_n = Gf[ttn + sidx]; gi_n = Gi[ttn + sidx]; }
                }
                __syncthreads();
            }
            if (lat) {
#pragma unroll
                for (int tq = 0; tq < 2; ++tq) {
                    const int ti = wave * 2 + tq, lt = ti >> 2, mt = ti & 3;
                    f32x4 acc = (f32x4){0.f, 0.f, 0.f, 0.f};
#pragma unroll
                    for (int k8 = 0; k8 < 8; ++k8) {
                        const bf16x8 ka = *(const LAS bf16x8*)(Kb + (LB1 + X4[k8 & 3] + mt * 4096) + (k8 >> 2) * 16384);
                        const bf16x8 qb = *(const LAS bf16x8*)(Qb + (LB1 + X4[k8 & 3] + lt * 4096) + (k8 >> 2) * 16384);
                        acc = MFMA16(ka, qb, acc);
                    }
                    const int l = lt * 16 + frs; const float rv = rowv[l]; float o[4]; float s = 0.f;
#pragma unroll
                    for (int r = 0; r < 4; ++r) { const int m = mt * 16 + 4 * fqs + r; const bool ok = dir ? (m > l) : (m <= l); const float w = ok ? __expf(rv + colv[m]) : 0.f; o[r] = acc[r] * w; s += o[r]; }
                    *(LAS u32x2*)(att + l * ATT_LD + mt * 16 + 4 * fqs) = (u32x2){pk2(o[0], o[1]), pk2(o[2], o[3])};
                    s += __shfl_xor(s, 16); s += __shfl_xor(s, 32);
                    if (fqs == 0) denp[l * 4 + mt] = s;
                }
                if (a.is_ml) {
                    const int l = tid >> 3, part = tid & 7; float s = 0.f;
#pragma unroll
                    for (int cc = 0; cc < 4; ++cc) { const int cg = part * 4 + cc; const u32x4 w = *(const LAS u32x4*)(Qb + img_chunk(l, cg >> 4, cg & 15)); const LAS float* np = nv + cg * 8;
#pragma unroll
                        for (int j = 0; j < 4; ++j) s += bflo(w[j]) * np[2 * j] + bfhi(w[j]) * np[2 * j + 1]; }
                    s += __shfl_xor(s, 1); s += __shfl_xor(s, 2); s += __shfl_xor(s, 4);
                    if (part == 0) qn[l] = s;
                }
            }
            __syncthreads();
            if (hasn) {
                scan_dma_tile(lds + S2_K + ((st + 1) & 1) * 32768, Kh + (size_t)ttn * D, wave, lane);
                if (latn) scan_dma_tile(lds + S2_Q + ((st + 1) & 1) * 32768, Qh + (size_t)ttn * D, wave, lane);
            }
            const float cdec = scal[1];
            if (lat) {
                const int t0 = tt0 - TC;
                f32x4 oacc[4];
#pragma unroll
                for (int lt = 0; lt < 4; ++lt) oacc[lt] = (f32x4){0.f, 0.f, 0.f, 0.f};
#pragma unroll
                for (int kb = 0; kb < 8; ++kb) {
                    u32x4 w; w.x = pk2(S[2 * kb][0], S[2 * kb][1]); w.y = pk2(S[2 * kb][2], S[2 * kb][3]); w.z = pk2(S[2 * kb + 1][0], S[2 * kb + 1][1]); w.w = pk2(S[2 * kb + 1][2], S[2 * kb + 1][3]);
                    const bf16x8 sbk = __builtin_bit_cast(bf16x8, w);
#pragma unroll
                    for (int lt = 0; lt < 4; ++lt) {
                        const u32x2 lo = *(const LAS u32x2*)(Qb + (LB2 + X4[kb & 3]) + lt * 4096 + (kb >> 2) * 16384);
                        const u32x2 hi = *(const LAS u32x2*)(Qb + (LB3 + X4[kb & 3]) + lt * 4096 + (kb >> 2) * 16384);
                        const u32x4 qa = (u32x4){lo.x, lo.y, hi.x, hi.y};
                        oacc[lt] = MFMA16(__builtin_bit_cast(bf16x8, qa), sbk, oacc[lt]);
                    }
                    if (kb & 1) __builtin_amdgcn_sched_barrier(0);
                }
#pragma unroll
                for (int lt = 0; lt < 4; ++lt) {
                    f32x4 acc = oacc[lt];
                    float hs[4];
#pragma unroll
                    for (int r = 0; r < 4; ++r) { const int l = lt * 16 + 4 * fqs + r; acc[r] *= aq[l];
                        if (a.is_ml) { const float den = (denp[l * 4] + denp[l * 4 + 1]) + (denp[l * 4 + 2] + denp[l * 4 + 3]) + aq[l] * qn[l]; hs[r] = 1.f / fmaxf(fabsf(den), emr[l]); } else hs[r] = 1.f; }
                    const bf16x8 a0 = *(const LAS bf16x8*)(att + (lt * 16 + frs) * ATT_LD + 8 * fqs), a1 = *(const LAS bf16x8*)(att + (lt * 16 + frs) * ATT_LD + 32 + 8 * fqs);
                    acc = MFMA16(a0, vf0, acc); acc = MFMA16(a1, vf1, acc);
#pragma unroll
                    for (int r = 0; r < 4; ++r) { const int l = lt * 16 + 4 * fqs + r; Oo[((size_t)b * T + t0 + l) * D + h * 256 + eh * 128 + ew + frs] = f2bf(acc[r] * hs[r]); }
                    __builtin_amdgcn_sched_barrier(0);
                }
            }
            {
                bf16x8 vs[2];
#pragma unroll
                for (int ks = 0; ks < 2; ++ks) { const u32x4 vw = __builtin_bit_cast(u32x4, ks ? vf1 : vf0); const LAS float* kp = kd + 32 * ks + 8 * fqs; u32x4 o;
#pragma unroll
                    for (int j = 0; j < 4; ++j) o[j] = pk2(bflo(vw[j]) * kp[2 * j], bfhi(vw[j]) * kp[2 * j + 1]);
                    vs[ks] = __builtin_bit_cast(bf16x8, o); }
#pragma unroll
                for (int dt = 0; dt < 16; ++dt) {
                    f32x4 acc = S[dt] * cdec;
#pragma unroll
                    for (int ks = 0; ks < 2; ++ks) {
                        const v4i16_t lo = __builtin_amdgcn_ds_read_tr16_b64_v4i16((LAS v4i16_t*)(Kb + (TB0 + W8[dt & 7]) + (dt >> 3) * 16384 + ks * 8192));
                        const v4i16_t hi = __builtin_amdgcn_ds_read_tr16_b64_v4i16((LAS v4i16_t*)(Kb + (TB1 + W8[dt & 7]) + (dt >> 3) * 16384 + ks * 8192));
                        const bf16x8 ka = __builtin_shufflevector(lo, hi, 0, 1, 2, 3, 4, 5, 6, 7);
                        acc = MFMA16(ka, vs[ks], acc);
                    }
                    S[dt] = acc;
                    if ((dt & 1) == 1) __builtin_amdgcn_sched_barrier(0);
                }
                if (a.is_ml && tid < 256) { const int d = tid; float s = nv[d] * cdec;
#pragma unroll 4
                    for (int m = 0; m < CH; ++m) s += kd[m] * bf2f(*(const LAS bf16_t*)(Kb + img_chunk(m, d >> 7, (d & 127) >> 3) + (d & 7) * 2));
                    nv[d] = s; }
            }
            asm volatile("s_waitcnt vmcnt(0)" ::: "memory");
            __syncthreads();
        }
    }
}


constexpr int S3_SET = 328;
template <int VAR> __device__ __forceinline__ void scan_phase3(LAS unsigned char* lds, const ScanArgs a, int tid, int wave, int lane) {
    LAS bf16_t* att = (LAS bf16_t*)(lds + S2_ATT);
    LAS float* vec = (LAS float*)(lds + S2_VEC);
    LAS float* qn2 = vec + 2 * S3_SET, *denp = qn2 + 128;
    const int fr = lane & 15, fq = lane >> 4;
    for (int item = blockIdx.x; item < 256; item += gridDim.x) {
        const int eh = item & 1, dir = (item >> 1) & 1, h = (item >> 2) & 3, b = item >> 4;
        const int ew = wave * 16;
        const int Ff = swz_f(fr), Fhp = Ff >> 2, Flp = Ff & 3;
        int X4[4];
#pragma unroll
        for (int c2 = 0; c2 < 4; ++c2) X4[c2] = 64 * (c2 ^ Fhp);
        const int LB1 = 256 * fr + 16 * (fq ^ Flp);
        const int LB2 = 256 * fr + 16 * ((fq >> 1) ^ Flp) + 8 * (fq & 1);
        const int LB3 = 256 * fr + 16 * (((fq >> 1) | 2) ^ Flp) + 8 * (fq & 1);
        const int q4 = (lane & 15) >> 2, p4 = lane & 3;
        const int TB0 = 256 * (8 * fq + q4) + 16 * (p4 >> 1) + 8 * (p4 & 1);
        const int TB1 = 256 * (8 * fq + q4 + 4) + 16 * ((p4 >> 1) ^ 1) + 8 * (p4 & 1);
        int W8[8];
#pragma unroll
        for (int i = 0; i < 8; ++i) W8[i] = 64 * ((i >> 1) ^ q4) + 32 * ((i & 1) ^ (fq & 1));
        __syncthreads();
        f32x4 S[16];
#pragma unroll
        for (int i = 0; i < 16; ++i) S[i] = (f32x4){0.f, 0.f, 0.f, 0.f};
        if (tid < 128) qn2[tid] = 0.f;
        f32x4 nA[2]; nA[0] = (f32x4){0.f, 0.f, 0.f, 0.f}; nA[1] = nA[0];
        const float* Gi = a.G + ((size_t)b * 16 + (dir ? 8 : 0) + h) * TT;
        const float* Gf = a.G + ((size_t)b * 16 + (dir ? 12 : 4) + h) * TT;
        bf16_t* Oo = (dir ? a.Ob : a.Of) + (size_t)b * T * D + h * 256 + eh * 128 + ew;
        const bf16_t* Qh = a.Q + (size_t)b * TT * D + h * 256;
        const bf16_t* Kh = a.K + (size_t)b * TT * D + h * 256;
        const bf16_t* Vw = a.VT + ((size_t)(b * 4 + h) * 256 + eh * 128 + ew + fr) * TT + 8 * fq;
        const int sidx = dir ? 63 - lane : lane;
        if (!a.is_ml) {
            const float lg = logsigmoid_f(a.decay[dir * 4 + h]);
            if (tid < 2 * CH) { const int l = tid & 63; LAS float* v = vec + (tid >> 6) * S3_SET;
                v[l] = (dir ? -(float)l : (float)l) * lg; v[64 + l] = (dir ? (float)l : -(float)l) * lg;
                v[128 + l] = expf((float)(dir ? (CH - l) : (l + 1)) * lg); v[192 + l] = expf((float)(dir ? l : (CH - 1 - l)) * lg); v[256 + l] = 0.f;
                if (l == 0) v[321] = expf((float)CH * lg); }
        }
#define S3_STAGE1(SET, f_, ig_) do { LAS float* v_ = vec + (SET) * S3_SET; \
            const float cc_ = scan_incl_sum((f_), lane); const float ctot_ = __shfl(cc_, 63); const float av_ = (ig_) - cc_; \
            const float mi_ = scan_incl_max(av_, lane); float mx_ = mi_; if (dir) { mx_ = __shfl_up(mi_, 1); if (lane == 0) mx_ = -1e30f; } \
            const float gmax_ = __shfl(mi_, 63); const float mnew_ = fmaxf(ctot_ + mst, ctot_ + gmax_); const float mrow_ = fmaxf(cc_ + mx_, cc_ + mst); \
            v_[sidx] = cc_ - mrow_; v_[64 + sidx] = av_; v_[128 + sidx] = __expf(cc_ + mst - mrow_); v_[256 + sidx] = __expf(-mrow_); v_[192 + sidx] = __expf(ctot_ + av_ - mnew_); \
            if (lane == 0) v_[321] = __expf(ctot_ + mst - mnew_); mst = mnew_; } while (0)
        float mst = 0.f, gf_n = 0.f, gi_n = 0.f;
        const int tt_first = (dir ? 3 : 0) * CH;
        if (!(VAR & 1)) scan_dma_tile(lds + S2_K, Kh + (size_t)tt_first * D, wave, lane);
        bf16x8 vf0 = *(const bf16x8*)(Vw + tt_first), vf1 = *(const bf16x8*)(Vw + tt_first + 32);
        if (a.is_ml && wave == 0) {
            const float f0 = Gf[tt_first + sidx], i0 = Gi[tt_first + sidx];
            S3_STAGE1(0, f0, i0);
            const int tt1 = (dir ? 2 : 1) * CH; gf_n = Gf[tt1 + sidx]; gi_n = Gi[tt1 + sidx];
        }
        float outv[16];
#pragma unroll
        for (int i = 0; i < 16; ++i) outv[i] = 0.f;
        int tprev = -1;
        asm volatile("s_waitcnt vmcnt(0)" ::: "memory");
        __syncthreads();
        for (int st = 0; st < 36; ++st) {
            int tt0, ttn, ttnn;
            if (st < 4) tt0 = (dir ? (3 - st) : st) * CH; else tt0 = TC + (dir ? (35 - st) : (st - 4)) * CH;
            { const int sn = st + 1; if (sn < 4) ttn = (dir ? (3 - sn) : sn) * CH; else ttn = TC + (dir ? (35 - sn) : (sn - 4)) * CH; }
            { const int sn = st + 2; if (sn < 4) ttnn = (dir ? (3 - sn) : sn) * CH; else ttnn = TC + (dir ? (35 - sn) : (sn - 4)) * CH; }
            const bool lat = st >= 4, latn = (st + 1) >= 4, hasn = (st + 1) < 36, hasnn = (st + 2) < 36;
            int frs = fr, fqs = fq; asm volatile("" : "+v"(frs), "+v"(fqs));
            LAS unsigned char* Qb = lds + S2_Q + (st & 1) * 32768;
            LAS unsigned char* Kb = lds + S2_K + (st & 1) * 32768;
            LAS float* vs_ = vec + ((a.is_ml ? st : 0) & 1) * S3_SET;
            LAS float* rowv = vs_, *colv = vs_ + 64, *aq = vs_ + 128, *kd = vs_ + 192, *emr = vs_ + 256;
            LAS float* qn = qn2 + (st & 1) * 64;
            bf16x8 vfn0 = vf0, vfn1 = vf1;
            if (tprev >= 0) {
#pragma unroll
                for (int lt = 0; lt < 4; ++lt)
#pragma unroll
                    for (int r = 0; r < 4; ++r) Oo[(size_t)(tprev + lt * 16 + 4 * fqs + r) * D + frs] = f2bf(outv[lt * 4 + r]);
            }
            f32x4 oacc[4];
#pragma unroll
            for (int lt = 0; lt < 4; ++lt) oacc[lt] = (f32x4){0.f, 0.f, 0.f, 0.f};
            if (lat) {
                if (!(VAR & 2)) {
                {
                    int lts[2], mts[2];
#pragma unroll
                    for (int tq = 0; tq < 2; ++tq) { const int ti = wave * 2 + tq;
                        const int ta = (int)((0x3333222110211000ull >> (4 * ti)) & 15ull), tb = (int)((0x3210210100332321ull >> (4 * ti)) & 15ull);
                        lts[tq] = dir ? tb : ta; mts[tq] = dir ? ta : tb; }
                    f32x4 accs[2]; accs[0] = (f32x4){0.f, 0.f, 0.f, 0.f}; accs[1] = accs[0];
                    if (wave >= 3) {
#pragma unroll
                        for (int k8 = 0; k8 < 8; ++k8) {
#pragma unroll
                            for (int tq = 0; tq < 2; ++tq) {
                                const bf16x8 ka = *(const LAS bf16x8*)(Kb + (LB1 + X4[k8 & 3] + mts[tq] * 4096) + (k8 >> 2) * 16384);
                                const bf16x8 qb = *(const LAS bf16x8*)(Qb + (LB1 + X4[k8 & 3] + lts[tq] * 4096) + (k8 >> 2) * 16384);
                                accs[tq] = MFMA16(ka, qb, accs[tq]);
                            }
                        }
                    }
#pragma unroll
                    for (int tq = 0; tq < 2; ++tq) {
                        const int lt = lts[tq], mt = mts[tq]; const f32x4 acc = accs[tq];
                        const int l = lt * 16 + frs; const float rv = rowv[l]; float o[4]; float s = 0.f;
#pragma unroll
                        for (int r = 0; r < 4; ++r) { const int m = mt * 16 + 4 * fqs + r; const bool ok = dir ? (m > l) : (m <= l); const float w = ok ? __expf(rv + colv[m]) : 0.f; o[r] = acc[r] * w; s += o[r]; }
                        *(LAS u32x2*)(att + l * ATT_LD + mt * 16 + 4 * fqs) = (u32x2){pk2(o[0], o[1]), pk2(o[2], o[3])};
                        s += __shfl_xor(s, 16); s += __shfl_xor(s, 32);
                        if (fqs == 0) denp[l * 4 + mt] = s;
                    }
                }
                }
            }
            asm volatile("" : "+v"(vf0), "+v"(vf1), "+v"(gf_n), "+v"(gi_n));
            if (hasn) { vfn0 = *(const bf16x8*)(Vw + ttn); vfn1 = *(const bf16x8*)(Vw + ttn + 32); }
            if (hasn) {
                scan_dma_tile(lds + S2_K + ((st + 1) & 1) * 32768, Kh + (size_t)ttn * D, wave, lane);
                if (latn) scan_dma_tile(lds + S2_Q + ((st + 1) & 1) * 32768, Qh + (size_t)ttn * D, wave, lane);
            }
            if (lat) {
                __builtin_amdgcn_sched_barrier(0);
                if (!(VAR & 4)) {
                bf16x8 nfr;
                { u32x4 w; w.x = pk2(nA[0][0], nA[0][1]); w.y = pk2(nA[0][2], nA[0][3]); w.z = pk2(nA[1][0], nA[1][1]); w.w = pk2(nA[1][2], nA[1][3]); nfr = __builtin_bit_cast(bf16x8, w); }
#pragma unroll
                for (int kb = 0; kb < 8; ++kb) {
                    u32x4 w; w.x = pk2(S[2 * kb][0], S[2 * kb][1]); w.y = pk2(S[2 * kb][2], S[2 * kb][3]); w.z = pk2(S[2 * kb + 1][0], S[2 * kb + 1][1]); w.w = pk2(S[2 * kb + 1][2], S[2 * kb + 1][3]);
                    const bf16x8 sbk = __builtin_bit_cast(bf16x8, w);
                    u32x2 ql[4], qh[4];
                    { const unsigned alo = (unsigned)(size_t)(Qb + (LB2 + X4[kb & 3]) + (kb >> 2) * 16384), ahi = (unsigned)(size_t)(Qb + (LB3 + X4[kb & 3]) + (kb >> 2) * 16384);
                      asm volatile("ds_read_b64 %0, %8\n\tds_read_b64 %1, %9\n\tds_read_b64 %2, %8 offset:4096\n\tds_read_b64 %3, %9 offset:4096\n\t"
                                   "ds_read_b64 %4, %8 offset:8192\n\tds_read_b64 %5, %9 offset:8192\n\tds_read_b64 %6, %8 offset:12288\n\tds_read_b64 %7, %9 offset:12288\n\ts_waitcnt lgkmcnt(0)"
                                   : "=&v"(ql[0]), "=&v"(qh[0]), "=&v"(ql[1]), "=&v"(qh[1]), "=&v"(ql[2]), "=&v"(qh[2]), "=&v"(ql[3]), "=&v"(qh[3]) : "v"(alo), "v"(ahi) : "memory"); }
#pragma unroll
                    for (int lt = 0; lt < 4; ++lt) {
                        const u32x2 lo = ql[lt], hi = qh[lt];
                        const u32x4 qa = (u32x4){lo.x, lo.y, hi.x, hi.y};
                        oacc[lt] = MFMA16(__builtin_bit_cast(bf16x8, qa), sbk, oacc[lt]);
                    }
                    if (kb & 1) __builtin_amdgcn_sched_barrier(0);
                }
                if (a.is_ml) {
                    u32x2 ql[4], qh[4];
                    { const int xw = 64 * ((wave & 3) ^ Fhp) + (wave >> 2) * 16384; const unsigned alo = (unsigned)(size_t)(Qb + LB2 + xw), ahi = (unsigned)(size_t)(Qb + LB3 + xw);
                      asm volatile("ds_read_b64 %0, %8\n\tds_read_b64 %1, %9\n\tds_read_b64 %2, %8 offset:4096\n\tds_read_b64 %3, %9 offset:4096\n\t"
                                   "ds_read_b64 %4, %8 offset:8192\n\tds_read_b64 %5, %9 offset:8192\n\tds_read_b64 %6, %8 offset:12288\n\tds_read_b64 %7, %9 offset:12288\n\ts_waitcnt lgkmcnt(0)"
                                   : "=&v"(ql[0]), "=&v"(qh[0]), "=&v"(ql[1]), "=&v"(qh[1]), "=&v"(ql[2]), "=&v"(qh[2]), "=&v"(ql[3]), "=&v"(qh[3]) : "v"(alo), "v"(ahi) : "memory"); }
#pragma unroll
                    for (int lt = 0; lt < 4; ++lt) {
                        const u32x4 qa = (u32x4){ql[lt].x, ql[lt].y, qh[lt].x, qh[lt].y};
                        const f32x4 qp = MFMA16(__builtin_bit_cast(bf16x8, qa), nfr, ((f32x4){0.f, 0.f, 0.f, 0.f}));
                        if (frs == 0) {
                            const unsigned qa_ = (unsigned)(size_t)(qn + lt * 16 + 4 * fqs);
                            asm volatile("s_nop 7\n\ts_nop 7\n\tds_add_f32 %0, %1\n\tds_add_f32 %0, %2 offset:4\n\tds_add_f32 %0, %3 offset:8\n\tds_add_f32 %0, %4 offset:12" :: "v"(qa_), "v"(qp[0]), "v"(qp[1]), "v"(qp[2]), "v"(qp[3]) : "memory");
                        }
                    }
                }
                }
            }
            if (a.is_ml && wave == 0 && hasn) {
                S3_STAGE1((st + 1) & 1, gf_n, gi_n);
                if (hasnn) { gf_n = Gf[ttnn + sidx]; gi_n = Gi[ttnn + sidx]; }
            }
            const float cdec = vs_[321];
            if (!(VAR & 8)) {
                bf16x8 vs[2];
#pragma unroll
                for (int ks = 0; ks < 2; ++ks) { const u32x4 vw = __builtin_bit_cast(u32x4, ks ? vf1 : vf0); const LAS float* kp = kd + 32 * ks + 8 * fqs; u32x4 o;
#pragma unroll
                    for (int j = 0; j < 4; ++j) o[j] = pk2(bflo(vw[j]) * kp[2 * j], bfhi(vw[j]) * kp[2 * j + 1]);
                    vs[ks] = __builtin_bit_cast(bf16x8, o); }
                bf16x8 kdf[2];
                if (a.is_ml) {
#pragma unroll
                    for (int ks = 0; ks < 2; ++ks) { const LAS float* kp = kd + 32 * ks + 8 * fqs; u32x4 o;
#pragma unroll
                        for (int j = 0; j < 4; ++j) o[j] = pk2(kp[2 * j], kp[2 * j + 1]);
                        kdf[ks] = __builtin_bit_cast(bf16x8, o); }
                    nA[0] = nA[0] * cdec; nA[1] = nA[1] * cdec;
                }
#pragma unroll
                for (int g = 0; g < 8; ++g) {
                    v4i16_t t0, t1, t2, t3, t4, t5, t6, t7;
                    const unsigned a00 = (unsigned)(size_t)(Kb + (TB0 + W8[(2 * g) & 7]) + ((2 * g) >> 3) * 16384), a01 = (unsigned)(size_t)(Kb + (TB1 + W8[(2 * g) & 7]) + ((2 * g) >> 3) * 16384);
                    const unsigned a10 = (unsigned)(size_t)(Kb + (TB0 + W8[(2 * g + 1) & 7]) + ((2 * g + 1) >> 3) * 16384), a11 = (unsigned)(size_t)(Kb + (TB1 + W8[(2 * g + 1) & 7]) + ((2 * g + 1) >> 3) * 16384);
                    asm volatile("ds_read_b64_tr_b16 %0, %8\n\tds_read_b64_tr_b16 %1, %9\n\tds_read_b64_tr_b16 %2, %8 offset:8192\n\tds_read_b64_tr_b16 %3, %9 offset:8192\n\t"
                                 "ds_read_b64_tr_b16 %4, %10\n\tds_read_b64_tr_b16 %5, %11\n\tds_read_b64_tr_b16 %6, %10 offset:8192\n\tds_read_b64_tr_b16 %7, %11 offset:8192\n\ts_waitcnt lgkmcnt(0)"
                                 : "=&v"(t0), "=&v"(t1), "=&v"(t2), "=&v"(t3), "=&v"(t4), "=&v"(t5), "=&v"(t6), "=&v"(t7) : "v"(a00), "v"(a01), "v"(a10), "v"(a11) : "memory");
#define S3_UPD(dt_, lo0_, hi0_, lo1_, hi1_) do { f32x4 acc = S[dt_] * cdec; \
                        const bf16x8 ka0 = __builtin_shufflevector(lo0_, hi0_, 0, 1, 2, 3, 4, 5, 6, 7), ka1 = __builtin_shufflevector(lo1_, hi1_, 0, 1, 2, 3, 4, 5, 6, 7); \
                        acc = MFMA16(ka0, vs[0], acc); acc = MFMA16(ka1, vs[1], acc); \
                        S[dt_] = acc; } while (0)
                    S3_UPD(2 * g, t0, t1, t2, t3); S3_UPD(2 * g + 1, t4, t5, t6, t7);
#undef S3_UPD
                    __builtin_amdgcn_sched_barrier(0);
                }
                if (a.is_ml) {
#pragma unroll
                    for (int t = 0; t < 2; ++t) {
                        const int w8 = 64 * ((wave & 3) ^ q4) + 32 * (t ^ (fq & 1)) + (wave >> 2) * 16384;
                        v4i16_t t0, t1, t2, t3; const unsigned a0 = (unsigned)(size_t)(Kb + TB0 + w8), a1 = (unsigned)(size_t)(Kb + TB1 + w8);
                        asm volatile("ds_read_b64_tr_b16 %0, %4\n\tds_read_b64_tr_b16 %1, %5\n\tds_read_b64_tr_b16 %2, %4 offset:8192\n\tds_read_b64_tr_b16 %3, %5 offset:8192\n\ts_waitcnt lgkmcnt(0)"
                                     : "=&v"(t0), "=&v"(t1), "=&v"(t2), "=&v"(t3) : "v"(a0), "v"(a1) : "memory");
                        const bf16x8 ka0 = __builtin_shufflevector(t0, t1, 0, 1, 2, 3, 4, 5, 6, 7), ka1 = __builtin_shufflevector(t2, t3, 0, 1, 2, 3, 4, 5, 6, 7);
                        nA[t] = MFMA16(ka0, kdf[0], nA[t]); nA[t] = MFMA16(ka1, kdf[1], nA[t]);
                    }
                }
            }
            asm volatile("s_waitcnt lgkmcnt(0)" ::: "memory"); __builtin_amdgcn_s_barrier(); asm volatile("" ::: "memory");
            const bf16x8 av0 = vf0, av1 = vf1;
            if (lat && !(VAR & 16)) {
#pragma unroll
                for (int lt = 0; lt < 4; ++lt) {
                    f32x4 acc = oacc[lt];
                    float hs[4];
#pragma unroll
                    for (int r = 0; r < 4; ++r) { const int l = lt * 16 + 4 * fqs + r; acc[r] *= aq[l];
                        if (a.is_ml) { const float den = (denp[l * 4] + denp[l * 4 + 1]) + (denp[l * 4 + 2] + denp[l * 4 + 3]) + aq[l] * qn[l]; hs[r] = 1.f / fmaxf(fabsf(den), emr[l]); } else hs[r] = 1.f; }
                    const bf16x8 a0 = *(const LAS bf16x8*)(att + (lt * 16 + frs) * ATT_LD + 8 * fqs), a1 = *(const LAS bf16x8*)(att + (lt * 16 + frs) * ATT_LD + 32 + 8 * fqs);
                    acc = MFMA16(a0, av0, acc); acc = MFMA16(a1, av1, acc);
#pragma unroll
                    for (int r = 0; r < 4; ++r) outv[lt * 4 + r] = acc[r] * hs[r];
                }
                tprev = tt0 - TC;
            } else tprev = -1;
            if (a.is_ml) {
                if (tid >= 448) qn2[((st + 1) & 1) * 64 + (tid - 448)] = 0.f;
            }
            asm volatile("s_waitcnt vmcnt(0)" ::: "memory");
            __syncthreads();
            vf0 = vfn0; vf1 = vfn1;
        }
        if (tprev >= 0) {
#pragma unroll
            for (int lt = 0; lt < 4; ++lt)
#pragma unroll
                for (int r = 0; r < 4; ++r) Oo[(size_t)(tprev + lt * 16 + 4 * fq + r) * D + fr] = f2bf(outv[lt * 4 + r]);
        }
#undef S3_STAGE1
    }
}

template <int ACT  > __device__ __forceinline__ void phase4_one(const bf16_t* Of, const bf16_t* Ob, const bf16_t* Ga, bf16_t* Out, int wave, int lane) {
    const int gw = blockIdx.x * NWAVES + wave, NGW = gridDim.x * NWAVES;
    u32x4 f[2], bb[2], gg[2], nf[2], nb[2], ng[2];
    if (gw < NLAT) {
#pragma unroll
        for (int j = 0; j < 2; ++j) { f[j] = ld_nt((const u32x4*)(Of + (size_t)gw * D) + lane + 64 * j); bb[j] = ld_nt((const u32x4*)(Ob + (size_t)gw * D) + lane + 64 * j); gg[j] = ld_nt((const u32x4*)(Ga + (size_t)gw * D) + lane + 64 * j); } }
    for (int R = gw; R < NLAT; R += NGW) {
        const int Rn = R + NGW;
        if (Rn < NLAT) {
#pragma unroll
            for (int j = 0; j < 2; ++j) { nf[j] = ld_nt((const u32x4*)(Of + (size_t)Rn * D) + lane + 64 * j); nb[j] = ld_nt((const u32x4*)(Ob + (size_t)Rn * D) + lane + 64 * j); ng[j] = ld_nt((const u32x4*)(Ga + (size_t)Rn * D) + lane + 64 * j); } }
        u32x4* op = (u32x4*)(Out + (size_t)R * D);
#pragma unroll
        for (int j = 0; j < 2; ++j) {
            float v[8]; float s = 0.f;
#pragma unroll
            for (int i = 0; i < 4; ++i) { v[2 * i] = bflo(f[j][i]) + bflo(bb[j][i]); v[2 * i + 1] = bfhi(f[j][i]) + bfhi(bb[j][i]); s += v[2 * i] + v[2 * i + 1]; }
            const float mean = half_sum(s) * (1.f / 256.f); float s2 = 0.f;
#pragma unroll
            for (int i = 0; i < 8; ++i) { v[i] -= mean; s2 += v[i] * v[i]; }
            const float rstd = 1.f / sqrtf(half_sum(s2) * (1.f / 256.f) + LN_EPS);
            u32x4 o;
#pragma unroll
            for (int i = 0; i < 4; ++i) { const float ga = bflo(gg[j][i]), gb = bfhi(gg[j][i]); o[i] = pk2(v[2 * i] * rstd * (ACT ? sigmoid_f(ga) : silu_f(ga)), v[2 * i + 1] * rstd * (ACT ? sigmoid_f(gb) : silu_f(gb))); }
            op[lane + 64 * j] = o;
        }
#pragma unroll
        for (int j = 0; j < 2; ++j) { f[j] = nf[j]; bb[j] = nb[j]; gg[j] = ng[j]; }
    }
}

struct SchedDense { int G, c, nM, nN, rep; __device__ __forceinline__ void a_ready(const Unit&) const {} __device__ __forceinline__ void done(const Unit&) const {}
    __device__ __forceinline__ bool next(int i, Unit& u) const {
        const int x = c & 7, y = c >> 3, nxc = G >> 3; int q = i * nxc + y; const int ntot = (nM >> 3) * 4; if (q >= rep * ntot) return false; q %= ntot; u.pm = x + 8 * (q >> 2); u.pn = q & 3; return true; } };
struct EpiY {
    static constexpr bool PERM = true, AFTER_DRAIN = false;
    bf16_t* Y; const bf16_t* gate; int pass;
    __device__ __forceinline__ void operator()(const f32x4 (&acc)[2][2][4][2], const Unit& u, int wr, int wc, int fr, int fq) const {
#pragma unroll
        for (int ai = 0; ai < 2; ++ai)
#pragma unroll
            for (int m = 0; m < 4; ++m) { const int r = u.pm * 256 + ai * 128 + wr * 64 + m * 16 + fr;
#pragma unroll
                for (int bj = 0; bj < 2; ++bj) { const size_t off = (size_t)r * D + u.pn * 256 + bj * 128 + wc * 32 + 8 * fq; const f32x4 v0 = acc[ai][bj][m][0], v1 = acc[ai][bj][m][1];
                    const u32x4 g = *(const u32x4*)(gate + off);
                    float o[8] = {bflo(g.x) * v0[0], bfhi(g.x) * v0[1], bflo(g.y) * v0[2], bfhi(g.y) * v0[3], bflo(g.z) * v1[0], bfhi(g.z) * v1[1], bflo(g.w) * v1[2], bfhi(g.w) * v1[3]};
                    if (pass) { const u32x4 y = *(const u32x4*)(Y + off); o[0] += bflo(y.x); o[1] += bfhi(y.x); o[2] += bflo(y.y); o[3] += bfhi(y.y); o[4] += bflo(y.z); o[5] += bfhi(y.z); o[6] += bflo(y.w); o[7] += bfhi(y.w); }
                    *(u32x4*)(Y + off) = (u32x4){pk2(o[0], o[1]), pk2(o[2], o[3]), pk2(o[4], o[5]), pk2(o[6], o[7])}; } }
    }
};
struct EpiY2 {
    static constexpr bool PERM = true, AFTER_DRAIN = false;
    bf16_t* Y2;
    __device__ __forceinline__ void operator()(const f32x4 (&acc)[2][2][4][2], const Unit& u, int wr, int wc, int fr, int fq) const {
#pragma unroll
        for (int ai = 0; ai < 2; ++ai)
#pragma unroll
            for (int m = 0; m < 4; ++m) { const int r = u.pm * 256 + ai * 128 + wr * 64 + m * 16 + fr;
#pragma unroll
                for (int bj = 0; bj < 2; ++bj) { const f32x4 v0 = acc[ai][bj][m][0], v1 = acc[ai][bj][m][1];
                    *(u32x4*)(Y2 + (size_t)r * D + u.pn * 256 + bj * 128 + wc * 32 + 8 * fq) = (u32x4){pk2(v0[0], v0[1]), pk2(v0[2], v0[3]), pk2(v1[0], v1[1]), pk2(v1[2], v1[3])}; } }
    }
};
struct EpiZ {
    static constexpr bool PERM = false, AFTER_DRAIN = false;
    const float* x; const float* MOD; float* Z;
    __device__ __forceinline__ void operator()(const f32x4 (&acc)[2][2][4][2], const Unit& u, int wr, int wc, int fr, int fq) const {
#pragma unroll
        for (int ai = 0; ai < 2; ++ai)
#pragma unroll
            for (int m = 0; m < 4; ++m) { const int r = u.pm * 256 + ai * 128 + wr * 64 + m * 16 + fr, b = r >> 11;
#pragma unroll
                for (int bj = 0; bj < 2; ++bj)
#pragma unroll
                    for (int n = 0; n < 2; ++n) { const int c = u.pn * 256 + bj * 128 + wc * 32 + n * 16 + 4 * fq; const size_t off = (size_t)r * D + c;
                        const f32x4 xv = *(const f32x4*)(x + off), gv = *(const f32x4*)(MOD + (size_t)b * 6144 + 2048 + c);
                        *(f32x4*)(Z + off) = xv * DN_ALPHA + gv * acc[ai][bj][m][n]; } }
    }
};

constexpr int P7_U2F = 0, P7_LD = 1028, P7_PART = 16 * P7_LD * 4, P7_LOG = P7_PART + 8 * 16 * 48 * 4, P7_CNT = P7_LOG + 16 * 48 * 4;
__device__ __forceinline__ void phase7(const Params& p, LAS unsigned char* lds, int tid, int wave, int lane) {
    const int G = gridDim.x, gw = blockIdx.x * NWAVES + wave, NGW = G * NWAVES;
    LAS float* u2f = (LAS float*)(lds + P7_U2F); LAS float* part = (LAS float*)(lds + P7_PART); LAS float* logt = (LAS float*)(lds + P7_LOG);
    LAS int* lcnt = (LAS int*)(lds + P7_CNT);
    if (tid < 32) lcnt[tid] = 0;
    __syncthreads();
    const float* MOD = (const float*)(p.ws + WS_MOD); const float* WR = (const float*)(p.ws + WS_WRT);
    bf16_t* U2 = (bf16_t*)(p.ws + WS_U2); int* rec = (int*)(p.ws + WS_TOKREC);
    const float* g1 = p.in[I_LN1G]; const float* b1 = p.in[I_LN1B];
    const int fr = lane & 15, fq = lane >> 4;
    float wreg[32][3];
    { const float* bp = WR + (size_t)(wave * 128 + fq) * 48 + fr;
#pragma unroll
      for (int kk = 0; kk < 32; ++kk)
#pragma unroll
          for (int nt = 0; nt < 3; ++nt) wreg[kk][nt] = bp[(size_t)kk * 4 * 48 + 16 * nt]; }
    const bf16_t* Y2 = (const bf16_t*)(p.ws + WS_Y2); const float* xin = p.in[I_X];
    f32x4 zn[2][4]; u32x2 yn[2][4];
    if ((int)blockIdx.x < NLAT / 16) {
#pragma unroll
        for (int rr = 0; rr < 2; ++rr)
#pragma unroll
            for (int j = 0; j < 4; ++j) { const size_t R = (size_t)(blockIdx.x * 16 + wave * 2 + rr); zn[rr][j] = ld_nt((const f32x4*)(xin + R * D) + lane + 64 * j); yn[rr][j] = ld_nt((const u32x2*)(Y2 + R * D) + lane + 64 * j); } }
    for (int bi = blockIdx.x; bi < NLAT / 16; bi += G) {
#pragma unroll
        for (int rr = 0; rr < 2; ++rr) {
            const int rl = wave * 2 + rr, R = bi * 16 + rl, b = R >> 11;
            f32x4 zc[4];
            { const float* gv = MOD + (size_t)b * 6144 + 2048;
#pragma unroll
              for (int j = 0; j < 4; ++j) { const f32x4 g = *(const f32x4*)(gv + 4 * lane + 256 * j); const u32x2 y = yn[rr][j];
                  zc[j] = zn[rr][j] * DN_ALPHA + g * (f32x4){bflo(y.x), bfhi(y.x), bflo(y.y), bfhi(y.y)}; } }
            if (bi + G < NLAT / 16) {
#pragma unroll
                for (int j = 0; j < 4; ++j) { const size_t Rn = (size_t)((bi + G) * 16 + rl); zn[rr][j] = ld_nt((const f32x4*)(xin + Rn * D) + lane + 64 * j); yn[rr][j] = ld_nt((const u32x2*)(Y2 + Rn * D) + lane + 64 * j); } }
            float* zr = p.out + (size_t)R * D;
            f32x4 v[4]; float s = 0.f;
#pragma unroll
            for (int j = 0; j < 4; ++j) { v[j] = zc[j]; s += (v[j].x + v[j].y) + (v[j].z + v[j].w); }
            float mean = wave_sum(s) * (1.f / D); float s2 = 0.f;
#pragma unroll
            for (int j = 0; j < 4; ++j) { v[j] = v[j] - mean; s2 += (v[j].x * v[j].x + v[j].y * v[j].y) + (v[j].z * v[j].z + v[j].w * v[j].w); }
            float rstd = 1.f / sqrtf(wave_sum(s2) * (1.f / D) + LN_EPS);
            s = 0.f;
#pragma unroll
            for (int j = 0; j < 4; ++j) { const int col = 4 * lane + 256 * j; v[j] = v[j] * rstd * *(const f32x4*)(g1 + col) + *(const f32x4*)(b1 + col); st_nt((f32x4*)zr + lane + 64 * j, v[j]); s += (v[j].x + v[j].y) + (v[j].z + v[j].w); }
            mean = wave_sum(s) * (1.f / D); s2 = 0.f;
#pragma unroll
            for (int j = 0; j < 4; ++j) { v[j] = v[j] - mean; s2 += (v[j].x * v[j].x + v[j].y * v[j].y) + (v[j].z * v[j].z + v[j].w * v[j].w); }
            rstd = 1.f / sqrtf(wave_sum(s2) * (1.f / D) + LN_EPS);
            const float* sh = MOD + (size_t)b * 6144 + 3072; const float* sc = sh + 1024;
            u32x2* o8 = (u32x2*)(U2 + (size_t)R * D);
#pragma unroll
            for (int j = 0; j < 4; ++j) { const int col = 4 * lane + 256 * j; v[j] = v[j] * rstd * (*(const f32x4*)(sc + col) + 1.f) + *(const f32x4*)(sh + col);
                o8[lane + 64 * j] = (u32x2){pk2(v[j].x, v[j].y), pk2(v[j].z, v[j].w)};
                *(LAS f32x4*)(u2f + rl * P7_LD + col) = v[j]; }
        }
        __syncthreads();
        {
            f32x4 acc[3];
#pragma unroll
            for (int nt = 0; nt < 3; ++nt) acc[nt] = (f32x4){0.f, 0.f, 0.f, 0.f};
            const LAS float* ap = u2f + fr * P7_LD + wave * 128 + fq;
#pragma unroll
            for (int kk = 0; kk < 32; ++kk) {
                const float av = ap[4 * kk];
#pragma unroll
                for (int nt = 0; nt < 3; ++nt) acc[nt] = __builtin_amdgcn_mfma_f32_16x16x4f32(av, wreg[kk][nt], acc[nt], 0, 0, 0);
            }
#pragma unroll
            for (int nt = 0; nt < 3; ++nt)
#pragma unroll
                for (int r = 0; r < 4; ++r) part[(wave * 16 + 4 * fq + r) * 48 + 16 * nt + fr] = acc[nt][r];
        }
        __syncthreads();
        for (int i = tid; i < 16 * 48; i += NTHREADS) { float q = 0.f;
#pragma unroll
            for (int w = 0; w < 8; ++w) q += part[w * 16 * 48 + i];
            logt[i] = q; }
        __syncthreads();
        if (tid < 16) {
            const int R = bi * 16 + tid; const LAS float* lg = logt + tid * 48;
            float gl[4];
#pragma unroll
            for (int i = 0; i < 4; ++i) gl[i] = lg[i] + p.in[I_BRG][i];
            int gi = 0; float gm = gl[0];
#pragma unroll
            for (int i = 1; i < 4; ++i) if (gl[i] > gm) { gm = gl[i]; gi = i; }
            float gsum = 0.f;
#pragma unroll
            for (int i = 0; i < 4; ++i) gsum += expf(gl[i] - gm);
            const float pg = 1.f / gsum;
            int e0 = 0, e1 = -1; float m0 = -3.0e38f, m1 = -3.0e38f;
            for (int j = 0; j < 8; ++j) { const float x = lg[4 + gi * 8 + j] + p.in[I_BRE][gi * 8 + j];
                if (x > m0) { m1 = m0; e1 = e0; m0 = x; e0 = j; } else if (x > m1) { m1 = x; e1 = j; } }
            const float p1 = expf(m1 - m0); const float w0 = pg / (1.f + p1), w1 = pg * p1 / (1.f + p1);
            const int E0 = gi * 8 + e0, E1 = gi * 8 + e1;
            const int r0 = atomicAdd((int*)&lcnt[E0], 1), r1 = atomicAdd((int*)&lcnt[E1], 1);
            int* rr = rec + (size_t)R * 8; rr[0] = E0; rr[1] = E1; rr[2] = r0; rr[3] = r1; rr[4] = __float_as_int(w0); rr[5] = __float_as_int(w1); rr[6] = (int)blockIdx.x; rr[7] = 0;
        }
    }
    __syncthreads();
    if (tid < 32) { const int base = atomicAdd((int*)(p.ws + WS_CTL) + tid, lcnt[tid]); ((int*)(p.ws + WS_BASE))[blockIdx.x * 32 + tid] = base; }
    {
        LAS float* scr = (LAS float*)(lds + wave * 8448);
        constexpr int I13 = 16 * 16, I2 = 8 * 32;
        for (int it = gw; it < 32 * (2 * I13 + I2); it += NGW) {
            const int e = it / (2 * I13 + I2); int r = it % (2 * I13 + I2);
            bf16_t* w13 = (bf16_t*)(p.ws + WS_W13T) + (size_t)e * 1024 * 1024; bf16_t* w2 = (bf16_t*)(p.ws + WS_W2T) + (size_t)e * 1024 * 512;
            if (r < I13) { transpose_item<2>(p.in[I_WE1] + (size_t)e * 1024 * 512, 1024, 512, w13, scr, r, lane); continue; } r -= I13;
            if (r < I13) { transpose_item<3>(p.in[I_WE3] + (size_t)e * 1024 * 512, 1024, 512, w13, scr, r, lane); continue; } r -= I13;
            transpose_item<0>(p.in[I_WE2] + (size_t)e * 512 * 1024, 512, 1024, w2, scr, r, lane);
        }
    }
}

__device__ __forceinline__ void phase8(const Params& p, LAS unsigned char* lds, int tid, int wave, int lane) {
    const int G = gridDim.x, gw = blockIdx.x * NWAVES + wave, NGW = G * NWAVES;
    LAS int* poff = (LAS int*)lds;
    if (tid == 0) { const int* gc = (const int*)(p.ws + WS_CTL); int off = 0;
        for (int e = 0; e < 32; ++e) { const int c = gc[e]; poff[e] = off; poff[32 + e] = c; off += ((c + 255) >> 8) << 8; }
        poff[64] = off >> 8; }
    __syncthreads();
    const int ntiles = poff[64];
    if (blockIdx.x == 0) {
        int* te = (int*)(p.ws + WS_TILEEXP);
        for (int t = tid; t < 288; t += NTHREADS) { int ex = 31; for (int e = 0; e < 32; ++e) { const int c = poff[32 + e]; const int pe = poff[e] + (((c + 255) >> 8) << 8); if (t * 256 < pe) { ex = e; break; } } te[t] = ex; }
        if (tid == 0) ((int*)(p.ws + WS_CTL))[64] = ntiles;
    }
    const int* rec = (const int*)(p.ws + WS_TOKREC); const int* base = (const int*)(p.ws + WS_BASE);
    const bf16_t* U2 = (const bf16_t*)(p.ws + WS_U2); bf16_t* Xs = (bf16_t*)(p.ws + WS_XS); int* ts = (int*)(p.ws + WS_TOKSLOT);
    {
        int E0 = 0, E1 = 0, lr0 = 0, lr1 = 0, w0b = 0, w1b = 0, blk = 0; u32x4 ua = (u32x4){0u, 0u, 0u, 0u}, uc = ua;
        if (gw < NLAT) { const int* rr = rec + (size_t)gw * 8; E0 = rr[0]; E1 = rr[1]; lr0 = rr[2]; lr1 = rr[3]; w0b = rr[4]; w1b = rr[5]; blk = rr[6];
            const u32x4* src = (const u32x4*)(U2 + (size_t)gw * D); ua = ld_nt(src + lane); uc = ld_nt(src + lane + 64); }
        for (int R = gw; R < NLAT; R += NGW) {
            const int Rn = R + NGW; int nE0 = 0, nE1 = 0, nlr0 = 0, nlr1 = 0, nw0 = 0, nw1 = 0, nblk = 0; u32x4 na = ua, nc = uc;
            if (Rn < NLAT) { const int* rr = rec + (size_t)Rn * 8; nE0 = rr[0]; nE1 = rr[1]; nlr0 = rr[2]; nlr1 = rr[3]; nw0 = rr[4]; nw1 = rr[5]; nblk = rr[6];
                const u32x4* src = (const u32x4*)(U2 + (size_t)Rn * D); na = ld_nt(src + lane); nc = ld_nt(src + lane + 64); }
            const int s0 = poff[E0] + base[blk * 32 + E0] + lr0, s1 = poff[E1] + base[blk * 32 + E1] + lr1;
            u32x4* d0 = (u32x4*)(Xs + (size_t)s0 * D); u32x4* d1 = (u32x4*)(Xs + (size_t)s1 * D);
            d0[lane] = ua; d0[lane + 64] = uc; d1[lane] = ua; d1[lane + 64] = uc;
            if (lane == 0) { int* t4 = ts + (size_t)R * 4; t4[0] = s0; t4[1] = s1; t4[2] = w0b; t4[3] = w1b; }
            E0 = nE0; E1 = nE1; lr0 = nlr0; lr1 = nlr1; w0b = nw0; w1b = nw1; blk = nblk; ua = na; uc = nc;
        }
    }
    for (int e = 0; e < 32; ++e) { const int c = poff[32 + e]; const int lo = poff[e] + c, hi = poff[e] + (((c + 255) >> 8) << 8);
        for (int r = lo + gw; r < hi; r += NGW) { u32x4* d = (u32x4*)(Xs + (size_t)r * D); d[lane] = (u32x4){0u, 0u, 0u, 0u}; d[lane + 64] = (u32x4){0u, 0u, 0u, 0u}; } }
}

struct SchedMoe { int G, c; const int* tile_exp; int ntiles, rep; __device__ __forceinline__ void a_ready(const Unit&) const {} __device__ __forceinline__ void done(const Unit&) const {}
    __device__ __forceinline__ bool next(int i, Unit& u) const {
        const int x = c & 7, y = c >> 3, nxc = G >> 3; int q = i * nxc + y; const int t0 = (x * ntiles) >> 3, t1 = ((x + 1) * ntiles) >> 3, ntot = (t1 - t0) * 4; if (q >= rep * ntot) return false; q %= ntot;
        const int t = t0 + (q >> 2); u.pm = t; u.pn = tile_exp[t] * 4 + (q & 3); return true; } };
struct EpiH {
    static constexpr bool PERM = true, AFTER_DRAIN = false;
    bf16_t* Hs;
    __device__ __forceinline__ void operator()(const f32x4 (&acc)[2][2][4][2], const Unit& u, int wr, int wc, int fr, int fq) const {
        const int j = u.pn & 3;
#pragma unroll
        for (int ai = 0; ai < 2; ++ai)
#pragma unroll
            for (int m = 0; m < 4; ++m) { const int r = u.pm * 256 + ai * 128 + wr * 64 + m * 16 + fr; float o[8];
#pragma unroll
                for (int k = 0; k < 8; ++k) o[k] = silu_f(acc[ai][0][m][k >> 2][k & 3]) * acc[ai][1][m][k >> 2][k & 3];
                *(u32x4*)(Hs + (size_t)r * DE + j * 128 + wc * 32 + 8 * fq) = (u32x4){pk2(o[0], o[1]), pk2(o[2], o[3]), pk2(o[4], o[5]), pk2(o[6], o[7])}; }
    }
};
struct EpiYs {
    static constexpr bool PERM = true, AFTER_DRAIN = false;
    bf16_t* Ys;
    __device__ __forceinline__ void operator()(const f32x4 (&acc)[2][2][4][2], const Unit& u, int wr, int wc, int fr, int fq) const {
        const int j = u.pn & 3;
#pragma unroll
        for (int ai = 0; ai < 2; ++ai)
#pragma unroll
            for (int m = 0; m < 4; ++m) { const int r = u.pm * 256 + ai * 128 + wr * 64 + m * 16 + fr;
#pragma unroll
                for (int bj = 0; bj < 2; ++bj) { const f32x4 v0 = acc[ai][bj][m][0], v1 = acc[ai][bj][m][1];
                    *(u32x4*)(Ys + (size_t)r * D + j * 256 + bj * 128 + wc * 32 + 8 * fq) = (u32x4){pk2(v0[0], v0[1]), pk2(v0[2], v0[3]), pk2(v1[0], v1[1]), pk2(v1[2], v1[3])}; } }
    }
};

__device__ __forceinline__ void phase11(const Params& p, int wave, int lane) {
    const int gw = blockIdx.x * NWAVES + wave, NGW = gridDim.x * NWAVES;
    const float* MOD = (const float*)(p.ws + WS_MOD); const bf16_t* Ys = (const bf16_t*)(p.ws + WS_YS); const int* ts = (const int*)(p.ws + WS_TOKSLOT);
    const float* g2 = p.in[I_LN2G]; const float* b2 = p.in[I_LN2B];
    f32x4 x1[4], nx1[4]; u32x2 ya[4], yc[4], nya[4], nyc[4]; float w0 = 0.f, w1 = 0.f, nw0 = 0.f, nw1 = 0.f;
    if (gw < NLAT) { const int* t4 = ts + (size_t)gw * 4; const int s0 = t4[0], s1 = t4[1]; w0 = __int_as_float(t4[2]); w1 = __int_as_float(t4[3]);
#pragma unroll
        for (int j = 0; j < 4; ++j) { x1[j] = ld_nt((const f32x4*)(p.out + (size_t)gw * D) + lane + 64 * j); ya[j] = ld_nt((const u32x2*)(Ys + (size_t)s0 * D) + lane + 64 * j); yc[j] = ld_nt((const u32x2*)(Ys + (size_t)s1 * D) + lane + 64 * j); } }
    for (int R = gw; R < NLAT; R += NGW) {
        const int Rn = R + NGW;
        if (Rn < NLAT) { const int* t4 = ts + (size_t)Rn * 4; const int s0 = t4[0], s1 = t4[1]; nw0 = __int_as_float(t4[2]); nw1 = __int_as_float(t4[3]);
#pragma unroll
            for (int j = 0; j < 4; ++j) { nx1[j] = ld_nt((const f32x4*)(p.out + (size_t)Rn * D) + lane + 64 * j); nya[j] = ld_nt((const u32x2*)(Ys + (size_t)s0 * D) + lane + 64 * j); nyc[j] = ld_nt((const u32x2*)(Ys + (size_t)s1 * D) + lane + 64 * j); } }
        const int b = R >> 11; float* xr = p.out + (size_t)R * D; const float* gg = MOD + (size_t)b * 6144 + 5120;
        f32x4 v[4]; float s = 0.f;
#pragma unroll
        for (int j = 0; j < 4; ++j) { const int col = 4 * lane + 256 * j; const u32x2 a = ya[j], c = yc[j];
            f32x4 f; f.x = w0 * bflo(a.x) + w1 * bflo(c.x); f.y = w0 * bfhi(a.x) + w1 * bfhi(c.x); f.z = w0 * bflo(a.y) + w1 * bflo(c.y); f.w = w0 * bfhi(a.y) + w1 * bfhi(c.y);
            v[j] = x1[j] * DN_ALPHA + *(const f32x4*)(gg + col) * f; s += (v[j].x + v[j].y) + (v[j].z + v[j].w); }
        const float mean = wave_sum(s) * (1.f / D); float s2 = 0.f;
#pragma unroll
        for (int j = 0; j < 4; ++j) { v[j] = v[j] - mean; s2 += (v[j].x * v[j].x + v[j].y * v[j].y) + (v[j].z * v[j].z + v[j].w * v[j].w); }
        const float rstd = 1.f / sqrtf(wave_sum(s2) * (1.f / D) + LN_EPS);
#pragma unroll
        for (int j = 0; j < 4; ++j) { const int col = 4 * lane + 256 * j; st_nt((f32x4*)xr + lane + 64 * j, v[j] * rstd * *(const f32x4*)(g2 + col) + *(const f32x4*)(b2 + col)); }
#pragma unroll
        for (int j = 0; j < 4; ++j) { x1[j] = nx1[j]; ya[j] = nya[j]; yc[j] = nyc[j]; }
        w0 = nw0; w1 = nw1;
    }
}

#define XB_TMO      128
#define XB_XCNT(j)  (256  + 64 * (j))
#define XB_XSUB(j)  (1280 + 64 * (j))
#define XB_XGEN(j)  (2304 + 64 * (j))
#define XB_TOP      3328
#define XB_TOPGEN   3392
#define XCD_BAR_WORDS 3456
#define XB_SPIN_CAP (1u << 18)

__device__ __forceinline__ unsigned xb_ld(unsigned* p)              { return __hip_atomic_load(p, __ATOMIC_RELAXED, __HIP_MEMORY_SCOPE_AGENT); }
__device__ __forceinline__ unsigned xb_add(unsigned* p, unsigned v) { return __hip_atomic_fetch_add(p, v, __ATOMIC_RELAXED, __HIP_MEMORY_SCOPE_AGENT); }
__device__ __forceinline__ unsigned xb_xcc_id() { return (unsigned)__builtin_amdgcn_s_getreg((3 << 11) | 20) & 0xFu; }
#define XB_SPIN(cond, bar) do { unsigned _sp = 0; while (cond) { __builtin_amdgcn_s_sleep(1); \
    if ((++_sp & 255u) == 0u) { if (xb_ld(&(bar)[XB_TMO])) break; if (_sp > XB_SPIN_CAP) { atomicAdd(&(bar)[XB_TMO], 1u); break; } } } } while (0)

struct XcdBarrier {
    unsigned* bar; unsigned x;
    volatile LAS unsigned* st;
};

__device__ __forceinline__ XcdBarrier xcd_barrier_post(unsigned* bar, volatile LAS unsigned* st) {
    XcdBarrier b; b.bar = bar; b.x = xb_xcc_id(); b.st = st;
    if (threadIdx.x == 0) (void)xb_add(&bar[XB_XCNT(b.x)], 1u);
    return b;
}
__device__ __forceinline__ void xcd_barrier_complete(unsigned* bar, unsigned x, unsigned& nloc, unsigned& nx) {
    const unsigned G = gridDim.x * gridDim.y * gridDim.z;
    unsigned sum, cnt, mine, sp = 0u;
    for (;;) {
        sum = 0u; cnt = 0u; mine = 0u;
#pragma unroll
        for (unsigned j = 0; j < 16; ++j) { const unsigned c = xb_ld(&bar[XB_XCNT(j)]); sum += c; cnt += (c > 0u) ? 1u : 0u; mine = (j == x) ? c : mine; }
        if (sum == G) break;
        __builtin_amdgcn_s_sleep(1);
        if ((++sp & 255u) == 0u) { if (xb_ld(&bar[XB_TMO])) break; if (sp > XB_SPIN_CAP) { atomicAdd(&bar[XB_TMO], 1u); break; } }
    }
    nloc = mine > 0u ? mine : 1u; nx = cnt > 0u ? cnt : 1u;
}

__device__ __forceinline__ void xcd_barrier(const XcdBarrier& b) {
    asm volatile("s_waitcnt vmcnt(0)" ::: "memory");
    __syncthreads();
    if (threadIdx.x == 0) {
        unsigned* bar = b.bar;
        __builtin_amdgcn_s_waitcnt(0);
        unsigned nloc = b.st[0], nx = b.st[1];
        if (nloc == 0u) { xcd_barrier_complete(bar, b.x, nloc, nx); b.st[0] = nloc; b.st[1] = nx; }
        const unsigned old = xb_add(&bar[XB_XSUB(b.x)], 1u);
        const unsigned gen = old / nloc;
        if (old + 1u == (gen + 1u) * nloc) {
            __builtin_amdgcn_fence(__ATOMIC_RELEASE, "agent");
            asm volatile("s_waitcnt vmcnt(0)" ::: "memory");
            const unsigned og = xb_add(&bar[XB_TOP], 1u);
            const unsigned tg = og / nx;
            if (og + 1u == (tg + 1u) * nx) xb_add(&bar[XB_TOPGEN], 1u);
            else XB_SPIN(xb_ld(&bar[XB_TOPGEN]) == tg, bar);
            __builtin_amdgcn_fence(__ATOMIC_ACQUIRE, "agent");
            xb_add(&bar[XB_XGEN(b.x)], 1u);
            asm volatile("s_waitcnt vmcnt(0)" ::: "memory");
        } else {
            XB_SPIN(xb_ld(&bar[XB_XGEN(b.x)]) == gen, bar);
            __builtin_amdgcn_fence(__ATOMIC_ACQUIRE, "agent");
            asm volatile("s_waitcnt vmcnt(0)" ::: "memory");
        }
    }
    __syncthreads();
}

#ifdef USE_SIMPLE_GEMM
#define GEMM_CALL(g, S, E) gemm_simple(g, S, E)
#else
#define GEMM_CALL(g, S, E) pg8::gemm_phase<decltype(E), decltype(S), true, true>(lds, g, S, E)
#endif
#ifdef USE_SIMPLE_SCAN
#define SCAN_CALL scan_phase
#else
#ifdef USE_SCAN2
#define SCAN_CALL scan_phase2
#else
#define SCAN_CALL scan_phase3<0>
#endif
#endif
constexpr int NPHASE = 15;
__global__ void __launch_bounds__(NTHREADS) mega(Params p) {
    extern __shared__ __attribute__((aligned(16))) unsigned char lds_raw[];
    LAS unsigned char* lds = (LAS unsigned char*)lds_raw;
    cg::grid_group grid = cg::this_grid();
    const int tid = threadIdx.x, lane = tid & 63, wave = __builtin_amdgcn_readfirstlane(tid >> 6);
    unsigned char* ws = p.ws;
    const int G = gridDim.x, c = blockIdx.x;
    volatile LAS unsigned* xst = (volatile LAS unsigned*)(lds + LDS_BYTES - 16);
    if (tid < 2) xst[tid] = 0u;
    __syncthreads();
    XcdBarrier xbar; xbar.bar = (unsigned*)(ws + WS_BAR); xbar.x = 0; xbar.st = xst;
#ifndef PHMASK
#define PHMASK 0x7fff
#endif
#define IN(k) (((PHMASK >> (k)) & 1) && p.ph_lo <= (k) && (k) < p.ph_hi)
#define GSYNC() xcd_barrier(xbar)
#define SEAM(k) do { if (IN(k) && IN((k) + 1)) { if ((k) == 0) { grid.sync(); xbar = xcd_barrier_post((unsigned*)(ws + WS_BAR), xst); } else GSYNC(); } } while (0)
#ifndef REPMASK
#define REPMASK 0
#endif
#ifndef REPN
#define REPN 2
#endif
#define GEMMPH ((1 << 2) | (1 << 4) | (1 << 7) | (1 << 9) | (1 << 10) | (1 << 13))
#define GREP(k) ((((REPMASK) >> (k)) & 1) ? REPN : 1)
#define PHASE(k) for (int rep_ = 0; rep_ < (IN(k) ? (((((REPMASK) & ~GEMMPH) >> (k)) & 1) ? REPN : 1) : 0); ++rep_) if (rep_ ? (GSYNC(), true) : true)
    PHASE(0) phase0(p, lds, tid, wave, lane);
    SEAM(0);
    PHASE(1) phase1(p, wave, lane);
    SEAM(1);
    PHASE(2) { Gemm g{(const bf16_t*)(ws + WS_U), (const bf16_t*)(ws + WS_WT_IN), NROW, IN_PHYS, D}; SchedProj<0> S{G, c, GREP(2)}; EpiProj E{ws, p.in[I_BMG], lds, p.in[I_CONVW], p.in[I_CONVB]}; GEMM_CALL(g, S, E); }
    SEAM(2);
    PHASE(3) { ScanArgs a{(const bf16_t*)(ws + WS_RQ), (const bf16_t*)(ws + WS_RK), (const bf16_t*)(ws + WS_RVT), (const float*)(ws + WS_G), p.in[I_DECAY], (bf16_t*)p.out, (bf16_t*)p.out + (size_t)NLAT * D, 0}; SCAN_CALL(lds, a, tid, wave, lane); }
#ifdef SCANPROBE
    if (IN(3)) { GSYNC(); ScanArgs a{(const bf16_t*)(ws + WS_RQ), (const bf16_t*)(ws + WS_RK), (const bf16_t*)(ws + WS_RVT), (const float*)(ws + WS_G), p.in[I_DECAY], (bf16_t*)(ws + WS_X0), (bf16_t*)(ws + WS_X0 + 64 * MiB), 0}; scan_phase3<SCANPROBE>(lds, a, tid, wave, lane); }
#endif
    SEAM(3);
    PHASE(4) { Gemm g{(const bf16_t*)(ws + WS_U), (const bf16_t*)(ws + WS_WT_IN), NROW, IN_PHYS, D}; SchedProj<1> S{G, c, GREP(4)};
        const int pnl = ((((c >> 3) + 6) & 7) >> 1);
        { LAS float* WL = (LAS float*)(lds + 139264); const float* cwp = p.in[I_CONVW]; const float* cbp = p.in[I_CONVB];
          for (int i = tid; i < 2048; i += NTHREADS) { const int sl = i >> 10, k = (i >> 8) & 3, col = i & 255, cg0 = sl * 1024 + pnl * 256;
              WL[i] = ((k < 3) ? cwp[k * 2048 + cg0 + col] : cbp[cg0 + col]) * (sl ? 0.0625f : 1.f); }
          __syncthreads(); }
        EpiProj E{ws, p.in[I_BMG], lds, p.in[I_CONVW], p.in[I_CONVB], pnl}; GEMM_CALL(g, S, E); }
    if (IN(4) && IN(6)) GSYNC();
    PHASE(6) { ScanArgs a{(const bf16_t*)(ws + WS_MQ), (const bf16_t*)(ws + WS_MK), (const bf16_t*)(ws + WS_MVT), (const float*)(ws + WS_G), p.in[I_DECAY], (bf16_t*)(ws + WS_OMF), (bf16_t*)(ws + WS_OMB), 1}; SCAN_CALL(lds, a, tid, wave, lane); }
    SEAM(6);
    PHASE(7) { Gemm g{(const bf16_t*)(ws + WS_U), (const bf16_t*)(ws + WS_WT_IN), NROW, IN_PHYS, D}; SchedProj<2> S{G, c, GREP(7)}; EpiProj E{ws, p.in[I_BMG], lds, p.in[I_CONVW], p.in[I_CONVB]}; GEMM_CALL(g, S, E); }
    SEAM(7);
    PHASE(8) {
        phase4_one<0>((const bf16_t*)p.out, (const bf16_t*)p.out + (size_t)NLAT * D, (const bf16_t*)(ws + WS_RGA), (bf16_t*)p.out, wave, lane);
        phase4_one<1>((const bf16_t*)(ws + WS_OMF), (const bf16_t*)(ws + WS_OMB), (const bf16_t*)(ws + WS_MOA), (bf16_t*)(ws + WS_M), wave, lane);
    }
    SEAM(8);
    PHASE(9) {
        SchedDense S{G, c, 128, 4, 1}; SchedDense S1{G, c, 128, 4, GREP(9)};
        { Gemm g{(const bf16_t*)p.out, (const bf16_t*)(ws + WS_WT_R), NLAT, D, D}; EpiY E{(bf16_t*)(ws + WS_Y), (const bf16_t*)(ws + WS_GRA), 0}; GEMM_CALL(g, S1, E); }
        { Gemm g{(const bf16_t*)(ws + WS_M), (const bf16_t*)(ws + WS_WT_M), NLAT, D, D}; EpiY E{(bf16_t*)(ws + WS_Y), (const bf16_t*)(ws + WS_GMA), 1}; GEMM_CALL(g, S, E); }
    }
    SEAM(9);
    PHASE(10) { SchedDense S{G, c, 128, 4, GREP(10)}; Gemm g{(const bf16_t*)(ws + WS_Y), (const bf16_t*)(ws + WS_WT_O), NLAT, D, D}; EpiY2 E{(bf16_t*)(ws + WS_Y2)}; GEMM_CALL(g, S, E); }
    SEAM(10);
    PHASE(11) phase7(p, lds, tid, wave, lane);
    SEAM(11);
    PHASE(12) phase8(p, lds, tid, wave, lane);
    SEAM(12);
    PHASE(13) {
        const int ntiles = ((const int*)(ws + WS_CTL))[64];
        SchedMoe S{G, c, (const int*)(ws + WS_TILEEXP), ntiles, GREP(13)};
        Gemm g{(const bf16_t*)(ws + WS_XS), (const bf16_t*)(ws + WS_W13T), MAXSLOT, 32 * 1024, D}; EpiH E{(bf16_t*)(ws + WS_HS)}; GEMM_CALL(g, S, E);
        GSYNC();
        Gemm g2{(const bf16_t*)(ws + WS_HS), (const bf16_t*)(ws + WS_W2T), MAXSLOT, 32 * 1024, DE}; EpiYs E2{(bf16_t*)(ws + WS_YS)}; GEMM_CALL(g2, S, E2);
    }
    SEAM(13);
    PHASE(14) phase11(p, wave, lane);
#undef IN
#undef SEAM
}

extern "C" void kernel_launch(void* const* d_in, const int* in_sizes, int n_in, void* d_out, int out_size, void* d_ws, size_t ws_size, hipStream_t stream) {
    static int grid = 0;
    if (grid == 0) {
        if (n_in != 25 || out_size != NLAT * D || ws_size < WS_NEED) { fprintf(stderr, "kernel_launch: unexpected shapes n_in %d out %d ws %zu; nothing launched\n", n_in, out_size, ws_size); grid = -1; return; }
        int dev = 0, cus = 0, per_cu = 0;
        if (hipGetDevice(&dev) != hipSuccess || hipDeviceGetAttribute(&cus, hipDeviceAttributeMultiprocessorCount, dev) != hipSuccess) { grid = -1; return; }
        if (hipFuncSetAttribute((const void*)mega, hipFuncAttributeMaxDynamicSharedMemorySize, LDS_BYTES) != hipSuccess) { fprintf(stderr, "kernel_launch: hipFuncSetAttribute failed\n"); grid = -1; return; }
        if (hipOccupancyMaxActiveBlocksPerMultiprocessor(&per_cu, (const void*)mega, NTHREADS, LDS_BYTES) != hipSuccess || per_cu < 1) { fprintf(stderr, "kernel_launch: occupancy query says %d\n", per_cu); per_cu = 1; }
        (void)hipGetLastError();
        grid = cus * 1;
        (void)per_cu;
    }
    if (grid < 0) return;
    Params p{};
    for (int i = 0; i < 25; ++i) p.in[i] = (const float*)d_in[i];
    p.out = (float*)d_out; p.ws = (unsigned char*)d_ws; p.ph_lo = 0; p.ph_hi = NPHASE;
    void* args[] = {&p};
    hipError_t e = hipLaunchCooperativeKernel((const void*)mega, dim3(grid), dim3(NTHREADS), args, LDS_BYTES, stream);
    if (e != hipSuccess) fprintf(stderr, "kernel_launch: cooperative launch failed: %s (grid %d)\n", hipGetErrorString(e), grid);
}
```

```cpp
#include <hip/hip_runtime.h>
#include <hip/hip_cooperative_groups.h>
#include <cstdio>
#include <cstdint>
namespace cg = cooperative_groups;

#define LAS __attribute__((address_space(3)))
typedef unsigned short bf16_t;
typedef short bf16x8 __attribute__((ext_vector_type(8)));
typedef float f32x4 __attribute__((ext_vector_type(4)));
typedef float f32x2 __attribute__((ext_vector_type(2)));
typedef unsigned u32x4 __attribute__((ext_vector_type(4)));
typedef unsigned u32x2 __attribute__((ext_vector_type(2)));
typedef __bf16 bf16x2_t __attribute__((ext_vector_type(2)));

constexpr int D = 1024, NB = 16, T = 2048, TC = 256, TT = T + TC;
constexpr int NROW = NB * TT;
constexpr int NLAT = NB * T;
constexpr int NH = 4, DH = 256;
constexpr int IN_COLS = 10256, IN_PHYS = 10496;
constexpr int NE = 32, DE = 512;
constexpr int CH = 64;
constexpr float LN_EPS = 1e-5f;
constexpr float DN_ALPHA = 1.189207115002721f;
constexpr int MAXSLOT = 73728;

constexpr size_t MiB = 1u << 20;
constexpr size_t WS_CTL = 0;
constexpr size_t WS_BAR = 16384;
constexpr size_t WS_WT_IN = 1 * MiB;
constexpr size_t WS_WT_R = 22 * MiB, WS_WT_M = 24 * MiB, WS_WT_O = 26 * MiB;
constexpr size_t WS_MOD = 28 * MiB;
constexpr size_t WS_ROT = 29 * MiB;
constexpr size_t WS_G = 30 * MiB;
constexpr size_t WS_WRT = 33 * MiB;
constexpr size_t WS_TOKREC = 34 * MiB;
constexpr size_t WS_TOKSLOT = 35 * MiB;
constexpr size_t WS_TILEEXP = 36 * MiB;
constexpr size_t WS_BASE = 37 * MiB;
constexpr size_t WS_U = 40 * MiB;
constexpr size_t WS_HS = 40 * MiB;
constexpr size_t WS_X0 = 112 * MiB;
constexpr size_t WS_RQ = 296 * MiB, WS_RK = 368 * MiB, WS_RVT = 440 * MiB;
constexpr size_t WS_MVT = 296 * MiB, WS_MQRAW = 112 * MiB, WS_MKRAW = 184 * MiB;
constexpr size_t WS_MQ = 368 * MiB, WS_MK = 440 * MiB;
constexpr size_t WS_OMF = 112 * MiB, WS_OMB = 176 * MiB;
constexpr size_t WS_RGA = 240 * MiB, WS_MOA = 304 * MiB, WS_GRA = 368 * MiB, WS_GMA = 432 * MiB;
constexpr size_t WS_M = 112 * MiB;
constexpr size_t WS_Y = 176 * MiB;
constexpr size_t WS_Y2 = 112 * MiB;
constexpr size_t WS_U2 = 176 * MiB;
constexpr size_t WS_W13T = 240 * MiB;
constexpr size_t WS_W2T = 304 * MiB;
constexpr size_t WS_XS = 336 * MiB;
constexpr size_t WS_YS = 336 * MiB;
constexpr size_t WS_NEED = 512 * MiB;

constexpr int LDS_BYTES = 163840;
constexpr int NTHREADS = 512, NWAVES = 8;

struct Params { const float* in[25]; float* out; unsigned char* ws; int ph_lo, ph_hi; };
enum { I_X = 0, I_C, I_CTX, I_CCTX, I_WADA, I_BADA, I_WIN, I_BMG, I_CONVW, I_CONVB, I_DECAY, I_WRB, I_WMB, I_WOUT, I_LN1G, I_LN1B,
       I_WRG, I_BRG, I_WRE, I_BRE, I_WE1, I_WE3, I_WE2, I_LN2G, I_LN2B };

__device__ __forceinline__ unsigned pk2(float lo, float hi) { f32x2 v = {lo, hi}; bf16x2_t b = __builtin_convertvector(v, bf16x2_t); return __builtin_bit_cast(unsigned, b); }
__device__ __forceinline__ float bflo(unsigned w) { return __uint_as_float(w << 16); }
__device__ __forceinline__ float bfhi(unsigned w) { return __uint_as_float(w & 0xffff0000u); }
__device__ __forceinline__ float bf2f(bf16_t h) { return __uint_as_float(((unsigned)h) << 16); }
__device__ __forceinline__ bf16_t f2bf(float f) { return (bf16_t)(pk2(f, 0.f) & 0xffffu); }
template <int CTRL, int RMASK> __device__ __forceinline__ float dpp_add(float v) {
    return v + __builtin_bit_cast(float, __builtin_amdgcn_update_dpp(0, __builtin_bit_cast(int, v), CTRL, RMASK, 0xF, false)); }
__device__ __forceinline__ float row_sum16(float v) {
    v = dpp_add<0xB1, 0xF>(v);
    v = dpp_add<0x4E, 0xF>(v);
    v = dpp_add<0x141, 0xF>(v);
    v = dpp_add<0x140, 0xF>(v);
    return v;
}
__device__ __forceinline__ float wave_sum(float v) {
    v = row_sum16(v);
    v = dpp_add<0x142, 0xA>(v);
    v = dpp_add<0x143, 0xC>(v);
    return __builtin_bit_cast(float, __builtin_amdgcn_readlane(__builtin_bit_cast(int, v), 63));
}
__device__ __forceinline__ float half_sum(float v) {
    v = row_sum16(v);
    v = dpp_add<0x142, 0xA>(v);
    const float lo = __builtin_bit_cast(float, __builtin_amdgcn_readlane(__builtin_bit_cast(int, v), 31)), hi = __builtin_bit_cast(float, __builtin_amdgcn_readlane(__builtin_bit_cast(int, v), 63));
    return ((threadIdx.x & 32) ? hi : lo);
}
template <class T> __device__ __forceinline__ T ld_nt(const T* p) { return __builtin_nontemporal_load(p); }
template <class T> __device__ __forceinline__ void st_nt(T* p, const T& v) { __builtin_nontemporal_store(v, p); }
__device__ __forceinline__ void lds_stage(LAS float* dst, const float* src, int rows, int rv4, int sstride, int tid) {
    const int n4 = rows * rv4;
    for (int base = 0; base < n4; base += 8 * NTHREADS) {
        f32x4 t[8];
#pragma unroll
        for (int j = 0; j < 8; ++j) { const int i = base + j * NTHREADS + tid; const int r = i / rv4, c = i - r * rv4; t[j] = (i < n4) ? *(const f32x4*)(src + (size_t)r * sstride + 4 * c) : (f32x4){0.f, 0.f, 0.f, 0.f}; }
#pragma unroll
        for (int j = 0; j < 8; ++j) { const int i = base + j * NTHREADS + tid; if (i < n4) *(LAS f32x4*)(dst + 4 * i) = t[j]; }
    }
}
__device__ __forceinline__ float silu_f(float x) { return x * __builtin_amdgcn_rcpf(1.f + __expf(-x)); }
__device__ __forceinline__ float sigmoid_f(float x) { return __builtin_amdgcn_rcpf(1.f + __expf(-x)); }
__device__ __forceinline__ float logsigmoid_f(float x) { return fminf(x, 0.f) - __logf(1.f + __expf(-fabsf(x))); }
#define MFMA16(a, b, c) __builtin_amdgcn_mfma_f32_16x16x32_bf16((a), (b), (c), 0, 0, 0)

template <int MODE> __device__ __forceinline__ int rowmap(int n) {
    if (MODE == 0) return n;
    if (MODE == 1) {
        if (n < 2048) { const int blk = n >> 10, w = n & 1023, h = w >> 8, dd = w & 255, hb = dd >> 7, part = (dd >> 6) & 1, i = dd & 63; return blk * 1024 + h * 256 + part * 128 + hb * 64 + i; }
        if (n < 8192) return n;
        if (n < 8208) return 10240 + (n - 8192);
        return n - 16;
    }
    if (MODE == 2) return (n >> 7) * 256 + (n & 127);
    return (n >> 7) * 256 + 128 + (n & 127);
}
template <int MODE> __device__ __forceinline__ void transpose_item(const float* W, int K, int N, bf16_t* WT, LAS float* scr, int item, int lane) {
    const int nblk = (N + 31) / 32, kb = item / nblk, nb = item % nblk, k0 = 64 * kb, n0 = 32 * nb;
    const int r8 = lane >> 3, c4 = (lane & 7) * 4, nn = n0 + c4;
    f32x4 tv[8];
#pragma unroll
    for (int i = 0; i < 8; ++i) tv[i] = (nn < N) ? ld_nt((const f32x4*)(W + (size_t)(k0 + 8 * i + r8) * N + nn)) : (f32x4){0.f, 0.f, 0.f, 0.f};
#pragma unroll
    for (int i = 0; i < 8; ++i) { LAS float* d = scr + (8 * i + r8) * 33 + c4; d[0] = tv[i].x; d[1] = tv[i].y; d[2] = tv[i].z; d[3] = tv[i].w; }
    asm volatile("s_waitcnt lgkmcnt(0)" ::: "memory");
    const int c = lane & 7;
#pragma unroll
    for (int j = 0; j < 4; ++j) { const int n = (lane >> 3) + 8 * j; const LAS float* s = scr + (8 * c) * 33 + n;
        u32x4 o; o.x = pk2(s[0 * 33], s[1 * 33]); o.y = pk2(s[2 * 33], s[3 * 33]); o.z = pk2(s[4 * 33], s[5 * 33]); o.w = pk2(s[6 * 33], s[7 * 33]);
        if (n0 + n < N) *(u32x4*)(WT + (size_t)rowmap<MODE>(n0 + n) * K + k0 + 8 * c) = o; }
    asm volatile("s_waitcnt lgkmcnt(0)" ::: "memory");
}

template <int MODE> __device__ __forceinline__ void transpose_item64(const float* W, int K, int N, bf16_t* WT, LAS float* scr, int item, int lane) {
    const int nblk = (N + 63) / 64, kb = item / nblk, nb = item % nblk, k0 = 64 * kb, n0 = 64 * nb;
    const int r4 = lane >> 4, c4 = (lane & 15) * 4, nn = n0 + c4;
    f32x4 tv[16];
#pragma unroll
    for (int i = 0; i < 16; ++i) tv[i] = (nn < N) ? ld_nt((const f32x4*)(W + (size_t)(k0 + 4 * i + r4) * N + nn)) : (f32x4){0.f, 0.f, 0.f, 0.f};
#pragma unroll
    for (int i = 0; i < 16; ++i) { LAS float* d = scr + (4 * i + r4) * 65 + c4; d[0] = tv[i].x; d[1] = tv[i].y; d[2] = tv[i].z; d[3] = tv[i].w; }
    asm volatile("s_waitcnt lgkmcnt(0)" ::: "memory");
    const int c = lane & 7;
#pragma unroll
    for (int j = 0; j < 8; ++j) { const int n = (lane >> 3) + 8 * j; const LAS float* sp = scr + (8 * c) * 65 + n;
        u32x4 o; o.x = pk2(sp[0 * 65], sp[1 * 65]); o.y = pk2(sp[2 * 65], sp[3 * 65]); o.z = pk2(sp[4 * 65], sp[5 * 65]); o.w = pk2(sp[6 * 65], sp[7 * 65]);
        if (n0 + n < N) *(u32x4*)(WT + (size_t)rowmap<MODE>(n0 + n) * K + k0 + 8 * c) = o; }
    asm volatile("s_waitcnt lgkmcnt(0)" ::: "memory");
}

__device__ __forceinline__ void phase0(const Params& p, LAS unsigned char* lds, int tid, int wave, int lane) {
    const int G = gridDim.x, gw = blockIdx.x * NWAVES + wave, NGW = G * NWAVES;
    unsigned char* ws = p.ws;
    if (blockIdx.x == 0) { if (tid < 64) ((int*)(ws + WS_CTL))[tid] = 0; for (int i = tid; i < 3456; i += NTHREADS) ((unsigned*)(ws + WS_BAR))[i] = 0u; }
    {
        LAS float* scr = (LAS float*)(lds + wave * 16640);
        constexpr int I_IN = 16 * 161, I_SQ = 16 * 16;
        for (int it = gw; it < I_IN + 3 * I_SQ; it += NGW) {
            int r = it;
            if (r < I_IN) { transpose_item64<1>(p.in[I_WIN], 1024, IN_COLS, (bf16_t*)(ws + WS_WT_IN), scr, r, lane); continue; } r -= I_IN;
            if (r < I_SQ) { transpose_item64<0>(p.in[I_WRB], 1024, 1024, (bf16_t*)(ws + WS_WT_R), scr, r, lane); continue; } r -= I_SQ;
            if (r < I_SQ) { transpose_item64<0>(p.in[I_WMB], 1024, 1024, (bf16_t*)(ws + WS_WT_M), scr, r, lane); continue; } r -= I_SQ;
            transpose_item64<0>(p.in[I_WOUT], 1024, 1024, (bf16_t*)(ws + WS_WT_O), scr, r, lane);
        }
        u32x4* z = (u32x4*)(ws + WS_WT_IN + (size_t)10256 * 1024 * 2);
        const int nz = 240 * 1024 * 2 / 16;
        for (int i = blockIdx.x * NTHREADS + tid; i < nz; i += G * NTHREADS) z[i] = (u32x4){0u, 0u, 0u, 0u};
    }
    for (int i = blockIdx.x * NTHREADS + tid; i < 4096; i += G * NTHREADS) {
        const int pos = i >> 6, fi = i & 63; const float freq = powf(10000.f, -((float)fi / 64.f)); const float ang = (float)pos * freq;
        ((f32x2*)(ws + WS_ROT))[i] = (f32x2){cosf(ang), sinf(ang)};
    }
    for (int i = blockIdx.x * NTHREADS + tid; i < 48 * 1024; i += G * NTHREADS) {
        const int k = i / 48, o = i - k * 48;
        ((float*)(ws + WS_WRT))[i] = (o < 4) ? p.in[I_WRG][k * 4 + o] : ((o < 36) ? p.in[I_WRE][k * 32 + (o - 4)] : 0.f);
    }
    __syncthreads();
    if ((int)blockIdx.x < 96) {
        LAS float* sl = (LAS float*)lds;
        LAS float* red = (LAS float*)(lds + 17 * 1024 * 4);
        lds_stage(sl, p.in[I_C], 16, 256, 1024, tid); lds_stage(sl + 16 * 1024, p.in[I_CCTX], 1, 256, 0, tid);
        __syncthreads();
        for (int i = tid; i < 17 * 1024; i += NTHREADS) { const float v = sl[i]; sl[i] = v / (1.f + expf(-v)); }
        __syncthreads();
        for (int it = blockIdx.x; it < 96; it += G) {
            const int col = it * 64 + lane; float acc[17];
#pragma unroll
            for (int r = 0; r < 17; ++r) acc[r] = 0.f;
            const float* wp = p.in[I_WADA] + col;
#pragma unroll 1
            for (int kb = 0; kb < 2; ++kb) {
                const int k0 = wave * 128 + kb * 64; float wv[64];
#pragma unroll
                for (int kk = 0; kk < 64; ++kk) wv[kk] = wp[(size_t)(k0 + kk) * 6144];
#pragma unroll
                for (int kk = 0; kk < 64; ++kk) {
#pragma unroll
                    for (int r = 0; r < 17; ++r) acc[r] += sl[r * 1024 + k0 + kk] * wv[kk];
                    if ((kk & 3) == 3) __builtin_amdgcn_sched_barrier(0);
                }
            }
#pragma unroll
            for (int r = 0; r < 17; ++r) red[(wave * 17 + r) * 64 + lane] = acc[r];
            __syncthreads();
            for (int i = tid; i < 17 * 64; i += NTHREADS) { const int r = i >> 6, l = i & 63; float s = 0.f;
#pragma unroll
                for (int w = 0; w < 8; ++w) s += red[(w * 17 + r) * 64 + l];
                ((float*)(ws + WS_MOD))[r * 6144 + it * 64 + l] = s + p.in[I_BADA][it * 64 + l]; }
            __syncthreads();
        }
    }
}

__device__ __forceinline__ const float* p1_src(const Params& p, int R, int& mr) {
    const int b = R / TT, tt = R - b * TT;
    if (tt < TC) { mr = 16; return p.in[I_CTX] + ((size_t)b * TC + tt) * D; }
    mr = b; return p.in[I_X] + ((size_t)b * T + (tt - TC)) * D;
}
__device__ __forceinline__ void phase1(const Params& p, LAS unsigned char* lds, int tid, int wave, int lane) {
    const int gw = blockIdx.x * NWAVES + wave, NGW = gridDim.x * NWAVES;
    const float* MOD = (const float*)(p.ws + WS_MOD); bf16_t* U = (bf16_t*)(p.ws + WS_U);
    if (NGW == 2048) {
        LAS float* ml = (LAS float*)lds;
        lds_stage(ml, MOD, 17, 512, 6144, tid);
        __syncthreads();
        f32x4 v[4]; int mr = 0;
        { const float* src = p1_src(p, gw, mr);
#pragma unroll
          for (int j = 0; j < 4; ++j) v[j] = ld_nt((const f32x4*)src + lane + 64 * j); }
#pragma unroll
        for (int k = 0; k < 18; ++k) {
            const int R = gw + 2048 * k; f32x4 nx[4]; int mrn = 0;
            if (k < 17) { const float* src = p1_src(p, R + 2048, mrn);
#pragma unroll
                for (int j = 0; j < 4; ++j) nx[j] = ld_nt((const f32x4*)src + lane + 64 * j); }
            __builtin_amdgcn_sched_barrier(0);
            LAS const float* sh = ml + mr * 2048; LAS const float* sc = sh + 1024;
            float s = 0.f;
#pragma unroll
            for (int j = 0; j < 4; ++j) s += (v[j].x + v[j].y) + (v[j].z + v[j].w);
            const float mean = wave_sum(s) * (1.f / D); float s2 = 0.f;
#pragma unroll
            for (int j = 0; j < 4; ++j) { v[j] = v[j] - mean; s2 += (v[j].x * v[j].x + v[j].y * v[j].y) + (v[j].z * v[j].z + v[j].w * v[j].w); }
            const float rstd = 1.f / sqrtf(wave_sum(s2) * (1.f / D) + LN_EPS);
            u32x2* o8 = (u32x2*)(U + (size_t)R * D);
#pragma unroll
            for (int j = 0; j < 4; ++j) { const int col = 4 * lane + 256 * j; const f32x4 a = *(LAS const f32x4*)(sh + col), m = *(LAS const f32x4*)(sc + col);
                const f32x4 y = v[j] * rstd * (m + 1.f) + a; o8[lane + 64 * j] = (u32x2){pk2(y.x, y.y), pk2(y.z, y.w)}; }
            if (k < 17) {
#pragma unroll
                for (int j = 0; j < 4; ++j) v[j] = nx[j];
                mr = mrn; }
            __builtin_amdgcn_sched_barrier(0);
        }
        return;
    }
    f32x4 v[4], nx[4]; int mr = 0, mrn = 0;
    if (gw < NROW) { const float* src = p1_src(p, gw, mr);
#pragma unroll
        for (int j = 0; j < 4; ++j) v[j] = ld_nt((const f32x4*)src + lane + 64 * j); }
    for (int R = gw; R < NROW; R += NGW) {
        const int Rn = R + NGW;
        if (Rn < NROW) { const float* src = p1_src(p, Rn, mrn);
#pragma unroll
            for (int j = 0; j < 4; ++j) nx[j] = ld_nt((const f32x4*)src + lane + 64 * j); }
        const float* sh = MOD + (size_t)mr * 6144; const float* sc = sh + 1024;
        float s = 0.f;
#pragma unroll
        for (int j = 0; j < 4; ++j) s += (v[j].x + v[j].y) + (v[j].z + v[j].w);
        const float mean = wave_sum(s) * (1.f / D); float s2 = 0.f;
#pragma unroll
        for (int j = 0; j < 4; ++j) { v[j] = v[j] - mean; s2 += (v[j].x * v[j].x + v[j].y * v[j].y) + (v[j].z * v[j].z + v[j].w * v[j].w); }
        const float rstd = 1.f / sqrtf(wave_sum(s2) * (1.f / D) + LN_EPS);
        u32x2* o8 = (u32x2*)(U + (size_t)R * D);
#pragma unroll
        for (int j = 0; j < 4; ++j) { const int col = 4 * lane + 256 * j; const f32x4 a = *(const f32x4*)(sh + col), m = *(const f32x4*)(sc + col);
            const f32x4 y = v[j] * rstd * (m + 1.f) + a; o8[lane + 64 * j] = (u32x2){pk2(y.x, y.y), pk2(y.z, y.w)}; }
#pragma unroll
        for (int j = 0; j < 4; ++j) v[j] = nx[j];
        mr = mrn;
    }
}

struct Unit { int pm, pn; int aofs = 0, ovl = 0, rend = 0, seam = 0; };
struct Gemm { const bf16_t* A; const bf16_t* Bt; int M, N, K; };
template <class Epi, class Sched>
__device__ __forceinline__ void gemm_simple(const Gemm g, const Sched& S, const Epi& E) {
    const int tid = threadIdx.x, wid = __builtin_amdgcn_readfirstlane(tid >> 6), lane = tid & 63, wr = wid >> 2, wc = wid & 3, fr = lane & 15, fq = lane >> 4;
    const int K = g.K;
    Unit u;
    for (int it = 0; S.next(it, u); ++it) {
        f32x4 acc[2][2][4][2];
#pragma unroll
        for (int a = 0; a < 2; ++a)
#pragma unroll
            for (int b = 0; b < 2; ++b)
#pragma unroll
                for (int m = 0; m < 4; ++m)
#pragma unroll
                    for (int n = 0; n < 2; ++n) acc[a][b][m][n] = (f32x4){0.f, 0.f, 0.f, 0.f};
        const bf16_t* Ab = g.A + ((size_t)u.pm * 256 + wr * 64 + fr) * K + 8 * fq;
        const bf16_t* Bb = g.Bt + ((size_t)u.pn * 256 + wc * 32 + fr) * K + 8 * fq;
        for (int k0 = 0; k0 < K; k0 += 32) {
            bf16x8 At[2][4], Bf[2][2];
#pragma unroll
            for (int a = 0; a < 2; ++a)
#pragma unroll
                for (int m = 0; m < 4; ++m) At[a][m] = *(const bf16x8*)(Ab + (size_t)(a * 128 + m * 16) * K + k0);
#pragma unroll
            for (int b = 0; b < 2; ++b)
#pragma unroll
                for (int n = 0; n < 2; ++n) Bf[b][n] = *(const bf16x8*)(Bb + (size_t)(b * 128 + n * 16) * K + k0);
#pragma unroll
            for (int a = 0; a < 2; ++a)
#pragma unroll
                for (int b = 0; b < 2; ++b)
#pragma unroll
                    for (int m = 0; m < 4; ++m)
#pragma unroll
                        for (int n = 0; n < 2; ++n) acc[a][b][m][n] = MFMA16(Bf[b][n], At[a][m], acc[a][b][m][n]);
        }
        E(acc, u, wr, wc, fr, fq);
    }
}


namespace pg8 {
#define PG8_LAS LAS
constexpr int BM = 256, BK = 64, HALF = 128, HTB = HALF * BK * 2  , STAGE_BYTES = 8 * HTB, NXCD = 8, WGM = 8;

__host__ __device__ __forceinline__ int lds_byte(int r, int c) { const int st = (r >> 4) * 2 + (c >> 5), rr = r & 15, cc = c & 31, ob = rr * 64 + cc * 2; return st * 1024 + (ob ^ (((ob >> 9) & 1) << 5)); }
__host__ __device__ __forceinline__ void stage_rc(int b, int& R, int& C) { const int st = b / 1024, sb = b % 1024, swz = sb ^ (((sb >> 9) & 1) << 5); R = (st >> 1) * 16 + swz / 64; C = (st & 1) * 32 + (swz % 64) / 2; }
__host__ __device__ __forceinline__ int perm32(int rho) { const int n = rho >> 4, i = rho & 15; return 8 * (i >> 2) + 4 * n + (i & 3); }
template <class Epi, class Sched, bool ALIGN_EPI = false, bool SP2 = false>
__device__ __forceinline__ void gemm_phase(PG8_LAS unsigned char* lds, const Gemm g, const Sched& S, const Epi& E) {
    const int tid = threadIdx.x, wid = __builtin_amdgcn_readfirstlane(tid >> 6), lane = tid & 63, wr = wid >> 2, wc = wid & 3, fr = lane & 15, fq = lane >> 4;
    const int K = g.K, nt = K / BK;
    unsigned voffA[2], voffB[2];
#pragma unroll
    for (int i = 0; i < 2; ++i) { int R, C; stage_rc(tid * 16 + i * 8192, R, C); const int Rb = Epi::PERM ? ((R & ~31) + perm32(R & 31)) : R;
        voffA[i] = (unsigned)(R * K + C) * 2u; voffB[i] = (unsigned)(Rb * K + C) * 2u; }
    const size_t kstep = (size_t)(BK * 2);
    const size_t hstep = (size_t)HALF * K * 2;
    const size_t tstep = 2 * hstep;
    const unsigned ldsw = (unsigned)wid * 1024u;
    const int aoff = lds_byte(wr * 64 + fr, fq * 8), boff = lds_byte(wc * 32 + fr, fq * 8);
#define PG8_SA(b, h) (((b) * 2 + (h)) * HTB)
#define PG8_SB(b, h) ((4 + (b) * 2 + (h)) * HTB)
#define PG8_STAGE(bufoff, gbase, voff) do { _Pragma("unroll") for (int _i = 0; _i < 2; ++_i) \
        __builtin_amdgcn_global_load_lds((const unsigned*)((const char*)(gbase) + (voff)[_i]), (PG8_LAS unsigned*)(lds + (bufoff) + ldsw + _i * 8192), 16, 0, 0); } while (0)
#define PG8_LDA(dst, b, h) do { _Pragma("unroll") for (int m = 0; m < 4; ++m) _Pragma("unroll") for (int k = 0; k < 2; ++k) dst[m][k] = *(const PG8_LAS bf16x8*)(lds + PG8_SA(b, h) + aoff + m * 2048 + k * 1024); } while (0)
#define PG8_LDB(dst, b, h) do { _Pragma("unroll") for (int n = 0; n < 2; ++n) _Pragma("unroll") for (int k = 0; k < 2; ++k) dst[n][k] = *(const PG8_LAS bf16x8*)(lds + PG8_SB(b, h) + boff + n * 2048 + k * 1024); } while (0)
#define PG8_MMA(ai, bj, At, Bt) do { __builtin_amdgcn_s_setprio(1); _Pragma("unroll") for (int m = 0; m < 4; ++m) _Pragma("unroll") for (int n = 0; n < 2; ++n) _Pragma("unroll") for (int k = 0; k < 2; ++k) \
        acc[ai][bj][m][n] = __builtin_amdgcn_mfma_f32_16x16x32_bf16(Bt[n][k], At[m][k], acc[ai][bj][m][n], 0, 0, 0); __builtin_amdgcn_s_setprio(0); } while (0)
#define PG8_WAIT_V(n) asm volatile("s_waitcnt vmcnt(" #n ")" ::: "memory")
#define PG8_WAIT_L(n) asm volatile("s_waitcnt lgkmcnt(" #n ")" ::: "memory")
#define PG8_BAR __builtin_amdgcn_s_barrier()
#define PG8_SCHED __builtin_amdgcn_sched_barrier(0)
    Unit cur, nxt; int ui = 0;
    if (!S.next(0, cur)) return;
    f32x4 acc[2][2][4][2];
#pragma unroll
    for (int a = 0; a < 2; ++a)
#pragma unroll
        for (int b = 0; b < 2; ++b)
#pragma unroll
            for (int m = 0; m < 4; ++m)
#pragma unroll
                for (int n = 0; n < 2; ++n) acc[a][b][m][n] = (f32x4){0.f, 0.f, 0.f, 0.f};
    bf16x8 At[4][2], B0[2][2], B1[2][2];
    const char* cA = (const char*)g.A + (ptrdiff_t)cur.pm * (ptrdiff_t)tstep + (ptrdiff_t)cur.aofs * (ptrdiff_t)(g.K * 2); const char* cB = (const char*)g.Bt + (size_t)cur.pn * tstep;
    S.a_ready(cur);
    if constexpr (SP2) {
        PG8_STAGE(PG8_SB(0, 0), cB, voffB); PG8_STAGE(PG8_SB(0, 1), cB + hstep, voffB); PG8_STAGE(PG8_SA(0, 0), cA, voffA); PG8_STAGE(PG8_SA(0, 1), cA + hstep, voffA);
        if (wr == 1) PG8_BAR;
        PG8_WAIT_V(2); PG8_BAR;
        PG8_STAGE(PG8_SB(1, 0), cB + kstep, voffB); PG8_STAGE(PG8_SA(1, 0), cA + kstep, voffA); PG8_STAGE(PG8_SB(1, 1), cB + hstep + kstep, voffB);
        PG8_WAIT_V(6); PG8_BAR;
    } else {
        PG8_STAGE(PG8_SB(0, 0), cB, voffB); PG8_STAGE(PG8_SA(0, 0), cA, voffA); PG8_STAGE(PG8_SB(0, 1), cB + hstep, voffB); PG8_STAGE(PG8_SA(0, 1), cA + hstep, voffA);
        if (wr == 1) PG8_BAR;
        PG8_WAIT_V(4); PG8_BAR;
        PG8_STAGE(PG8_SB(1, 0), cB + kstep, voffB); PG8_STAGE(PG8_SA(1, 0), cA + kstep, voffA); PG8_STAGE(PG8_SB(1, 1), cB + hstep + kstep, voffB);
        PG8_WAIT_V(6); PG8_BAR;
    }
    for (;;) {
        const bool has_next = S.next(ui + 1, nxt);
        const char* nA = has_next ? (const char*)g.A + (ptrdiff_t)nxt.pm * (ptrdiff_t)tstep + (ptrdiff_t)nxt.aofs * (ptrdiff_t)(g.K * 2) : cA; const char* nB = has_next ? (const char*)g.Bt + (size_t)nxt.pn * tstep : cB;
        for (int t = 0; t < nt; t += 2) {
            const bool last = (t == nt - 2);
            const char* a1 = cA + (size_t)(t + 1) * kstep;
            const char* a2 = last ? nA : cA + (size_t)(t + 2) * kstep; const char* b2 = last ? nB : cB + (size_t)(t + 2) * kstep;
            const char* a3 = a2 + kstep; const char* b3 = b2 + kstep;
            if (last && has_next) S.a_ready(nxt);
            if constexpr (SP2) {
            PG8_LDB(B0, 0, 0); PG8_LDB(B1, 0, 1); PG8_SCHED; PG8_LDA(At, 0, 0); PG8_STAGE(PG8_SA(1, 1), a1 + hstep, voffA);
            PG8_WAIT_V(8); PG8_WAIT_L(0); PG8_BAR; PG8_MMA(0, 0, At, B0); PG8_MMA(0, 1, At, B1); PG8_BAR; PG8_SCHED;
            PG8_LDA(At, 0, 1); PG8_STAGE(PG8_SB(0, 0), b2, voffB); PG8_STAGE(PG8_SB(0, 1), b2 + hstep, voffB); PG8_STAGE(PG8_SA(0, 0), a2, voffA);
            PG8_WAIT_V(8); PG8_WAIT_L(0); PG8_BAR; PG8_MMA(1, 0, At, B0); PG8_MMA(1, 1, At, B1); PG8_BAR; PG8_SCHED;
            PG8_LDB(B0, 1, 0); PG8_LDB(B1, 1, 1); PG8_SCHED; PG8_LDA(At, 1, 0); PG8_STAGE(PG8_SA(0, 1), a2 + hstep, voffA);
            PG8_WAIT_V(8); PG8_WAIT_L(0); PG8_BAR; PG8_MMA(0, 0, At, B0); PG8_MMA(0, 1, At, B1); PG8_BAR; PG8_SCHED;
            PG8_LDA(At, 1, 1); PG8_STAGE(PG8_SB(1, 0), b3, voffB); PG8_STAGE(PG8_SB(1, 1), b3 + hstep, voffB); PG8_STAGE(PG8_SA(1, 0), a3, voffA);
            PG8_WAIT_V(8); PG8_WAIT_L(0); PG8_BAR; PG8_MMA(1, 0, At, B0); PG8_MMA(1, 1, At, B1); PG8_BAR; PG8_SCHED;
            } else {
            PG8_LDB(B0, 0, 0); PG8_SCHED; PG8_LDA(At, 0, 0); PG8_STAGE(PG8_SA(1, 1), a1 + hstep, voffA);
            PG8_WAIT_L(8); PG8_BAR; PG8_WAIT_L(0); PG8_MMA(0, 0, At, B0); PG8_BAR; PG8_SCHED;
            PG8_LDB(B1, 0, 1); PG8_STAGE(PG8_SB(0, 0), b2, voffB);
            PG8_BAR; PG8_WAIT_L(0); PG8_MMA(0, 1, At, B1); PG8_BAR;
            PG8_LDA(At, 0, 1); PG8_STAGE(PG8_SA(0, 0), a2, voffA);
            PG8_BAR; PG8_WAIT_L(0); PG8_MMA(1, 0, At, B0); PG8_BAR; PG8_SCHED;
            PG8_STAGE(PG8_SB(0, 1), b2 + hstep, voffB);
            PG8_WAIT_V(6); PG8_BAR; PG8_MMA(1, 1, At, B1); PG8_BAR;
            PG8_LDB(B0, 1, 0); PG8_SCHED; PG8_LDA(At, 1, 0); PG8_STAGE(PG8_SA(0, 1), a2 + hstep, voffA);
            PG8_WAIT_L(8); PG8_BAR; PG8_WAIT_L(0); PG8_MMA(0, 0, At, B0); PG8_BAR; PG8_SCHED;
            PG8_LDB(B1, 1, 1); PG8_STAGE(PG8_SB(1, 0), b3, voffB);
            PG8_BAR; PG8_WAIT_L(0); PG8_MMA(0, 1, At, B1); PG8_BAR;
            PG8_LDA(At, 1, 1); PG8_STAGE(PG8_SA(1, 0), a3, voffA);
            PG8_BAR; PG8_WAIT_L(0); PG8_MMA(1, 0, At, B0); PG8_BAR; PG8_SCHED;
            PG8_STAGE(PG8_SB(1, 1), b3 + hstep, voffB);
            PG8_WAIT_V(6); PG8_BAR; PG8_MMA(1, 1, At, B1); PG8_BAR;
            }
        }
        if constexpr (ALIGN_EPI) { if (wr == 0) PG8_BAR; }
        if constexpr (!Epi::AFTER_DRAIN) { E(acc, cur, wr, wc, fr, fq); S.done(cur); }
        if (!has_next) break;
#pragma unroll
        for (int a = 0; a < 2; ++a)
#pragma unroll
            for (int b = 0; b < 2; ++b)
#pragma unroll
                for (int m = 0; m < 4; ++m)
#pragma unroll
                    for (int n = 0; n < 2; ++n) acc[a][b][m][n] = (f32x4){0.f, 0.f, 0.f, 0.f};
        cur = nxt; cA = nA; cB = nB; ++ui;
        if constexpr (ALIGN_EPI) { if (wr == 1) PG8_BAR; }
    }
    PG8_WAIT_V(0);
    if constexpr (!ALIGN_EPI) { if (wr == 0) PG8_BAR; }
    PG8_BAR;
    if constexpr (Epi::AFTER_DRAIN) { E.fused(acc, cur, wr, wc, fr, fq, lds, wid, lane); S.done(cur); }
#undef PG8_SA
#undef PG8_SB
#undef PG8_STAGE
#undef PG8_LDA
#undef PG8_LDB
#undef PG8_MMA
#undef PG8_WAIT_V
#undef PG8_WAIT_L
#undef PG8_BAR
#undef PG8_SCHED
}
}

__device__ __forceinline__ int tile_seam(int r0) {
    if (r0 < 0) return 1;
    const int tt0 = r0 - (r0 / TT) * TT;
    return (tt0 == 0 || tt0 + 255 >= TT - 1 || (tt0 <= TC && tt0 + 255 >= TC - 1)) ? 1 : 0;
}
template <int PH> struct SchedProj {
    int G, c, rep;
    __device__ __forceinline__ void a_ready(const Unit&) const {}
    __device__ __forceinline__ void done(const Unit&) const {}
    static __device__ __forceinline__ int nlat() { return PH == 0 ? 13 : 16; }
    static __device__ __forceinline__ int nctx() { return PH == 0 ? 8 : 0; }
    __device__ __forceinline__ bool next(int i, Unit& u) const {
        const int x = c & 7, y = c >> 3, nxc = G >> 3;
        int q = i * nxc + y;
        u.aofs = 0; u.ovl = 0; u.rend = 0; u.seam = 0;
        if (PH == 1) {
            const int nk = (x < 2) ? 19 : 18;
            const int ntot = 64 + 10 + 72 + 4 * nk;
            if (q >= rep * ntot) return false;
            q %= ntot;
            if (q < 64) { const int grp = q >> 4, rem = q & 15, idx = rem >> 2, pmi = x + 8 * (grp * 4 + (rem & 3)); u.pm = (pmi >> 3) * 9 + 1 + (pmi & 7); u.pn = 24 + idx; return true; }
            q -= 64;
            if (q < 10) { const int bsel = q / 5, idx = q - bsel * 5; u.pm = (x + 8 * bsel) * 9; u.pn = (idx < 4) ? 24 + idx : 40; return true; }
            q -= 10;
            if (q < 72) { const int k = (q >> 3) * 2 + (q & 1), pi = (q & 7) >> 1, tau = x + 8 * k, b = tau / 9, j = tau - b * 9;
                u.pm = 0; u.pn = 16 + pi; u.ovl = 1; u.aofs = b * TT + TC + 254 * j - 1; u.rend = (b + 1) * TT; u.seam = tile_seam(u.aofs); return true; }
            q -= 72;
            { int k, pi; if (q < 72) { k = (q >> 3) * 2 + (q & 1); pi = (q & 7) >> 1; } else { k = 18; pi = q - 72; }
                u.pm = 0; u.pn = 20 + pi; u.ovl = 1; u.aofs = 254 * (x + 8 * k) - 1; u.rend = NROW; u.seam = tile_seam(u.aofs); return true; }
        }
        const int nl = 16 * nlat(), ntot = nl + 2 * nctx();
        if (q >= rep * ntot) return false;
        q %= ntot;
        int idx;
        if (q < nl) { const int grp = q / (4 * nlat()), rem = q - grp * 4 * nlat(); idx = rem >> 2; const int pmi = x + 8 * (grp * 4 + (rem & 3)); u.pm = (pmi >> 3) * 9 + 1 + (pmi & 7);
            if (PH == 0) u.pn = (idx < 12) ? idx : 40; else u.pn = (idx < 4) ? 12 + idx : 24 + idx;
            return true; }
        q -= nl; const int bsel = q / (nctx() > 0 ? nctx() : 1); idx = q - bsel * nctx(); u.pm = (x + 8 * bsel) * 9;
        u.pn = 4 + idx;
        return true;
    }
};
struct EpiProj {
    static constexpr bool PERM = true, AFTER_DRAIN = false;
    unsigned char* ws; const float* b_mgate; LAS unsigned char* lds; const float* cw; const float* cb; int pn_lds = -1;
    template <int CTRL> static __device__ __forceinline__ float dpp_f(float v) { return __builtin_bit_cast(float, __builtin_amdgcn_update_dpp(0, __builtin_bit_cast(int, v), CTRL, 0xF, 0xF, true)); }
    template <bool SEAM> __device__ __forceinline__ void conv_epi(const f32x4 (&acc)[2][2][4][2], const Unit& u, int wr, int wc, int fr, int fq) const {
        const int pn = u.pn;
        {
            const int blk = pn >> 2, h = pn & 3; int cw0 = wc * 32 + 8 * fq;
            asm volatile("" : "+v"(cw0));
            LAS float* XB = (LAS float*)(lds + 131072);
#pragma unroll
            for (int ai = 0; ai < 2; ++ai) { const int gm = 2 * ai + wr;
                if (fr == 0) {
#pragma unroll
                    for (int bj = 0; bj < 2; ++bj) { LAS f32x4* d = (LAS f32x4*)(XB + (gm * 2 + 0) * 256 + bj * 128 + cw0); d[0] = acc[ai][bj][0][0]; d[1] = acc[ai][bj][0][1]; } }
                if (fr == 15) {
#pragma unroll
                    for (int bj = 0; bj < 2; ++bj) { LAS f32x4* d = (LAS f32x4*)(XB + (gm * 2 + 1) * 256 + bj * 128 + cw0); d[0] = acc[ai][bj][3][0]; d[1] = acc[ai][bj][3][1]; } } }
            asm volatile("s_waitcnt lgkmcnt(0)\n\ts_barrier" ::: "memory");
            bf16_t* dst = (bf16_t*)(ws + (blk == 4 ? WS_MQ : WS_MK));
            const float scl = (blk == 5) ? 0.0625f : 1.f, nl2e = (blk == 5) ? -16.f * 1.4426950408889634f : -1.4426950408889634f;
#pragma unroll
            for (int bj = 0; bj < 2; ++bj) {
                const int cg = (blk - 4) * 1024 + h * 256 + bj * 128 + cw0;
                f32x4 w0[2], w1[2], w2[2], bs[2];
                if ((pn & 3) == pn_lds) {
                    LAS const float* WL = (LAS const float*)(lds + 139264) + (blk - 4) * 1024 + bj * 128 + cw0;
#pragma unroll
                    for (int n = 0; n < 2; ++n) { w0[n] = *(LAS const f32x4*)(WL + 4 * n); w1[n] = *(LAS const f32x4*)(WL + 256 + 4 * n); w2[n] = *(LAS const f32x4*)(WL + 512 + 4 * n); bs[n] = *(LAS const f32x4*)(WL + 768 + 4 * n); }
                } else {
#pragma unroll
                    for (int n = 0; n < 2; ++n) { w0[n] = *(const f32x4*)(cw + cg + 4 * n) * scl; w1[n] = *(const f32x4*)(cw + 2048 + cg + 4 * n) * scl; w2[n] = *(const f32x4*)(cw + 4096 + cg + 4 * n) * scl; bs[n] = *(const f32x4*)(cb + cg + 4 * n) * scl; }
                }
#pragma unroll
                for (int ai = 0; ai < 2; ++ai) { const int gm = 2 * ai + wr;
#pragma unroll
                    for (int m = 0; m < 4; ++m) {
                        __builtin_amdgcn_sched_barrier(0);
                        const int rho = 128 * ai + 64 * wr + 16 * m + fr, row = u.aofs + rho, tt = row - (row / TT) * TT;
                        const bool zp = SEAM && ((tt == 0) || (tt == TC)), zn = SEAM && ((tt == TC - 1) || (tt == TT - 1));
                        f32x4 hx[2];
                        if (m == 0) { hx[0] = *(LAS const f32x4*)(XB + ((gm > 0 ? gm - 1 : 0) * 2 + 1) * 256 + bj * 128 + cw0); hx[1] = *(LAS const f32x4*)(XB + ((gm > 0 ? gm - 1 : 0) * 2 + 1) * 256 + bj * 128 + cw0 + 4); }
                        if (m == 3) { hx[0] = *(LAS const f32x4*)(XB + ((gm < 3 ? gm + 1 : 3) * 2 + 0) * 256 + bj * 128 + cw0); hx[1] = *(LAS const f32x4*)(XB + ((gm < 3 ? gm + 1 : 3) * 2 + 0) * 256 + bj * 128 + cw0 + 4); }
                        unsigned pk[4];
#pragma unroll
                        for (int kp = 0; kp < 4; ++kp) { const int n = kp >> 1, j0 = (2 * kp) & 3;
                            f32x2 cur, pv, nv;
#pragma unroll
                            for (int jj = 0; jj < 2; ++jj) { const int j = j0 + jj;
                                const float cu = acc[ai][bj][m][n][j];
                                float xs = (fr == 15) ? (m == 0 ? hx[n][j] : acc[ai][bj][m > 0 ? m - 1 : 0][n][j]) : cu;
                                float ys = (fr == 0) ? (m == 3 ? hx[n][j] : acc[ai][bj][m < 3 ? m + 1 : 3][n][j]) : cu;
                                cur[jj] = cu; pv[jj] = zp ? 0.f : dpp_f<0x121>(xs); nv[jj] = zn ? 0.f : dpp_f<0x12F>(ys); }
                            const f32x2 a0 = {w0[n][j0], w0[n][j0 + 1]}, a1 = {w1[n][j0], w1[n][j0 + 1]}, a2 = {w2[n][j0], w2[n][j0 + 1]}, ab = {bs[n][j0], bs[n][j0 + 1]};
                            f32x2 z = __builtin_elementwise_fma(a1, cur, ab);
                            z = __builtin_elementwise_fma(a0, pv, z);
                            z = __builtin_elementwise_fma(a2, nv, z);
                            const f32x2 ez = z * nl2e;
                            f32x2 den = {__builtin_amdgcn_exp2f(ez[0]), __builtin_amdgcn_exp2f(ez[1])};
                            den = den + 1.f;
                            const f32x2 rc = {__builtin_amdgcn_rcpf(den[0]), __builtin_amdgcn_rcpf(den[1])};
                            const f32x2 o = z * rc;
                            pk[kp] = pk2(o[0], o[1]);
                        }
                        if (rho >= 1 && rho <= 254 && row < u.rend) *(u32x4*)(dst + (size_t)row * D + h * 256 + bj * 128 + cw0) = (u32x4){pk[0], pk[1], pk[2], pk[3]};
                    }
                }
            }
            }
    }
    __device__ __forceinline__ void operator()(const f32x4 (&acc)[2][2][4][2], const Unit& u, int wr, int wc, int fr, int fq) const {
        const int pn = u.pn;
        if (u.ovl) { if (u.seam) conv_epi<true>(acc, u, wr, wc, fr, fq); else conv_epi<false>(acc, u, wr, wc, fr, fq); return; }
        if (pn == 40) {
            if (wc != 0 || fq >= 2) return;
            float* Gt = (float*)(ws + WS_G);
            const f32x4 bA = *(const f32x4*)(b_mgate + 8 * fq), bB = *(const f32x4*)(b_mgate + 8 * fq + 4);
#pragma unroll
            for (int ai = 0; ai < 2; ++ai)
#pragma unroll
                for (int m = 0; m < 4; ++m) { const int r = u.pm * 256 + ai * 128 + wr * 64 + m * 16 + fr, b = r / TT, tt = r - b * TT;
#pragma unroll
                    for (int k = 0; k < 8; ++k) { const int c = 8 * fq + k; float v = acc[ai][0][m][k >> 2][k & 3] + ((k < 4) ? bA[k & 3] : bB[k & 3]); if ((c >> 2) & 1) v = logsigmoid_f(v);
                        Gt[((size_t)b * 16 + c) * TT + tt] = v; } }
            return;
        }
        const int blk = pn >> 2, h = pn & 3;
        if (blk < 2) {
            bf16_t* dst = (bf16_t*)(ws + (blk == 0 ? WS_RQ : WS_RK));
            const float scl = (blk == 1) ? 0.0625f : 1.f;
            int q = wc * 32 + 8 * fq;
            asm volatile("" : "+v"(q));
            const int hb = q >> 6, i0 = q & 63;
            const int tile = u.pm % 9;
            LAS const float* TF = (LAS const float*)(lds + 131072); LAS const float* TM = TF + 16 * 128; LAS const float* TK = TF + 20 * 128;
#pragma unroll
            for (int ai = 0; ai < 2; ++ai)
#pragma unroll
                for (int m = 0; m < 4; ++m) { const int r = u.pm * 256 + ai * 128 + wr * 64 + m * 16 + fr;
                    float o1[8], o2[8];
                    if (tile > 0) {
                        LAS const f32x4* pa = (LAS const f32x4*)((hb ? TM + m * 128 : TK + (tile - 1) * 128) + 2 * i0);
                        LAS const f32x4* pb = (LAS const f32x4*)(TF + (hb ? fr : 2 * ai + wr) * 128 + 2 * i0);
#pragma unroll
                        for (int k2 = 0; k2 < 4; ++k2) { const f32x4 ca = pa[k2], cb = pb[k2];
                            const f32x4 cs = {ca[0] * cb[0] - ca[1] * cb[1], ca[1] * cb[0] + ca[0] * cb[1], ca[2] * cb[2] - ca[3] * cb[3], ca[3] * cb[2] + ca[2] * cb[3]};
                            const float a0 = acc[ai][0][m][k2 >> 1][(2 * k2) & 3], a1 = acc[ai][0][m][k2 >> 1][(2 * k2 + 1) & 3], b0 = acc[ai][1][m][k2 >> 1][(2 * k2) & 3], b1 = acc[ai][1][m][k2 >> 1][(2 * k2 + 1) & 3];
                            o1[2 * k2] = a0 * cs[0] - b0 * cs[1]; o2[2 * k2] = a0 * cs[1] + b0 * cs[0]; o1[2 * k2 + 1] = a1 * cs[2] - b1 * cs[3]; o2[2 * k2 + 1] = a1 * cs[3] + b1 * cs[2]; } }
                    else {
#pragma unroll
                        for (int k = 0; k < 8; ++k) { o1[k] = acc[ai][0][m][k >> 2][k & 3]; o2[k] = acc[ai][1][m][k >> 2][k & 3]; } }
                    bf16_t* rowp = dst + (size_t)r * D + h * 256 + q;
                    *(u32x4*)(rowp) = (u32x4){pk2(o1[0] * scl, o1[1] * scl), pk2(o1[2] * scl, o1[3] * scl), pk2(o1[4] * scl, o1[5] * scl), pk2(o1[6] * scl, o1[7] * scl)};
                    *(u32x4*)(rowp + 128) = (u32x4){pk2(o2[0] * scl, o2[1] * scl), pk2(o2[2] * scl, o2[3] * scl), pk2(o2[4] * scl, o2[5] * scl), pk2(o2[6] * scl, o2[7] * scl)}; }
            return;
        }
        if (blk == 2 || blk == 6) {
            const int b = u.pm / 9, tt0 = (u.pm - b * 9) * 256;
            unsigned char* base = ws + (blk == 2 ? WS_RVT : WS_MVT) + ((size_t)(b * 4 + h) * 256) * TT * 2;
            int ec = wc * 32 + 8 * fq; asm volatile("" : "+v"(ec));
            const unsigned e0 = (unsigned)ec * (TT * 2);
#pragma unroll
            for (int ai = 0; ai < 2; ++ai)
#pragma unroll
                for (int m = 0; m < 4; ++m) { const unsigned o0 = e0 + 2u * (unsigned)(tt0 + ai * 128 + wr * 64 + m * 16 + fr);
#pragma unroll
                    for (int bj = 0; bj < 2; ++bj)
#pragma unroll
                        for (int kp = 0; kp < 4; ++kp) { const unsigned w = pk2(acc[ai][bj][m][kp >> 1][(2 * kp) & 3], acc[ai][bj][m][kp >> 1][(2 * kp + 1) & 3]);
                            const unsigned o = o0 + (unsigned)((bj * 128 + 2 * kp) * TT * 2);
                            *(bf16_t*)(base + o) = (bf16_t)(w & 0xffffu); *(bf16_t*)(base + (o + TT * 2)) = (bf16_t)(w >> 16); } }
            return;
        }
        if (blk == 4 || blk == 5) {
            bf16_t* dst = (bf16_t*)(ws + (blk == 4 ? WS_MQRAW : WS_MKRAW));
#pragma unroll
            for (int ai = 0; ai < 2; ++ai)
#pragma unroll
                for (int m = 0; m < 4; ++m) { const int r = u.pm * 256 + ai * 128 + wr * 64 + m * 16 + fr;
#pragma unroll
                    for (int bj = 0; bj < 2; ++bj) { const f32x4 v0 = acc[ai][bj][m][0], v1 = acc[ai][bj][m][1]; const int c = h * 256 + bj * 128 + wc * 32 + 8 * fq;
                        *(u32x4*)(dst + (size_t)r * D + c) = (u32x4){pk2(v0[0], v0[1]), pk2(v0[2], v0[3]), pk2(v1[0], v1[1]), pk2(v1[2], v1[3])}; } }
            return;
        }
        {
            bf16_t* dst = (bf16_t*)(ws + (blk == 3 ? WS_RGA : (blk == 7 ? WS_MOA : (blk == 8 ? WS_GRA : WS_GMA))));
#pragma unroll
            for (int ai = 0; ai < 2; ++ai)
#pragma unroll
                for (int m = 0; m < 4; ++m) { const int r = u.pm * 256 + ai * 128 + wr * 64 + m * 16 + fr, b = r / TT, tt = r - b * TT; const int rl = b * T + (tt - TC);
#pragma unroll
                    for (int bj = 0; bj < 2; ++bj) { f32x4 v0 = acc[ai][bj][m][0], v1 = acc[ai][bj][m][1]; const int c = h * 256 + bj * 128 + wc * 32 + 8 * fq;
                        if (blk >= 8) { _Pragma("unroll") for (int j = 0; j < 4; ++j) { v0[j] = sigmoid_f(v0[j]); v1[j] = sigmoid_f(v1[j]); } }
                        if (tt >= TC) *(u32x4*)(dst + (size_t)rl * D + c) = (u32x4){pk2(v0[0], v0[1]), pk2(v0[2], v0[3]), pk2(v1[0], v1[1]), pk2(v1[2], v1[3])}; } }
        }
    }
};

__device__ __forceinline__ void phase_conv(const Params& p, int tid) {
    const bf16_t* QR = (const bf16_t*)(p.ws + WS_MQRAW); const bf16_t* KR = (const bf16_t*)(p.ws + WS_MKRAW);
    bf16_t* QO = (bf16_t*)(p.ws + WS_MQ); bf16_t* KO = (bf16_t*)(p.ws + WS_MK);
    const float* cw = p.in[I_CONVW]; const float* cb = p.in[I_CONVB];
    const int gt = blockIdx.x * NTHREADS + tid, nthr = gridDim.x * NTHREADS, ch = gt & 127;
    constexpr int NGRP = NROW / 8;
#pragma unroll 1
    for (int which = 0; which < 2; ++which) {
        const int c0 = which * 1024 + ch * 8; const float scl = which ? 0.0625f : 1.f;
        float w0[8], w1[8], w2[8], bs[8];
#pragma unroll
        for (int j = 0; j < 8; ++j) { w0[j] = cw[c0 + j]; w1[j] = cw[2048 + c0 + j]; w2[j] = cw[4096 + c0 + j]; bs[j] = cb[c0 + j]; }
        const bf16_t* srcb = (which ? KR : QR) + ch * 8; bf16_t* dstb = (which ? KO : QO) + ch * 8;
        for (int g = gt >> 7; g < NGRP; g += nthr >> 7) {
            const int R0 = g * 8, tt = R0 % TT;
            if (which == 0 && tt < TC) continue;
            const bool hasp = !(tt == 0 || tt == TC), hasn = !(tt + 7 == TC - 1 || tt + 7 == TT - 1);
            u32x4 rw[10];
            rw[0] = hasp ? ld_nt((const u32x4*)(srcb + (size_t)(R0 - 1) * D)) : (u32x4){0u, 0u, 0u, 0u};
#pragma unroll
            for (int i = 0; i < 8; ++i) rw[1 + i] = ld_nt((const u32x4*)(srcb + (size_t)(R0 + i) * D));
            rw[9] = hasn ? ld_nt((const u32x4*)(srcb + (size_t)(R0 + 8) * D)) : (u32x4){0u, 0u, 0u, 0u};
#pragma unroll
            for (int i = 0; i < 8; ++i) {
                float o[8];
#pragma unroll
                for (int j = 0; j < 4; ++j) {
                    const float a = w0[2 * j] * bflo(rw[i][j]) + w1[2 * j] * bflo(rw[i + 1][j]) + w2[2 * j] * bflo(rw[i + 2][j]) + bs[2 * j];
                    const float c = w0[2 * j + 1] * bfhi(rw[i][j]) + w1[2 * j + 1] * bfhi(rw[i + 1][j]) + w2[2 * j + 1] * bfhi(rw[i + 2][j]) + bs[2 * j + 1];
                    o[2 * j] = silu_f(a) * scl; o[2 * j + 1] = silu_f(c) * scl;
                }
                *(u32x4*)(dstb + (size_t)(R0 + i) * D) = (u32x4){pk2(o[0], o[1]), pk2(o[2], o[3]), pk2(o[4], o[5]), pk2(o[6], o[7])};
            }
        }
    }
}

struct ScanArgs { const bf16_t* Q; const bf16_t* K; const bf16_t* VT; const float* G; const float* decay; bf16_t* Of; bf16_t* Ob; int is_ml; };
constexpr int SC_S = 0;
constexpr int SC_ATT = 131072;
constexpr int ATT_LD = 72;
constexpr int SC_VEC = SC_ATT + 64 * ATT_LD * 2;
__device__ __forceinline__ void scan_phase(LAS unsigned char* lds, const ScanArgs a, int tid, int wave, int lane) {
    LAS float* Sm = (LAS float*)(lds + SC_S);
    LAS bf16_t* att = (LAS bf16_t*)(lds + SC_ATT);
    LAS float* vec = (LAS float*)(lds + SC_VEC);
    LAS float* rowv = vec, *colv = vec + 64, *aq = vec + 128, *kd = vec + 192, *emr = vec + 256, *cv = vec + 320, *av = vec + 384, *mxv = vec + 448, *qn = vec + 512, *denp = vec + 576, *nv = vec + 832, *scal = vec + 1088;
    const int fr = lane & 15, fq = lane >> 4;
    for (int item = blockIdx.x; item < 256; item += gridDim.x) {
        const int eh = item & 1, dir = (item >> 1) & 1, h = (item >> 2) & 3, b = item >> 4;
        __syncthreads();
        for (int i = tid; i < 256 * 128; i += NTHREADS) Sm[i] = 0.f;
        if (tid < 256) nv[tid] = 0.f;
        if (tid == 0) { scal[0] = 0.f;   scal[1] = 1.f;   }
        const float lg = a.is_ml ? 0.f : logsigmoid_f(a.decay[dir * 4 + h]);
        const float* Gi = a.G + ((size_t)b * 16 + (dir ? 8 : 0) + h) * TT;
        const float* Gf = a.G + ((size_t)b * 16 + (dir ? 12 : 4) + h) * TT;
        bf16_t* Oo = dir ? a.Ob : a.Of;
        __syncthreads();
        for (int st = 0; st < 36; ++st) {
            int tt0;
            if (st < 4) tt0 = (dir ? (3 - st) : st) * CH; else tt0 = TC + (dir ? (35 - st) : (st - 4)) * CH;
            const bool lat = st >= 4;
            const size_t R0 = (size_t)b * TT + tt0;
            if (a.is_ml) {
                if (tid == 0) {
                    const float mst = scal[0];
                    float run = 0.f;
                    if (dir == 0) { for (int l = 0; l < CH; ++l) { run += Gf[tt0 + l]; cv[l] = run; } }
                    else { for (int l = CH - 1; l >= 0; --l) { run += Gf[tt0 + l]; cv[l] = run; } }
                    const float ctot = run;
                    float mxr = -1e30f;
                    if (dir == 0) { for (int l = 0; l < CH; ++l) { const float x = Gi[tt0 + l] - cv[l]; av[l] = x; mxr = fmaxf(mxr, x); mxv[l] = mxr; } }
                    else { for (int l = CH - 1; l >= 0; --l) { mxv[l] = mxr; const float x = Gi[tt0 + l] - cv[l]; av[l] = x; mxr = fmaxf(mxr, x); } }
                    const float mnew = fmaxf(ctot + mst, ctot + mxr);
                    scal[1] = expf(ctot + mst - mnew); scal[2] = ctot; scal[3] = mnew; scal[4] = mst;
                }
                __syncthreads();
                if (tid < CH) { const int l = tid; const float mst = scal[4], ctot = scal[2], mnew = scal[3];
                    const float mrow = fmaxf(cv[l] + mxv[l], cv[l] + mst);
                    rowv[l] = cv[l] - mrow; colv[l] = av[l]; aq[l] = expf(cv[l] + mst - mrow); emr[l] = expf(-mrow); kd[l] = expf(ctot + av[l] - mnew); }
                if (tid == 0) scal[0] = scal[3];
            } else {
                if (tid < CH) { const int l = tid;
                    rowv[l] = (dir ? -(float)l : (float)l) * lg; colv[l] = (dir ? (float)l : -(float)l) * lg;
                    aq[l] = expf((float)(dir ? (CH - l) : (l + 1)) * lg); kd[l] = expf((float)(dir ? l : (CH - 1 - l)) * lg); emr[l] = 0.f; }
                if (tid == 0) scal[1] = expf((float)CH * lg);
            }
            __syncthreads();
            if (lat) {
#pragma unroll
                for (int tq = 0; tq < 2; ++tq) {
                    const int ti = wave * 2 + tq, lt = ti >> 2, mt = ti & 3, l0 = lt * 16, m0 = mt * 16;
                    f32x4 acc = (f32x4){0.f, 0.f, 0.f, 0.f};
                    const bf16_t* kp = a.K + (R0 + m0 + fr) * D + h * 256 + 8 * fq;
                    const bf16_t* qp = a.Q + (R0 + l0 + fr) * D + h * 256 + 8 * fq;
#pragma unroll
                    for (int d0 = 0; d0 < 256; d0 += 32) { const bf16x8 ka = *(const bf16x8*)(kp + d0), qb = *(const bf16x8*)(qp + d0); acc = MFMA16(ka, qb, acc); }
                    const int l = l0 + fr; const float rv = rowv[l]; float o[4]; float s = 0.f;
#pragma unroll
                    for (int r = 0; r < 4; ++r) { const int m = m0 + 4 * fq + r; const bool ok = dir ? (m > l) : (m <= l); const float w = ok ? __expf(rv + colv[m]) : 0.f; o[r] = acc[r] * w; s += o[r]; }
                    *(LAS u32x2*)(att + l * ATT_LD + m0 + 4 * fq) = (u32x2){pk2(o[0], o[1]), pk2(o[2], o[3])};
                    s += __shfl_xor(s, 16); s += __shfl_xor(s, 32);
                    if (fq == 0) denp[l * 4 + mt] = s;
                }
                if (a.is_ml && tid < CH) { const int l = tid; const bf16_t* qp = a.Q + (R0 + l) * D + h * 256; float s = 0.f;
                    for (int d = 0; d < 256; d += 8) { const u32x4 w = *(const u32x4*)(qp + d);
#pragma unroll
                        for (int j = 0; j < 4; ++j) s += bflo(w[j]) * nv[d + 2 * j] + bfhi(w[j]) * nv[d + 2 * j + 1]; }
                    qn[l] = s; }
            }
            __syncthreads();
            {
                const int ew = wave * 16; const float cdec = scal[1];
                const bf16_t* vp = a.VT + ((size_t)(b * 4 + h) * 256 + eh * 128 + ew + fr) * TT + tt0 + 8 * fq;
                const bf16x8 vf0 = *(const bf16x8*)(vp), vf1 = *(const bf16x8*)(vp + 32);
                if (lat) {
                    const int t0 = tt0 - TC;
#pragma unroll 1
                    for (int lt = 0; lt < 4; ++lt) {
                        f32x4 acc = (f32x4){0.f, 0.f, 0.f, 0.f};
                        const bf16_t* qp = a.Q + (R0 + lt * 16 + fr) * D + h * 256 + 8 * fq;
#pragma unroll
                        for (int d0 = 0; d0 < 256; d0 += 32) {
                            const bf16x8 qa = *(const bf16x8*)(qp + d0);
                            const LAS float* sp = Sm + (d0 + 8 * fq) * 128 + ew + fr;
                            u32x4 sb; sb.x = pk2(sp[0], sp[128]); sb.y = pk2(sp[256], sp[384]); sb.z = pk2(sp[512], sp[640]); sb.w = pk2(sp[768], sp[896]);
                            acc = MFMA16(qa, __builtin_bit_cast(bf16x8, sb), acc);
                        }
                        float hs[4];
#pragma unroll
                        for (int r = 0; r < 4; ++r) { const int l = lt * 16 + 4 * fq + r; acc[r] *= aq[l];
                            if (a.is_ml) { const float den = (denp[l * 4] + denp[l * 4 + 1]) + (denp[l * 4 + 2] + denp[l * 4 + 3]) + aq[l] * qn[l]; hs[r] = 1.f / fmaxf(fabsf(den), emr[l]); } else hs[r] = 1.f; }
                        const bf16x8 a0 = *(const LAS bf16x8*)(att + (lt * 16 + fr) * ATT_LD + 8 * fq), a1 = *(const LAS bf16x8*)(att + (lt * 16 + fr) * ATT_LD + 32 + 8 * fq);
                        acc = MFMA16(a0, vf0, acc); acc = MFMA16(a1, vf1, acc);
#pragma unroll
                        for (int r = 0; r < 4; ++r) { const int l = lt * 16 + 4 * fq + r; Oo[((size_t)b * T + t0 + l) * D + h * 256 + eh * 128 + ew + fr] = f2bf(acc[r] * hs[r]); }
                    }
                }
#pragma unroll 1
                for (int dt = 0; dt < 16; ++dt) {
                    const int d0 = dt * 16;
                    LAS float* sp = Sm + (d0 + 4 * fq) * 128 + ew + fr;
                    f32x4 acc; acc[0] = sp[0] * cdec; acc[1] = sp[128] * cdec; acc[2] = sp[256] * cdec; acc[3] = sp[384] * cdec;
#pragma unroll
                    for (int ks = 0; ks < 2; ++ks) {
                        const bf16_t* kp = a.K + (R0 + 32 * ks + 8 * fq) * D + h * 256 + d0 + fr;
                        float kk[8];
#pragma unroll
                        for (int j = 0; j < 8; ++j) kk[j] = bf2f(kp[(size_t)j * D]) * kd[32 * ks + 8 * fq + j];
                        u32x4 ka; ka.x = pk2(kk[0], kk[1]); ka.y = pk2(kk[2], kk[3]); ka.z = pk2(kk[4], kk[5]); ka.w = pk2(kk[6], kk[7]);
                        acc = MFMA16(__builtin_bit_cast(bf16x8, ka), ks ? vf1 : vf0, acc);
                    }
                    sp[0] = acc[0]; sp[128] = acc[1]; sp[256] = acc[2]; sp[384] = acc[3];
                }
                if (a.is_ml && tid < 256) { const int d = tid; const bf16_t* kp = a.K + R0 * D + h * 256 + d; float s = nv[d] * cdec;
                    for (int m = 0; m < CH; ++m) s += kd[m] * bf2f(kp[(size_t)m * D]);
                    nv[d] = s; }
            }
            __syncthreads();
        }
    }
}


typedef short v4i16_t __attribute__((ext_vector_type(4)));
__device__ __forceinline__ int swz_f(int row) { return ((row & 3) << 2) | ((row >> 2) & 3); }
__device__ __forceinline__ int img_chunk(int row, int half, int ch) { return half * 16384 + 256 * row + 16 * (ch ^ swz_f(row)); }
constexpr int S2_Q = 0, S2_K = 65536, S2_ATT = 131072, S2_VEC = S2_ATT + 64 * ATT_LD * 2, S2_OUT = 144512;
__device__ __forceinline__ void scan_dma_tile(LAS unsigned char* dstbuf, const bf16_t* src, int wave, int lane) {
#pragma unroll
    for (int j = 0; j < 4; ++j) { const int ii = wave * 4 + j, half = ii >> 4, rg = ii & 15; const int row = 4 * rg + (lane >> 4), ch = (lane & 15) ^ swz_f(row);
        __builtin_amdgcn_global_load_lds((const unsigned*)(src + (size_t)row * D + half * 128 + 8 * ch), (LAS unsigned*)(dstbuf + half * 16384 + rg * 1024), 16, 0, 0); }
}
__device__ __forceinline__ float rows_sum4(float s) {
    float a = s, b = s;
    asm volatile("s_nop 1\n\tv_permlane16_swap_b32 %0, %1" : "+v"(a), "+v"(b));
    a += b; b = a;
    asm volatile("s_nop 1\n\tv_permlane32_swap_b32 %0, %1" : "+v"(a), "+v"(b));
    return a + b;
}
__device__ __forceinline__ float lane63_f(float v) { return __builtin_bit_cast(float, __builtin_amdgcn_readlane(__builtin_bit_cast(int, v), 63)); }
template <int CTRL, int RMASK> __device__ __forceinline__ float dpp_src(float v, float ident) {
    return __builtin_bit_cast(float, __builtin_amdgcn_update_dpp(__builtin_bit_cast(int, ident), __builtin_bit_cast(int, v), CTRL, RMASK, 0xF, false)); }
__device__ __forceinline__ float scan_incl_sum(float v, int lane) {
    v += dpp_src<0x111, 0xF>(v, 0.f); v += dpp_src<0x112, 0xF>(v, 0.f); v += dpp_src<0x114, 0xF>(v, 0.f); v += dpp_src<0x118, 0xF>(v, 0.f);
    v += dpp_src<0x142, 0xA>(v, 0.f); v += dpp_src<0x143, 0xC>(v, 0.f);
    return v;
}
__device__ __forceinline__ float scan_incl_max(float v, int lane) {
    const float ni = -3.0e38f;
    v = fmaxf(v, dpp_src<0x111, 0xF>(v, ni)); v = fmaxf(v, dpp_src<0x112, 0xF>(v, ni)); v = fmaxf(v, dpp_src<0x114, 0xF>(v, ni)); v = fmaxf(v, dpp_src<0x118, 0xF>(v, ni));
    v = fmaxf(v, dpp_src<0x142, 0xA>(v, ni)); v = fmaxf(v, dpp_src<0x143, 0xC>(v, ni));
    return v;
}
__device__ __forceinline__ void scan_phase2(LAS unsigned char* lds, const ScanArgs a, int tid, int wave, int lane) {
    LAS bf16_t* att = (LAS bf16_t*)(lds + S2_ATT);
    LAS float* vec = (LAS float*)(lds + S2_VEC);
    LAS float* rowv = vec, *colv = vec + 64, *aq = vec + 128, *kd = vec + 192, *emr = vec + 256, *qn = vec + 320, *denp = vec + 384, *nv = vec + 640, *scal = vec + 896;
    const int fr = lane & 15, fq = lane >> 4;
    for (int item = blockIdx.x; item < 256; item += gridDim.x) {
        const int eh = item & 1, dir = (item >> 1) & 1, h = (item >> 2) & 3, b = item >> 4;
        const int ew = wave * 16;
        const int Ff = swz_f(fr), Fhp = Ff >> 2, Flp = Ff & 3;
        int X4[4];
#pragma unroll
        for (int c2 = 0; c2 < 4; ++c2) X4[c2] = 64 * (c2 ^ Fhp);
        const int LB1 = 256 * fr + 16 * (fq ^ Flp);
        const int LB2 = 256 * fr + 16 * ((fq >> 1) ^ Flp) + 8 * (fq & 1);
        const int LB3 = 256 * fr + 16 * (((fq >> 1) | 2) ^ Flp) + 8 * (fq & 1);
        const int q4 = (lane & 15) >> 2, p4 = lane & 3;
        const int TB0 = 256 * (8 * fq + q4) + 16 * (p4 >> 1) + 8 * (p4 & 1);
        const int TB1 = 256 * (8 * fq + q4 + 4) + 16 * ((p4 >> 1) ^ 1) + 8 * (p4 & 1);
        int W8[8];
#pragma unroll
        for (int i = 0; i < 8; ++i) W8[i] = 64 * ((i >> 1) ^ q4) + 32 * ((i & 1) ^ (fq & 1));
        __syncthreads();
        f32x4 S[16];
#pragma unroll
        for (int i = 0; i < 16; ++i) S[i] = (f32x4){0.f, 0.f, 0.f, 0.f};
        if (tid < 256) nv[tid] = 0.f;
        if (tid == 0) { scal[0] = 0.f; scal[1] = 1.f; }
        const float* Gi = a.G + ((size_t)b * 16 + (dir ? 8 : 0) + h) * TT;
        const float* Gf = a.G + ((size_t)b * 16 + (dir ? 12 : 4) + h) * TT;
        bf16_t* Oo = dir ? a.Ob : a.Of;
        const bf16_t* Qh = a.Q + (size_t)b * TT * D + h * 256;
        const bf16_t* Kh = a.K + (size_t)b * TT * D + h * 256;
        const bf16_t* Vw = a.VT + ((size_t)(b * 4 + h) * 256 + eh * 128 + ew + fr) * TT + 8 * fq;
        if (!a.is_ml) {
            const float lg = logsigmoid_f(a.decay[dir * 4 + h]);
            if (tid < CH) { const int l = tid;
                rowv[l] = (dir ? -(float)l : (float)l) * lg; colv[l] = (dir ? (float)l : -(float)l) * lg;
                aq[l] = expf((float)(dir ? (CH - l) : (l + 1)) * lg); kd[l] = expf((float)(dir ? l : (CH - 1 - l)) * lg); emr[l] = 0.f; }
            if (tid == 0) scal[1] = expf((float)CH * lg);
        }
        { const int tt0 = (dir ? 3 : 0) * CH; scan_dma_tile(lds + S2_K, Kh + (size_t)tt0 * D, wave, lane); }
        const int sidx = dir ? 63 - lane : lane;
        float gf_n = 0.f, gi_n = 0.f;
        if (a.is_ml && wave == 0) { const int tt0 = (dir ? 3 : 0) * CH; gf_n = Gf[tt0 + sidx]; gi_n = Gi[tt0 + sidx]; }
        asm volatile("s_waitcnt vmcnt(0)" ::: "memory");
        __syncthreads();
        for (int st = 0; st < 36; ++st) {
            int tt0, ttn;
            if (st < 4) tt0 = (dir ? (3 - st) : st) * CH; else tt0 = TC + (dir ? (35 - st) : (st - 4)) * CH;
            { const int sn = st + 1; if (sn < 4) ttn = (dir ? (3 - sn) : sn) * CH; else ttn = TC + (dir ? (35 - sn) : (sn - 4)) * CH; }
            const bool lat = st >= 4, latn = (st + 1) >= 4, hasn = (st + 1) < 36;
            int frs = fr, fqs = fq; asm volatile("" : "+v"(frs), "+v"(fqs));
            LAS unsigned char* Qb = lds + S2_Q + (st & 1) * 32768;
            LAS unsigned char* Kb = lds + S2_K + (st & 1) * 32768;
            const bf16x8 vf0 = *(const bf16x8*)(Vw + tt0), vf1 = *(const bf16x8*)(Vw + tt0 + 32);
            if (a.is_ml) {
                if (wave == 0) {
                    const float f = gf_n, ig = gi_n, mst = scal[0];
                    const float cc = scan_incl_sum(f, lane);
                    const float ctot = __shfl(cc, 63);
                    const float av = ig - cc;
                    const float mi = scan_incl_max(av, lane);
                    float mx = mi;
                    if (dir) { mx = __shfl_up(mi, 1); if (lane == 0) mx = -1e30f; }
                    const float gmax = __shfl(mi, 63);
                    const float mnew = fmaxf(ctot + mst, ctot + gmax);
                    const float mrow = fmaxf(cc + mx, cc + mst);
                    rowv[sidx] = cc - mrow; colv[sidx] = av; aq[sidx] = expf(cc + mst - mrow); emr[sidx] = expf(-mrow); kd[sidx] = expf(ctot + av - mnew);
                    if (lane == 0) { scal[1] = expf(ctot + mst - mnew); scal[0] = mnew; }
                    if (hasn) { gf_n = Gf[ttn + sidx]; gi_n = Gi[ttn + sidx]; }
                }
                __syncthreads();
            }
            if (lat) {
#pragma unroll
                for (int tq = 0; tq < 2; ++tq) {
                    const int ti = wave * 2 + tq, lt = ti >> 2, mt = ti & 3;
                    f32x4 acc = (f32x4){0.f, 0.f, 0.f, 0.f};
#pragma unroll
                    for (int k8 = 0; k8 < 8; ++k8) {
                        const bf16x8 ka = *(const LAS bf16x8*)(Kb + (LB1 + X4[k8 & 3] + mt * 4096) + (k8 >> 2) * 16384);
                        const bf16x8 qb = *(const LAS bf16x8*)(Qb + (LB1 + X4[k8 & 3] + lt * 4096) + (k8 >> 2) * 16384);
                        acc = MFMA16(ka, qb, acc);
                    }
                    const int l = lt * 16 + frs; const float rv = rowv[l]; float o[4]; float s = 0.f;
#pragma unroll
                    for (int r = 0; r < 4; ++r) { const int m = mt * 16 + 4 * fqs + r; const bool ok = dir ? (m > l) : (m <= l); const float w = ok ? __expf(rv + colv[m]) : 0.f; o[r] = acc[r] * w; s += o[r]; }
                    *(LAS u32x2*)(att + l * ATT_LD + mt * 16 + 4 * fqs) = (u32x2){pk2(o[0], o[1]), pk2(o[2], o[3])};
                    s += __shfl_xor(s, 16); s += __shfl_xor(s, 32);
                    if (fqs == 0) denp[l * 4 + mt] = s;
                }
                if (a.is_ml) {
                    const int l = tid >> 3, part = tid & 7; float s = 0.f;
#pragma unroll
                    for (int cc = 0; cc < 4; ++cc) { const int cg = part * 4 + cc; const u32x4 w = *(const LAS u32x4*)(Qb + img_chunk(l, cg >> 4, cg & 15)); const LAS float* np = nv + cg * 8;
#pragma unroll
                        for (int j = 0; j < 4; ++j) s += bflo(w[j]) * np[2 * j] + bfhi(w[j]) * np[2 * j + 1]; }
                    s += __shfl_xor(s, 1); s += __shfl_xor(s, 2); s += __shfl_xor(s, 4);
                    if (part == 0) qn[l] = s;
                }
            }
            __syncthreads();
            if (hasn) {
                scan_dma_tile(lds + S2_K + ((st + 1) & 1) * 32768, Kh + (size_t)ttn * D, wave, lane);
                if (latn) scan_dma_tile(lds + S2_Q + ((st + 1) & 1) * 32768, Qh + (size_t)ttn * D, wave, lane);
            }
            const float cdec = scal[1];
            if (lat) {
                const int t0 = tt0 - TC;
                f32x4 oacc[4];
#pragma unroll
                for (int lt = 0; lt < 4; ++lt) oacc[lt] = (f32x4){0.f, 0.f, 0.f, 0.f};
#pragma unroll
                for (int kb = 0; kb < 8; ++kb) {
                    u32x4 w; w.x = pk2(S[2 * kb][0], S[2 * kb][1]); w.y = pk2(S[2 * kb][2], S[2 * kb][3]); w.z = pk2(S[2 * kb + 1][0], S[2 * kb + 1][1]); w.w = pk2(S[2 * kb + 1][2], S[2 * kb + 1][3]);
                    const bf16x8 sbk = __builtin_bit_cast(bf16x8, w);
#pragma unroll
                    for (int lt = 0; lt < 4; ++lt) {
                        const u32x2 lo = *(const LAS u32x2*)(Qb + (LB2 + X4[kb & 3]) + lt * 4096 + (kb >> 2) * 16384);
                        const u32x2 hi = *(const LAS u32x2*)(Qb + (LB3 + X4[kb & 3]) + lt * 4096 + (kb >> 2) * 16384);
                        const u32x4 qa = (u32x4){lo.x, lo.y, hi.x, hi.y};
                        oacc[lt] = MFMA16(__builtin_bit_cast(bf16x8, qa), sbk, oacc[lt]);
                    }
                    if (kb & 1) __builtin_amdgcn_sched_barrier(0);
                }
#pragma unroll
                for (int lt = 0; lt < 4; ++lt) {
                    f32x4 acc = oacc[lt];
                    float hs[4];
#pragma unroll
                    for (int r = 0; r < 4; ++r) { const int l = lt * 16 + 4 * fqs + r; acc[r] *= aq[l];
                        if (a.is_ml) { const float den = (denp[l * 4] + denp[l * 4 + 1]) + (denp[l * 4 + 2] + denp[l * 4 + 3]) + aq[l] * qn[l]; hs[r] = 1.f / fmaxf(fabsf(den), emr[l]); } else hs[r] = 1.f; }
                    const bf16x8 a0 = *(const LAS bf16x8*)(att + (lt * 16 + frs) * ATT_LD + 8 * fqs), a1 = *(const LAS bf16x8*)(att + (lt * 16 + frs) * ATT_LD + 32 + 8 * fqs);
                    acc = MFMA16(a0, vf0, acc); acc = MFMA16(a1, vf1, acc);
#pragma unroll
                    for (int r = 0; r < 4; ++r) { const int l = lt * 16 + 4 * fqs + r; Oo[((size_t)b * T + t0 + l) * D + h * 256 + eh * 128 + ew + frs] = f2bf(acc[r] * hs[r]); }
                    __builtin_amdgcn_sched_barrier(0);
                }
            }
            {
                bf16x8 vs[2];
#pragma unroll
                for (int ks = 0; ks < 2; ++ks) { const u32x4 vw = __builtin_bit_cast(u32x4, ks ? vf1 : vf0); const LAS float* kp = kd + 32 * ks + 8 * fqs; u32x4 o;
#pragma unroll
                    for (int j = 0; j < 4; ++j) o[j] = pk2(bflo(vw[j]) * kp[2 * j], bfhi(vw[j]) * kp[2 * j + 1]);
                    vs[ks] = __builtin_bit_cast(bf16x8, o); }
#pragma unroll
                for (int dt = 0; dt < 16; ++dt) {
                    f32x4 acc = S[dt] * cdec;
#pragma unroll
                    for (int ks = 0; ks < 2; ++ks) {
                        const v4i16_t lo = __builtin_amdgcn_ds_read_tr16_b64_v4i16((LAS v4i16_t*)(Kb + (TB0 + W8[dt & 7]) + (dt >> 3) * 16384 + ks * 8192));
                        const v4i16_t hi = __builtin_amdgcn_ds_read_tr16_b64_v4i16((LAS v4i16_t*)(Kb + (TB1 + W8[dt & 7]) + (dt >> 3) * 16384 + ks * 8192));
                        const bf16x8 ka = __builtin_shufflevector(lo, hi, 0, 1, 2, 3, 4, 5, 6, 7);
                        acc = MFMA16(ka, vs[ks], acc);
                    }
                    S[dt] = acc;
                    if ((dt & 1) == 1) __builtin_amdgcn_sched_barrier(0);
                }
                if (a.is_ml && tid < 256) { const int d = tid; float s = nv[d] * cdec;
#pragma unroll 4
                    for (int m = 0; m < CH; ++m) s += kd[m] * bf2f(*(const LAS bf16_t*)(Kb + img_chunk(m, d >> 7, (d & 127) >> 3) + (d & 7) * 2));
                    nv[d] = s; }
            }
            asm volatile("s_waitcnt vmcnt(0)" ::: "memory");
            __syncthreads();
        }
    }
}


constexpr int S3_SET = 328;
template <int VAR> __device__ __forceinline__ void scan_phase3(LAS unsigned char* lds, const ScanArgs a, int tid, int wave, int lane) {
    LAS bf16_t* att = (LAS bf16_t*)(lds + S2_ATT);
    LAS float* vec = (LAS float*)(lds + S2_VEC);
    LAS float* qn2 = vec + 2 * S3_SET, *denp = qn2 + 128;
    const int fr = lane & 15, fq = lane >> 4;
    for (int item = blockIdx.x; item < 256; item += gridDim.x) {
        const int eh = item & 1, dir = (item >> 1) & 1, h = (item >> 2) & 3, b = item >> 4;
        const int ew = wave * 16;
        const int Ff = swz_f(fr), Fhp = Ff >> 2, Flp = Ff & 3;
        int X4[4];
#pragma unroll
        for (int c2 = 0; c2 < 4; ++c2) X4[c2] = 64 * (c2 ^ Fhp);
        const int LB1 = 256 * fr + 16 * (fq ^ Flp);
        const int LB2 = 256 * fr + 16 * ((fq >> 1) ^ Flp) + 8 * (fq & 1);
        const int LB3 = 256 * fr + 16 * (((fq >> 1) | 2) ^ Flp) + 8 * (fq & 1);
        const int q4 = (lane & 15) >> 2, p4 = lane & 3;
        const int TB0 = 256 * (8 * fq + q4) + 16 * (p4 >> 1) + 8 * (p4 & 1);
        const int TB1 = 256 * (8 * fq + q4 + 4) + 16 * ((p4 >> 1) ^ 1) + 8 * (p4 & 1);
        int W8[8];
#pragma unroll
        for (int i = 0; i < 8; ++i) W8[i] = 64 * ((i >> 1) ^ q4) + 32 * ((i & 1) ^ (fq & 1));
        __syncthreads();
        f32x4 S[16];
#pragma unroll
        for (int i = 0; i < 16; ++i) S[i] = (f32x4){0.f, 0.f, 0.f, 0.f};
        if (tid < 128) qn2[tid] = 0.f;
        f32x4 nA[2]; nA[0] = (f32x4){0.f, 0.f, 0.f, 0.f}; nA[1] = nA[0];
        const float* Gi = a.G + ((size_t)b * 16 + (dir ? 8 : 0) + h) * TT;
        const float* Gf = a.G + ((size_t)b * 16 + (dir ? 12 : 4) + h) * TT;
        bf16_t* Oo = (dir ? a.Ob : a.Of) + (size_t)b * T * D + h * 256 + eh * 128 + ew;
        const bf16_t* Qh = a.Q + (size_t)b * TT * D + h * 256;
        const bf16_t* Kh = a.K + (size_t)b * TT * D + h * 256;
        const bf16_t* Vw = a.VT + ((size_t)(b * 4 + h) * 256 + eh * 128 + ew + fr) * TT + 8 * fq;
        const int sidx = dir ? 63 - lane : lane;
        if (!a.is_ml) {
            const float lg = logsigmoid_f(a.decay[dir * 4 + h]);
            if (tid < 2 * CH) { const int l = tid & 63; LAS float* v = vec + (tid >> 6) * S3_SET;
                v[l] = (dir ? -(float)l : (float)l) * lg; v[64 + l] = (dir ? (float)l : -(float)l) * lg;
                v[128 + l] = expf((float)(dir ? (CH - l) : (l + 1)) * lg); v[192 + l] = expf((float)(dir ? l : (CH - 1 - l)) * lg); v[256 + l] = 0.f;
                if (l == 0) v[321] = expf((float)CH * lg); }
        }
#define S3_STAGE1(SET, f_, ig_) do { LAS float* v_ = vec + (SET) * S3_SET; \
            const float cc_ = scan_incl_sum((f_), lane); const float ctot_ = lane63_f(cc_); const float av_ = (ig_) - cc_; \
            const float mi_ = scan_incl_max(av_, lane); float mx_ = mi_; if (dir) { mx_ = __shfl_up(mi_, 1); if (lane == 0) mx_ = -1e30f; } \
            const float gmax_ = lane63_f(mi_); const float mnew_ = fmaxf(ctot_ + mst, ctot_ + gmax_); const float mrow_ = fmaxf(cc_ + mx_, cc_ + mst); \
            v_[sidx] = cc_ - mrow_; v_[64 + sidx] = av_; v_[128 + sidx] = __expf(cc_ + mst - mrow_); v_[256 + sidx] = __expf(-mrow_); v_[192 + sidx] = __expf(ctot_ + av_ - mnew_); \
            if (lane == 0) v_[321] = __expf(ctot_ + mst - mnew_); mst = mnew_; } while (0)
        float mst = 0.f, gf_n = 0.f, gi_n = 0.f;
        const int tt_first = (dir ? 3 : 0) * CH;
        if (!(VAR & 1)) scan_dma_tile(lds + S2_K, Kh + (size_t)tt_first * D, wave, lane);
        bf16x8 vf0 = *(const bf16x8*)(Vw + tt_first), vf1 = *(const bf16x8*)(Vw + tt_first + 32);
        if (a.is_ml && wave == 0) {
            const float f0 = Gf[tt_first + sidx], i0 = Gi[tt_first + sidx];
            S3_STAGE1(0, f0, i0);
            const int tt1 = (dir ? 2 : 1) * CH; gf_n = Gf[tt1 + sidx]; gi_n = Gi[tt1 + sidx];
        }
        LAS bf16_t* otile = (LAS bf16_t*)(lds + S2_OUT + wave * 2048);
        int tprev = -1;
        asm volatile("s_waitcnt vmcnt(0)" ::: "memory");
        __syncthreads();
        for (int st = 0; st < 36; ++st) {
            int tt0, ttn, ttnn;
            if (st < 4) tt0 = (dir ? (3 - st) : st) * CH; else tt0 = TC + (dir ? (35 - st) : (st - 4)) * CH;
            { const int sn = st + 1; if (sn < 4) ttn = (dir ? (3 - sn) : sn) * CH; else ttn = TC + (dir ? (35 - sn) : (sn - 4)) * CH; }
            { const int sn = st + 2; if (sn < 4) ttnn = (dir ? (3 - sn) : sn) * CH; else ttnn = TC + (dir ? (35 - sn) : (sn - 4)) * CH; }
            const bool lat = st >= 4, latn = (st + 1) >= 4, hasn = (st + 1) < 36, hasnn = (st + 2) < 36;
            int frs = fr, fqs = fq; asm volatile("" : "+v"(frs), "+v"(fqs));
            LAS unsigned char* Qb = lds + S2_Q + (st & 1) * 32768;
            LAS unsigned char* Kb = lds + S2_K + (st & 1) * 32768;
            LAS float* vs_ = vec + ((a.is_ml ? st : 0) & 1) * S3_SET;
            LAS float* rowv = vs_, *colv = vs_ + 64, *aq = vs_ + 128, *kd = vs_ + 192, *emr = vs_ + 256;
            LAS float* qn = qn2 + (st & 1) * 64;
            bf16x8 vfn0 = vf0, vfn1 = vf1;
            if (tprev >= 0) { const u32x4 oa = *(LAS const u32x4*)(otile + lane * 16), ob = *(LAS const u32x4*)(otile + lane * 16 + 8); u32x4* dp = (u32x4*)(Oo + (size_t)(tprev + lane) * D); dp[0] = oa; dp[1] = ob;
                asm volatile("s_waitcnt lgkmcnt(0)" ::: "memory"); }
            f32x4 oacc[4];
#pragma unroll
            for (int lt = 0; lt < 4; ++lt) oacc[lt] = (f32x4){0.f, 0.f, 0.f, 0.f};
            if (lat) {
                if (!(VAR & 2)) {
                {
                    int lts[2], mts[2];
#pragma unroll
                    for (int tq = 0; tq < 2; ++tq) { const int ti = wave * 2 + tq;
                        const int ta = (int)((0x3333222110211000ull >> (4 * ti)) & 15ull), tb = (int)((0x3210210100332321ull >> (4 * ti)) & 15ull);
                        lts[tq] = dir ? tb : ta; mts[tq] = dir ? ta : tb; }
                    f32x4 accs[2]; accs[0] = (f32x4){0.f, 0.f, 0.f, 0.f}; accs[1] = accs[0];
                    if (wave >= 3) {
#pragma unroll
                        for (int kh = 0; kh < 2; ++kh) {
                            bf16x8 kaf[2][4], qbf[2][4];
#pragma unroll
                            for (int tq = 0; tq < 2; ++tq)
#pragma unroll
                                for (int k4 = 0; k4 < 4; ++k4) {
                                    kaf[tq][k4] = *(const LAS bf16x8*)(Kb + (LB1 + X4[k4] + mts[tq] * 4096) + kh * 16384);
                                    qbf[tq][k4] = *(const LAS bf16x8*)(Qb + (LB1 + X4[k4] + lts[tq] * 4096) + kh * 16384); }
                            __builtin_amdgcn_sched_barrier(0);
#pragma unroll
                            for (int k4 = 0; k4 < 4; ++k4)
#pragma unroll
                                for (int tq = 0; tq < 2; ++tq) accs[tq] = MFMA16(kaf[tq][k4], qbf[tq][k4], accs[tq]);
                            __builtin_amdgcn_sched_barrier(0);
                        }
                    }
                    float rvv[2]; f32x4 cvv[2];
#pragma unroll
                    for (int tq = 0; tq < 2; ++tq) { rvv[tq] = rowv[lts[tq] * 16 + frs]; cvv[tq] = *(LAS const f32x4*)(colv + mts[tq] * 16 + 4 * fqs); }
#pragma unroll
                    for (int tq = 0; tq < 2; ++tq) {
                        const int lt = lts[tq], mt = mts[tq]; const f32x4 acc = accs[tq];
                        const int l = lt * 16 + frs; const float rv = rvv[tq]; float o[4]; float s = 0.f;
#pragma unroll
                        for (int r = 0; r < 4; ++r) { const int m = mt * 16 + 4 * fqs + r; const bool ok = dir ? (m > l) : (m <= l); const float w = ok ? __expf(rv + cvv[tq][r]) : 0.f; o[r] = acc[r] * w; s += o[r]; }
                        *(LAS u32x2*)(att + l * ATT_LD + mt * 16 + 4 * fqs) = (u32x2){pk2(o[0], o[1]), pk2(o[2], o[3])};
                        s = rows_sum4(s);
                        if (fqs == 0) denp[l * 4 + mt] = s;
                    }
                }
                }
            }
            asm volatile("" : "+v"(vf0), "+v"(vf1), "+v"(gf_n), "+v"(gi_n));
            if (hasn) { vfn0 = *(const bf16x8*)(Vw + ttn); vfn1 = *(const bf16x8*)(Vw + ttn + 32); }
            if (hasn) {
                scan_dma_tile(lds + S2_K + ((st + 1) & 1) * 32768, Kh + (size_t)ttn * D, wave, lane);
                if (latn) scan_dma_tile(lds + S2_Q + ((st + 1) & 1) * 32768, Qh + (size_t)ttn * D, wave, lane);
            }
            if (lat) {
                __builtin_amdgcn_sched_barrier(0);
                if (!(VAR & 4)) {
                bf16x8 nfr;
                { u32x4 w; w.x = pk2(nA[0][0], nA[0][1]); w.y = pk2(nA[0][2], nA[0][3]); w.z = pk2(nA[1][0], nA[1][1]); w.w = pk2(nA[1][2], nA[1][3]); nfr = __builtin_bit_cast(bf16x8, w); }
                u32x2 qlA[4], qhA[4], qlB[4], qhB[4];
#define S3_QISSUE(kb_, ql_, qh_) do { const unsigned alo = (unsigned)(size_t)(Qb + (LB2 + X4[(kb_) & 3]) + ((kb_) >> 2) * 16384), ahi = (unsigned)(size_t)(Qb + (LB3 + X4[(kb_) & 3]) + ((kb_) >> 2) * 16384); \
                    asm volatile("ds_read_b64 %0, %8\n\tds_read_b64 %1, %9\n\tds_read_b64 %2, %8 offset:4096\n\tds_read_b64 %3, %9 offset:4096\n\t" \
                                 "ds_read_b64 %4, %8 offset:8192\n\tds_read_b64 %5, %9 offset:8192\n\tds_read_b64 %6, %8 offset:12288\n\tds_read_b64 %7, %9 offset:12288" \
                                 : "=&v"(ql_[0]), "=&v"(qh_[0]), "=&v"(ql_[1]), "=&v"(qh_[1]), "=&v"(ql_[2]), "=&v"(qh_[2]), "=&v"(ql_[3]), "=&v"(qh_[3]) : "v"(alo), "v"(ahi) : "memory"); } while (0)
#define S3_QISSUE_AT(off_, ql_, qh_) do { const unsigned alo = (unsigned)(size_t)(Qb + LB2 + (off_)), ahi = (unsigned)(size_t)(Qb + LB3 + (off_)); \
                    asm volatile("ds_read_b64 %0, %8\n\tds_read_b64 %1, %9\n\tds_read_b64 %2, %8 offset:4096\n\tds_read_b64 %3, %9 offset:4096\n\t" \
                                 "ds_read_b64 %4, %8 offset:8192\n\tds_read_b64 %5, %9 offset:8192\n\tds_read_b64 %6, %8 offset:12288\n\tds_read_b64 %7, %9 offset:12288" \
                                 : "=&v"(ql_[0]), "=&v"(qh_[0]), "=&v"(ql_[1]), "=&v"(qh_[1]), "=&v"(ql_[2]), "=&v"(qh_[2]), "=&v"(ql_[3]), "=&v"(qh_[3]) : "v"(alo), "v"(ahi) : "memory"); } while (0)
#define S3_QWAIT(N_, ql_, qh_) asm volatile("s_waitcnt lgkmcnt(" #N_ ")" : "+v"(ql_[0]), "+v"(qh_[0]), "+v"(ql_[1]), "+v"(qh_[1]), "+v"(ql_[2]), "+v"(qh_[2]), "+v"(ql_[3]), "+v"(qh_[3]) :: "memory")
                S3_QISSUE(0, qlA, qhA);
#pragma unroll
                for (int kb = 0; kb < 8; ++kb) {
                    u32x4 w; w.x = pk2(S[2 * kb][0], S[2 * kb][1]); w.y = pk2(S[2 * kb][2], S[2 * kb][3]); w.z = pk2(S[2 * kb + 1][0], S[2 * kb + 1][1]); w.w = pk2(S[2 * kb + 1][2], S[2 * kb + 1][3]);
                    const bf16x8 sbk = __builtin_bit_cast(bf16x8, w);
                    if (kb & 1) { if (kb < 7) { S3_QISSUE(kb + 1, qlA, qhA); S3_QWAIT(8, qlB, qhB); }
                        else if (a.is_ml) { S3_QISSUE_AT(64 * ((wave & 3) ^ Fhp) + (wave >> 2) * 16384, qlA, qhA); S3_QWAIT(8, qlB, qhB); }
                        else S3_QWAIT(0, qlB, qhB); }
                    else { S3_QISSUE(kb + 1, qlB, qhB); S3_QWAIT(8, qlA, qhA); }
#pragma unroll
                    for (int lt = 0; lt < 4; ++lt) {
                        const u32x2 lo = (kb & 1) ? qlB[lt] : qlA[lt], hi = (kb & 1) ? qhB[lt] : qhA[lt];
                        const u32x4 qa = (u32x4){lo.x, lo.y, hi.x, hi.y};
                        oacc[lt] = MFMA16(__builtin_bit_cast(bf16x8, qa), sbk, oacc[lt]);
                    }
                }
#undef S3_QISSUE
                if (a.is_ml) {
                    S3_QWAIT(0, qlA, qhA);
#undef S3_QWAIT
#undef S3_QISSUE_AT
#pragma unroll
                    for (int lt = 0; lt < 4; ++lt) {
                        const u32x4 qa = (u32x4){qlA[lt].x, qlA[lt].y, qhA[lt].x, qhA[lt].y};
                        const f32x4 qp = MFMA16(__builtin_bit_cast(bf16x8, qa), nfr, ((f32x4){0.f, 0.f, 0.f, 0.f}));
                        if (frs == 0) {
                            const unsigned qa_ = (unsigned)(size_t)(qn + lt * 16 + 4 * fqs);
                            asm volatile("s_nop 7\n\ts_nop 7\n\tds_add_f32 %0, %1\n\tds_add_f32 %0, %2 offset:4\n\tds_add_f32 %0, %3 offset:8\n\tds_add_f32 %0, %4 offset:12" :: "v"(qa_), "v"(qp[0]), "v"(qp[1]), "v"(qp[2]), "v"(qp[3]) : "memory");
                        }
                    }
                }
                }
            }
            if (a.is_ml && wave == 0 && hasn) {
                S3_STAGE1((st + 1) & 1, gf_n, gi_n);
                if (hasnn) { gf_n = Gf[ttnn + sidx]; gi_n = Gi[ttnn + sidx]; }
            }
            const float cdec = vs_[321];
            if (!(VAR & 8)) {
                bf16x8 vs[2];
#pragma unroll
                for (int ks = 0; ks < 2; ++ks) { const u32x4 vw = __builtin_bit_cast(u32x4, ks ? vf1 : vf0); const LAS float* kp = kd + 32 * ks + 8 * fqs; u32x4 o;
#pragma unroll
                    for (int j = 0; j < 4; ++j) o[j] = pk2(bflo(vw[j]) * kp[2 * j], bfhi(vw[j]) * kp[2 * j + 1]);
                    vs[ks] = __builtin_bit_cast(bf16x8, o); }
                bf16x8 kdf[2];
                if (a.is_ml) {
#pragma unroll
                    for (int ks = 0; ks < 2; ++ks) { const LAS float* kp = kd + 32 * ks + 8 * fqs; u32x4 o;
#pragma unroll
                        for (int j = 0; j < 4; ++j) o[j] = pk2(kp[2 * j], kp[2 * j + 1]);
                        kdf[ks] = __builtin_bit_cast(bf16x8, o); }
                    nA[0] = nA[0] * cdec; nA[1] = nA[1] * cdec;
                }
                v4i16_t tA[8], tB[8];
#define S3_KISSUE(g_, t_) do { \
                    const unsigned a00 = (unsigned)(size_t)(Kb + (TB0 + W8[(2 * (g_)) & 7]) + ((2 * (g_)) >> 3) * 16384), a01 = (unsigned)(size_t)(Kb + (TB1 + W8[(2 * (g_)) & 7]) + ((2 * (g_)) >> 3) * 16384); \
                    const unsigned a10 = (unsigned)(size_t)(Kb + (TB0 + W8[(2 * (g_) + 1) & 7]) + ((2 * (g_) + 1) >> 3) * 16384), a11 = (unsigned)(size_t)(Kb + (TB1 + W8[(2 * (g_) + 1) & 7]) + ((2 * (g_) + 1) >> 3) * 16384); \
                    asm volatile("ds_read_b64_tr_b16 %0, %8\n\tds_read_b64_tr_b16 %1, %9\n\tds_read_b64_tr_b16 %2, %8 offset:8192\n\tds_read_b64_tr_b16 %3, %9 offset:8192\n\t" \
                                 "ds_read_b64_tr_b16 %4, %10\n\tds_read_b64_tr_b16 %5, %11\n\tds_read_b64_tr_b16 %6, %10 offset:8192\n\tds_read_b64_tr_b16 %7, %11 offset:8192" \
                                 : "=&v"(t_[0]), "=&v"(t_[1]), "=&v"(t_[2]), "=&v"(t_[3]), "=&v"(t_[4]), "=&v"(t_[5]), "=&v"(t_[6]), "=&v"(t_[7]) : "v"(a00), "v"(a01), "v"(a10), "v"(a11) : "memory"); } while (0)
#define S3_KISSUE_AT(p00_, p01_, p10_, p11_, t_) do { \
                    const unsigned a00 = (unsigned)(size_t)(p00_), a01 = (unsigned)(size_t)(p01_), a10 = (unsigned)(size_t)(p10_), a11 = (unsigned)(size_t)(p11_); \
                    asm volatile("ds_read_b64_tr_b16 %0, %8\n\tds_read_b64_tr_b16 %1, %9\n\tds_read_b64_tr_b16 %2, %8 offset:8192\n\tds_read_b64_tr_b16 %3, %9 offset:8192\n\t" \
                                 "ds_read_b64_tr_b16 %4, %10\n\tds_read_b64_tr_b16 %5, %11\n\tds_read_b64_tr_b16 %6, %10 offset:8192\n\tds_read_b64_tr_b16 %7, %11 offset:8192" \
                                 : "=&v"(t_[0]), "=&v"(t_[1]), "=&v"(t_[2]), "=&v"(t_[3]), "=&v"(t_[4]), "=&v"(t_[5]), "=&v"(t_[6]), "=&v"(t_[7]) : "v"(a00), "v"(a01), "v"(a10), "v"(a11) : "memory"); } while (0)
                const int nw8a = 64 * ((wave & 3) ^ q4) + 32 * (0 ^ (fq & 1)) + (wave >> 2) * 16384, nw8b = 64 * ((wave & 3) ^ q4) + 32 * (1 ^ (fq & 1)) + (wave >> 2) * 16384;
#define S3_KWAIT(N_, t_) asm volatile("s_waitcnt lgkmcnt(" #N_ ")" : "+v"(t_[0]), "+v"(t_[1]), "+v"(t_[2]), "+v"(t_[3]), "+v"(t_[4]), "+v"(t_[5]), "+v"(t_[6]), "+v"(t_[7]) :: "memory")
#define S3_UPD(dt_, lo0_, hi0_, lo1_, hi1_) do { f32x4 acc = S[dt_] * cdec; \
                        const bf16x8 ka0 = __builtin_shufflevector(lo0_, hi0_, 0, 1, 2, 3, 4, 5, 6, 7), ka1 = __builtin_shufflevector(lo1_, hi1_, 0, 1, 2, 3, 4, 5, 6, 7); \
                        acc = MFMA16(ka0, vs[0], acc); acc = MFMA16(ka1, vs[1], acc); \
                        S[dt_] = acc; } while (0)
                S3_KISSUE(0, tA);
#pragma unroll
                for (int g = 0; g < 8; ++g) {
                    if (g & 1) { if (g < 7) { S3_KISSUE(g + 1, tA); S3_KWAIT(8, tB); }
                        else if (a.is_ml) { S3_KISSUE_AT(Kb + TB0 + nw8a, Kb + TB1 + nw8a, Kb + TB0 + nw8b, Kb + TB1 + nw8b, tA); S3_KWAIT(8, tB); }
                        else S3_KWAIT(0, tB);
                        S3_UPD(2 * g, tB[0], tB[1], tB[2], tB[3]); S3_UPD(2 * g + 1, tB[4], tB[5], tB[6], tB[7]); }
                    else { S3_KISSUE(g + 1, tB); S3_KWAIT(8, tA);
                        S3_UPD(2 * g, tA[0], tA[1], tA[2], tA[3]); S3_UPD(2 * g + 1, tA[4], tA[5], tA[6], tA[7]); }
                }
#undef S3_UPD
#undef S3_KISSUE
                if (a.is_ml) {
                    S3_KWAIT(0, tA);
#pragma unroll
                    for (int t = 0; t < 2; ++t) {
                        const bf16x8 ka0 = __builtin_shufflevector(tA[4 * t], tA[4 * t + 1], 0, 1, 2, 3, 4, 5, 6, 7), ka1 = __builtin_shufflevector(tA[4 * t + 2], tA[4 * t + 3], 0, 1, 2, 3, 4, 5, 6, 7);
                        nA[t] = MFMA16(ka0, kdf[0], nA[t]); nA[t] = MFMA16(ka1, kdf[1], nA[t]);
                    }
                }
#undef S3_KWAIT
#undef S3_KISSUE_AT
            }
            asm volatile("s_waitcnt lgkmcnt(0)" ::: "memory"); __builtin_amdgcn_s_barrier(); asm volatile("" ::: "memory");
            const bf16x8 av0 = vf0, av1 = vf1;
            if (lat && !(VAR & 16)) {
#pragma unroll
                for (int lt = 0; lt < 4; ++lt) {
                    const int l0 = lt * 16 + 4 * fqs;
                    const f32x4 aqv = *(LAS const f32x4*)(aq + l0);
                    f32x4 qnv = aqv, emv = aqv, dv[4] = {aqv, aqv, aqv, aqv};
                    if (a.is_ml) { qnv = *(LAS const f32x4*)(qn + l0); emv = *(LAS const f32x4*)(emr + l0);
#pragma unroll
                        for (int r = 0; r < 4; ++r) dv[r] = *(LAS const f32x4*)(denp + (l0 + r) * 4); }
                    const bf16x8 a0 = *(const LAS bf16x8*)(att + (lt * 16 + frs) * ATT_LD + 8 * fqs), a1 = *(const LAS bf16x8*)(att + (lt * 16 + frs) * ATT_LD + 32 + 8 * fqs);
                    __builtin_amdgcn_sched_barrier(0);
                    f32x4 acc = oacc[lt];
                    float hs[4];
#pragma unroll
                    for (int r = 0; r < 4; ++r) { acc[r] *= aqv[r];
                        if (a.is_ml) { const float den = (dv[r][0] + dv[r][1]) + (dv[r][2] + dv[r][3]) + aqv[r] * qnv[r]; hs[r] = __builtin_amdgcn_rcpf(fmaxf(fabsf(den), emv[r])); } else hs[r] = 1.f; }
                    acc = MFMA16(a0, av0, acc); acc = MFMA16(a1, av1, acc);
#pragma unroll
                    for (int r = 0; r < 4; ++r) otile[(lt * 16 + 4 * fqs + r) * 16 + frs] = f2bf(acc[r] * hs[r]);
                }
                tprev = tt0 - TC;
            } else tprev = -1;
            if (a.is_ml) {
                if (tid >= 448) qn2[((st + 1) & 1) * 64 + (tid - 448)] = 0.f;
            }
            asm volatile("s_waitcnt vmcnt(0)" ::: "memory");
            __syncthreads();
            vf0 = vfn0; vf1 = vfn1;
        }
        if (tprev >= 0) { asm volatile("s_waitcnt lgkmcnt(0)" ::: "memory"); const u32x4 oa = *(LAS const u32x4*)(otile + lane * 16), ob = *(LAS const u32x4*)(otile + lane * 16 + 8); u32x4* dp = (u32x4*)(Oo + (size_t)(tprev + lane) * D); dp[0] = oa; dp[1] = ob;
            asm volatile("s_waitcnt lgkmcnt(0)" ::: "memory"); }
#undef S3_STAGE1
    }
}

template <int ACT  > __device__ __forceinline__ void phase4_one(const bf16_t* Of, const bf16_t* Ob, const bf16_t* Ga, bf16_t* Out, int wave, int lane) {
    const int gw = blockIdx.x * NWAVES + wave, NGW = gridDim.x * NWAVES;
    if (NGW == 2048) {
        u32x4 f[2], bb[2], gg[2];
#pragma unroll
        for (int j = 0; j < 2; ++j) { f[j] = ld_nt((const u32x4*)(Of + (size_t)gw * D) + lane + 64 * j); bb[j] = ld_nt((const u32x4*)(Ob + (size_t)gw * D) + lane + 64 * j); gg[j] = ld_nt((const u32x4*)(Ga + (size_t)gw * D) + lane + 64 * j); }
#pragma unroll
        for (int k = 0; k < 16; ++k) {
            const int R = gw + 2048 * k; u32x4 nf[2], nb[2], ng[2];
            if (k < 15) { const int Rn = R + 2048;
#pragma unroll
                for (int j = 0; j < 2; ++j) { nf[j] = ld_nt((const u32x4*)(Of + (size_t)Rn * D) + lane + 64 * j); nb[j] = ld_nt((const u32x4*)(Ob + (size_t)Rn * D) + lane + 64 * j); ng[j] = ld_nt((const u32x4*)(Ga + (size_t)Rn * D) + lane + 64 * j); } }
            __builtin_amdgcn_sched_barrier(0);
            u32x4* op = (u32x4*)(Out + (size_t)R * D);
#pragma unroll
            for (int j = 0; j < 2; ++j) {
                float v[8]; float s = 0.f;
#pragma unroll
                for (int i = 0; i < 4; ++i) { v[2 * i] = bflo(f[j][i]) + bflo(bb[j][i]); v[2 * i + 1] = bfhi(f[j][i]) + bfhi(bb[j][i]); s += v[2 * i] + v[2 * i + 1]; }
                const float mean = half_sum(s) * (1.f / 256.f); float s2 = 0.f;
#pragma unroll
                for (int i = 0; i < 8; ++i) { v[i] -= mean; s2 += v[i] * v[i]; }
                const float rstd = 1.f / sqrtf(half_sum(s2) * (1.f / 256.f) + LN_EPS);
                u32x4 o;
#pragma unroll
                for (int i = 0; i < 4; ++i) { const float ga = bflo(gg[j][i]), gb = bfhi(gg[j][i]); o[i] = pk2(v[2 * i] * rstd * (ACT ? sigmoid_f(ga) : silu_f(ga)), v[2 * i + 1] * rstd * (ACT ? sigmoid_f(gb) : silu_f(gb))); }
                op[lane + 64 * j] = o;
            }
            if (k < 15) {
#pragma unroll
                for (int j = 0; j < 2; ++j) { f[j] = nf[j]; bb[j] = nb[j]; gg[j] = ng[j]; } }
            __builtin_amdgcn_sched_barrier(0);
        }
        return;
    }
    u32x4 f[2], bb[2], gg[2], nf[2], nb[2], ng[2];
    if (gw < NLAT) {
#pragma unroll
        for (int j = 0; j < 2; ++j) { f[j] = ld_nt((const u32x4*)(Of + (size_t)gw * D) + lane + 64 * j); bb[j] = ld_nt((const u32x4*)(Ob + (size_t)gw * D) + lane + 64 * j); gg[j] = ld_nt((const u32x4*)(Ga + (size_t)gw * D) + lane + 64 * j); } }
    for (int R = gw; R < NLAT; R += NGW) {
        const int Rn = R + NGW;
        if (Rn < NLAT) {
#pragma unroll
            for (int j = 0; j < 2; ++j) { nf[j] = ld_nt((const u32x4*)(Of + (size_t)Rn * D) + lane + 64 * j); nb[j] = ld_nt((const u32x4*)(Ob + (size_t)Rn * D) + lane + 64 * j); ng[j] = ld_nt((const u32x4*)(Ga + (size_t)Rn * D) + lane + 64 * j); } }
        u32x4* op = (u32x4*)(Out + (size_t)R * D);
#pragma unroll
        for (int j = 0; j < 2; ++j) {
            float v[8]; float s = 0.f;
#pragma unroll
            for (int i = 0; i < 4; ++i) { v[2 * i] = bflo(f[j][i]) + bflo(bb[j][i]); v[2 * i + 1] = bfhi(f[j][i]) + bfhi(bb[j][i]); s += v[2 * i] + v[2 * i + 1]; }
            const float mean = half_sum(s) * (1.f / 256.f); float s2 = 0.f;
#pragma unroll
            for (int i = 0; i < 8; ++i) { v[i] -= mean; s2 += v[i] * v[i]; }
            const float rstd = 1.f / sqrtf(half_sum(s2) * (1.f / 256.f) + LN_EPS);
            u32x4 o;
#pragma unroll
            for (int i = 0; i < 4; ++i) { const float ga = bflo(gg[j][i]), gb = bfhi(gg[j][i]); o[i] = pk2(v[2 * i] * rstd * (ACT ? sigmoid_f(ga) : silu_f(ga)), v[2 * i + 1] * rstd * (ACT ? sigmoid_f(gb) : silu_f(gb))); }
            op[lane + 64 * j] = o;
        }
#pragma unroll
        for (int j = 0; j < 2; ++j) { f[j] = nf[j]; bb[j] = nb[j]; gg[j] = ng[j]; }
    }
}

struct SchedDense { int G, c, nM, nN, rep; __device__ __forceinline__ void a_ready(const Unit&) const {} __device__ __forceinline__ void done(const Unit&) const {}
    __device__ __forceinline__ bool next(int i, Unit& u) const {
        const int x = c & 7, y = c >> 3, nxc = G >> 3; int q = i * nxc + y; const int ntot = (nM >> 3) * 4; if (q >= rep * ntot) return false; q %= ntot; u.pm = x + 8 * (q >> 2); u.pn = q & 3; return true; } };
struct EpiY {
    static constexpr bool PERM = true, AFTER_DRAIN = false;
    bf16_t* Y; const bf16_t* gate; int pass;
    __device__ __forceinline__ void operator()(const f32x4 (&acc)[2][2][4][2], const Unit& u, int wr, int wc, int fr, int fq) const {
        int cb = wc * 32 + 8 * fq; asm volatile("" : "+v"(cb));
#pragma unroll
        for (int ai = 0; ai < 2; ++ai) {
            u32x4 g[4][2], y[4][2];
#pragma unroll
            for (int m = 0; m < 4; ++m)
#pragma unroll
                for (int bj = 0; bj < 2; ++bj) { const int r = u.pm * 256 + ai * 128 + wr * 64 + m * 16 + fr; const size_t off = (size_t)r * D + u.pn * 256 + bj * 128 + cb;
                    g[m][bj] = *(const u32x4*)(gate + off); if (pass) y[m][bj] = *(const u32x4*)(Y + off); }
#pragma unroll
            for (int m = 0; m < 4; ++m)
#pragma unroll
                for (int bj = 0; bj < 2; ++bj) { const int r = u.pm * 256 + ai * 128 + wr * 64 + m * 16 + fr; const size_t off = (size_t)r * D + u.pn * 256 + bj * 128 + cb;
                    const f32x4 v0 = acc[ai][bj][m][0], v1 = acc[ai][bj][m][1]; const u32x4 gg = g[m][bj];
                    float o[8] = {bflo(gg.x) * v0[0], bfhi(gg.x) * v0[1], bflo(gg.y) * v0[2], bfhi(gg.y) * v0[3], bflo(gg.z) * v1[0], bfhi(gg.z) * v1[1], bflo(gg.w) * v1[2], bfhi(gg.w) * v1[3]};
                    if (pass) { const u32x4 yy = y[m][bj]; o[0] += bflo(yy.x); o[1] += bfhi(yy.x); o[2] += bflo(yy.y); o[3] += bfhi(yy.y); o[4] += bflo(yy.z); o[5] += bfhi(yy.z); o[6] += bflo(yy.w); o[7] += bfhi(yy.w); }
                    *(u32x4*)(Y + off) = (u32x4){pk2(o[0], o[1]), pk2(o[2], o[3]), pk2(o[4], o[5]), pk2(o[6], o[7])}; }
        }
    }
};
struct EpiY2 {
    static constexpr bool PERM = true, AFTER_DRAIN = false;
    bf16_t* Y2;
    __device__ __forceinline__ void operator()(const f32x4 (&acc)[2][2][4][2], const Unit& u, int wr, int wc, int fr, int fq) const {
#pragma unroll
        for (int ai = 0; ai < 2; ++ai)
#pragma unroll
            for (int m = 0; m < 4; ++m) { const int r = u.pm * 256 + ai * 128 + wr * 64 + m * 16 + fr;
#pragma unroll
                for (int bj = 0; bj < 2; ++bj) { const f32x4 v0 = acc[ai][bj][m][0], v1 = acc[ai][bj][m][1];
                    *(u32x4*)(Y2 + (size_t)r * D + u.pn * 256 + bj * 128 + wc * 32 + 8 * fq) = (u32x4){pk2(v0[0], v0[1]), pk2(v0[2], v0[3]), pk2(v1[0], v1[1]), pk2(v1[2], v1[3])}; } }
    }
};
struct EpiZ {
    static constexpr bool PERM = false, AFTER_DRAIN = false;
    const float* x; const float* MOD; float* Z;
    __device__ __forceinline__ void operator()(const f32x4 (&acc)[2][2][4][2], const Unit& u, int wr, int wc, int fr, int fq) const {
#pragma unroll
        for (int ai = 0; ai < 2; ++ai)
#pragma unroll
            for (int m = 0; m < 4; ++m) { const int r = u.pm * 256 + ai * 128 + wr * 64 + m * 16 + fr, b = r >> 11;
#pragma unroll
                for (int bj = 0; bj < 2; ++bj)
#pragma unroll
                    for (int n = 0; n < 2; ++n) { const int c = u.pn * 256 + bj * 128 + wc * 32 + n * 16 + 4 * fq; const size_t off = (size_t)r * D + c;
                        const f32x4 xv = *(const f32x4*)(x + off), gv = *(const f32x4*)(MOD + (size_t)b * 6144 + 2048 + c);
                        *(f32x4*)(Z + off) = xv * DN_ALPHA + gv * acc[ai][bj][m][n]; } }
    }
};

constexpr int P7_U2F = 0, P7_LD = 1028, P7_PART = 16 * P7_LD * 4, P7_LOG = P7_PART + 8 * 16 * 48 * 4, P7_CNT = P7_LOG + 16 * 48 * 4, P7_PAR = 94208;
__device__ __forceinline__ void phase7(const Params& p, LAS unsigned char* lds, int tid, int wave, int lane) {
    const int G = gridDim.x, gw = blockIdx.x * NWAVES + wave, NGW = G * NWAVES;
    LAS float* u2f = (LAS float*)(lds + P7_U2F); LAS float* part = (LAS float*)(lds + P7_PART); LAS float* logt = (LAS float*)(lds + P7_LOG);
    LAS int* lcnt = (LAS int*)(lds + P7_CNT);
    if (tid < 32) lcnt[tid] = 0;
    LAS float* g1l = (LAS float*)(lds + P7_PAR); LAS float* b1l = g1l + 1024; LAS float* brl = g1l + 2048; LAS float* modl = g1l + 3072;
    const int per = (NLAT / 16 + G - 1) / G, bi0 = blockIdx.x * per, bi1 = (bi0 + per < NLAT / 16) ? bi0 + per : NLAT / 16, bfirst = (bi0 >> 7) < 15 ? (bi0 >> 7) : 15;
    { const float* MODg = (const float*)(p.ws + WS_MOD);
      lds_stage(g1l, p.in[I_LN1G], 1, 256, 0, tid); lds_stage(b1l, p.in[I_LN1B], 1, 256, 0, tid);
      if (tid < 36) brl[tid] = (tid < 4) ? p.in[I_BRG][tid] : p.in[I_BRE][tid - 4];
      lds_stage(modl, MODg + (size_t)bfirst * 6144 + 2048, 1, 768, 0, tid); lds_stage(modl + 3072, MODg + (size_t)((bfirst + 1 < 16) ? bfirst + 1 : 15) * 6144 + 2048, 1, 768, 0, tid); }
    __syncthreads();
    const float* MOD = (const float*)(p.ws + WS_MOD); const float* WR = (const float*)(p.ws + WS_WRT);
    bf16_t* U2 = (bf16_t*)(p.ws + WS_U2); int* rec = (int*)(p.ws + WS_TOKREC);
    const int fr = lane & 15, fq = lane >> 4;
    float wreg[32][3];
    { const float* bp = WR + (size_t)(wave * 128 + fq) * 48 + fr;
#pragma unroll
      for (int kk = 0; kk < 32; ++kk)
#pragma unroll
          for (int nt = 0; nt < 3; ++nt) wreg[kk][nt] = bp[(size_t)kk * 4 * 48 + 16 * nt]; }
    const bf16_t* Y2 = (const bf16_t*)(p.ws + WS_Y2); const float* xin = p.in[I_X];
    f32x4 zn[2][4]; u32x2 yn[2][4];
    if (bi0 < NLAT / 16) {
#pragma unroll
        for (int rr = 0; rr < 2; ++rr)
#pragma unroll
            for (int j = 0; j < 4; ++j) { const size_t R = (size_t)(bi0 * 16 + wave * 2 + rr); zn[rr][j] = ld_nt((const f32x4*)(xin + R * D) + lane + 64 * j); yn[rr][j] = ld_nt((const u32x2*)(Y2 + R * D) + lane + 64 * j); } }
    for (int bi = bi0; bi < bi1; ++bi) {
        LAS const float* mdl = modl + ((bi >> 7) - bfirst) * 3072;
#pragma unroll
        for (int rr = 0; rr < 2; ++rr) {
            const int rl = wave * 2 + rr, R = bi * 16 + rl, b = R >> 11;
            f32x4 zc[4];
            { LAS const float* gv = mdl;
#pragma unroll
              for (int j = 0; j < 4; ++j) { __builtin_amdgcn_sched_barrier(0); const f32x4 g = *(LAS const f32x4*)(gv + 4 * lane + 256 * j); const u32x2 y = yn[rr][j];
                  zc[j] = zn[rr][j] * DN_ALPHA + g * (f32x4){bflo(y.x), bfhi(y.x), bflo(y.y), bfhi(y.y)}; } }
            if (bi + 1 < bi1) {
#pragma unroll
                for (int j = 0; j < 4; ++j) { const size_t Rn = (size_t)((bi + 1) * 16 + rl); zn[rr][j] = ld_nt((const f32x4*)(xin + Rn * D) + lane + 64 * j); yn[rr][j] = ld_nt((const u32x2*)(Y2 + Rn * D) + lane + 64 * j); } }
            float* zr = p.out + (size_t)R * D;
            f32x4 v[4]; float s = 0.f;
#pragma unroll
            for (int j = 0; j < 4; ++j) { v[j] = zc[j]; s += (v[j].x + v[j].y) + (v[j].z + v[j].w); }
            float mean = wave_sum(s) * (1.f / D); float s2 = 0.f;
#pragma unroll
            for (int j = 0; j < 4; ++j) { v[j] = v[j] - mean; s2 += (v[j].x * v[j].x + v[j].y * v[j].y) + (v[j].z * v[j].z + v[j].w * v[j].w); }
            float rstd = 1.f / sqrtf(wave_sum(s2) * (1.f / D) + LN_EPS);
            s = 0.f;
#pragma unroll
            for (int j = 0; j < 4; ++j) { __builtin_amdgcn_sched_barrier(0); const int col = 4 * lane + 256 * j; v[j] = v[j] * rstd * *(LAS const f32x4*)(g1l + col) + *(LAS const f32x4*)(b1l + col); st_nt((u32x2*)zr + lane + 64 * j, (u32x2){pk2(v[j].x, v[j].y), pk2(v[j].z, v[j].w)});     s += (v[j].x + v[j].y) + (v[j].z + v[j].w); }
            mean = wave_sum(s) * (1.f / D); s2 = 0.f;
#pragma unroll
            for (int j = 0; j < 4; ++j) { v[j] = v[j] - mean; s2 += (v[j].x * v[j].x + v[j].y * v[j].y) + (v[j].z * v[j].z + v[j].w * v[j].w); }
            rstd = 1.f / sqrtf(wave_sum(s2) * (1.f / D) + LN_EPS);
            LAS const float* sh = mdl + 1024; LAS const float* sc = mdl + 2048;
            u32x2* o8 = (u32x2*)(U2 + (size_t)R * D);
#pragma unroll
            for (int j = 0; j < 4; ++j) { __builtin_amdgcn_sched_barrier(0); const int col = 4 * lane + 256 * j; v[j] = v[j] * rstd * (*(LAS const f32x4*)(sc + col) + 1.f) + *(LAS const f32x4*)(sh + col);
                o8[lane + 64 * j] = (u32x2){pk2(v[j].x, v[j].y), pk2(v[j].z, v[j].w)};
                *(LAS f32x4*)(u2f + rl * P7_LD + col) = v[j]; }
        }
        __syncthreads();
        {
            f32x4 acc[3];
#pragma unroll
            for (int nt = 0; nt < 3; ++nt) acc[nt] = (f32x4){0.f, 0.f, 0.f, 0.f};
            const LAS float* ap = u2f + fr * P7_LD + wave * 128 + fq;
#pragma unroll
            for (int kk = 0; kk < 32; ++kk) {
                const float av = ap[4 * kk];
#pragma unroll
                for (int nt = 0; nt < 3; ++nt) acc[nt] = __builtin_amdgcn_mfma_f32_16x16x4f32(av, wreg[kk][nt], acc[nt], 0, 0, 0);
            }
#pragma unroll
            for (int nt = 0; nt < 3; ++nt)
#pragma unroll
                for (int r = 0; r < 4; ++r) part[(wave * 16 + 4 * fq + r) * 48 + 16 * nt + fr] = acc[nt][r];
        }
        __syncthreads();
        for (int i = tid; i < 16 * 48; i += NTHREADS) { float q = 0.f;
#pragma unroll
            for (int w = 0; w < 8; ++w) q += part[w * 16 * 48 + i];
            logt[i] = q; }
        __syncthreads();
        if (tid < 16) {
            const int R = bi * 16 + tid; const LAS float* lg = logt + tid * 48;
            float gl[4];
#pragma unroll
            for (int i = 0; i < 4; ++i) gl[i] = lg[i] + brl[i];
            int gi = 0; float gm = gl[0];
#pragma unroll
            for (int i = 1; i < 4; ++i) if (gl[i] > gm) { gm = gl[i]; gi = i; }
            float gsum = 0.f;
#pragma unroll
            for (int i = 0; i < 4; ++i) gsum += __expf(gl[i] - gm);
            const float pg = __builtin_amdgcn_rcpf(gsum);
            int e0 = 0, e1 = -1; float m0 = -3.0e38f, m1 = -3.0e38f;
            for (int j = 0; j < 8; ++j) { const float x = lg[4 + gi * 8 + j] + brl[4 + gi * 8 + j];
                if (x > m0) { m1 = m0; e1 = e0; m0 = x; e0 = j; } else if (x > m1) { m1 = x; e1 = j; } }
            const float p1 = __expf(m1 - m0); const float rc1 = __builtin_amdgcn_rcpf(1.f + p1); const float w0 = pg * rc1, w1 = pg * p1 * rc1;
            const int E0 = gi * 8 + e0, E1 = gi * 8 + e1;
            const int r0 = atomicAdd((int*)&lcnt[E0], 1), r1 = atomicAdd((int*)&lcnt[E1], 1);
            int* rr = rec + (size_t)R * 8; rr[0] = E0; rr[1] = E1; rr[2] = r0; rr[3] = r1; rr[4] = __float_as_int(w0); rr[5] = __float_as_int(w1); rr[6] = (int)blockIdx.x; rr[7] = 0;
        }
    }
    __syncthreads();
    if (tid < 32) { const int base = atomicAdd((int*)(p.ws + WS_CTL) + tid, lcnt[tid]); ((int*)(p.ws + WS_BASE))[blockIdx.x * 32 + tid] = base; }
    {
        __syncthreads();
        LAS float* scr = (LAS float*)(lds + wave * 16640);
        constexpr int I13 = 16 * 8, I2 = 8 * 16;
        for (int it = gw; it < 32 * (2 * I13 + I2); it += NGW) {
            const int e = it / (2 * I13 + I2); int r = it % (2 * I13 + I2);
            bf16_t* w13 = (bf16_t*)(p.ws + WS_W13T) + (size_t)e * 1024 * 1024; bf16_t* w2 = (bf16_t*)(p.ws + WS_W2T) + (size_t)e * 1024 * 512;
            if (r < I13) { transpose_item64<2>(p.in[I_WE1] + (size_t)e * 1024 * 512, 1024, 512, w13, scr, r, lane); continue; } r -= I13;
            if (r < I13) { transpose_item64<3>(p.in[I_WE3] + (size_t)e * 1024 * 512, 1024, 512, w13, scr, r, lane); continue; } r -= I13;
            transpose_item64<0>(p.in[I_WE2] + (size_t)e * 512 * 1024, 512, 1024, w2, scr, r, lane);
        }
    }
}

__device__ __forceinline__ void phase8(const Params& p, LAS unsigned char* lds, int tid, int wave, int lane) {
    const int G = gridDim.x, gw = blockIdx.x * NWAVES + wave, NGW = G * NWAVES;
    LAS int* poff = (LAS int*)lds;
    if (tid == 0) { const int* gc = (const int*)(p.ws + WS_CTL); int off = 0;
        for (int e = 0; e < 32; ++e) { const int c = gc[e]; poff[e] = off; poff[32 + e] = c; off += ((c + 255) >> 8) << 8; }
        poff[64] = off >> 8; }
    __syncthreads();
    const int ntiles = poff[64];
    if (blockIdx.x == 0) {
        int* te = (int*)(p.ws + WS_TILEEXP);
        for (int t = tid; t < 288; t += NTHREADS) { int ex = 31; for (int e = 0; e < 32; ++e) { const int c = poff[32 + e]; const int pe = poff[e] + (((c + 255) >> 8) << 8); if (t * 256 < pe) { ex = e; break; } } te[t] = ex; }
        if (tid == 0) ((int*)(p.ws + WS_CTL))[64] = ntiles;
    }
    const int* rec = (const int*)(p.ws + WS_TOKREC); const int* base = (const int*)(p.ws + WS_BASE);
    const bf16_t* U2 = (const bf16_t*)(p.ws + WS_U2); bf16_t* Xs = (bf16_t*)(p.ws + WS_XS); int* ts = (int*)(p.ws + WS_TOKSLOT);
    if (NGW == 2048) {
        LAS int* bl = (LAS int*)(lds + 1024);
        lds_stage((LAS float*)bl, (const float*)base, 1, 2048, 0, tid);
        __syncthreads();
        u32x4 ra, rb, ua, uc;
        { const u32x4* rr = (const u32x4*)(rec + (size_t)gw * 8); ra = rr[0]; rb = rr[1]; const u32x4* src = (const u32x4*)(U2 + (size_t)gw * D); ua = ld_nt(src + lane); uc = ld_nt(src + lane + 64); }
#pragma unroll
        for (int k = 0; k < 16; ++k) {
            const int R = gw + 2048 * k; u32x4 nra = ra, nrb = rb, na = ua, nc = uc;
            if (k < 15) { const u32x4* rr = (const u32x4*)(rec + (size_t)(R + 2048) * 8); nra = rr[0]; nrb = rr[1]; const u32x4* src = (const u32x4*)(U2 + (size_t)(R + 2048) * D); na = ld_nt(src + lane); nc = ld_nt(src + lane + 64); }
            __builtin_amdgcn_sched_barrier(0);
            const int E0 = (int)ra.x, E1 = (int)ra.y, lr0 = (int)ra.z, lr1 = (int)ra.w, blk = (int)rb.z;
            const int s0 = poff[E0] + bl[blk * 32 + E0] + lr0, s1 = poff[E1] + bl[blk * 32 + E1] + lr1;
            u32x4* d0 = (u32x4*)(Xs + (size_t)s0 * D); u32x4* d1 = (u32x4*)(Xs + (size_t)s1 * D);
            d0[lane] = ua; d0[lane + 64] = uc; d1[lane] = ua; d1[lane + 64] = uc;
            if (lane == 0) { *(u32x4*)(ts + (size_t)R * 4) = (u32x4){(unsigned)s0, (unsigned)s1, rb.x, rb.y}; }
            ra = nra; rb = nrb; ua = na; uc = nc;
            __builtin_amdgcn_sched_barrier(0);
        }
    } else
    {
        int E0 = 0, E1 = 0, lr0 = 0, lr1 = 0, w0b = 0, w1b = 0, blk = 0; u32x4 ua = (u32x4){0u, 0u, 0u, 0u}, uc = ua;
        if (gw < NLAT) { const int* rr = rec + (size_t)gw * 8; E0 = rr[0]; E1 = rr[1]; lr0 = rr[2]; lr1 = rr[3]; w0b = rr[4]; w1b = rr[5]; blk = rr[6];
            const u32x4* src = (const u32x4*)(U2 + (size_t)gw * D); ua = ld_nt(src + lane); uc = ld_nt(src + lane + 64); }
        for (int R = gw; R < NLAT; R += NGW) {
            const int Rn = R + NGW; int nE0 = 0, nE1 = 0, nlr0 = 0, nlr1 = 0, nw0 = 0, nw1 = 0, nblk = 0; u32x4 na = ua, nc = uc;
            if (Rn < NLAT) { const int* rr = rec + (size_t)Rn * 8; nE0 = rr[0]; nE1 = rr[1]; nlr0 = rr[2]; nlr1 = rr[3]; nw0 = rr[4]; nw1 = rr[5]; nblk = rr[6];
                const u32x4* src = (const u32x4*)(U2 + (size_t)Rn * D); na = ld_nt(src + lane); nc = ld_nt(src + lane + 64); }
            const int s0 = poff[E0] + base[blk * 32 + E0] + lr0, s1 = poff[E1] + base[blk * 32 + E1] + lr1;
            u32x4* d0 = (u32x4*)(Xs + (size_t)s0 * D); u32x4* d1 = (u32x4*)(Xs + (size_t)s1 * D);
            d0[lane] = ua; d0[lane + 64] = uc; d1[lane] = ua; d1[lane + 64] = uc;
            if (lane == 0) { int* t4 = ts + (size_t)R * 4; t4[0] = s0; t4[1] = s1; t4[2] = w0b; t4[3] = w1b; }
            E0 = nE0; E1 = nE1; lr0 = nlr0; lr1 = nlr1; w0b = nw0; w1b = nw1; blk = nblk; ua = na; uc = nc;
        }
    }
    for (int e = 0; e < 32; ++e) { const int c = poff[32 + e]; const int lo = poff[e] + c, hi = poff[e] + (((c + 255) >> 8) << 8);
        for (int r = lo + gw; r < hi; r += NGW) { u32x4* d = (u32x4*)(Xs + (size_t)r * D); d[lane] = (u32x4){0u, 0u, 0u, 0u}; d[lane + 64] = (u32x4){0u, 0u, 0u, 0u}; } }
}

struct SchedMoe { int G, c; const int* tile_exp; int ntiles, rep; __device__ __forceinline__ void a_ready(const Unit&) const {} __device__ __forceinline__ void done(const Unit&) const {}
    __device__ __forceinline__ bool next(int i, Unit& u) const {
        const int x = c & 7, y = c >> 3, nxc = G >> 3; int q = i * nxc + y; const int t0 = (x * ntiles) >> 3, t1 = ((x + 1) * ntiles) >> 3, ntot = (t1 - t0) * 4; if (q >= rep * ntot) return false; q %= ntot;
        const int t = t0 + (q >> 2); u.pm = t; u.pn = tile_exp[t] * 4 + (q & 3); return true; } };
struct EpiH {
    static constexpr bool PERM = true, AFTER_DRAIN = false;
    bf16_t* Hs;
    __device__ __forceinline__ void operator()(const f32x4 (&acc)[2][2][4][2], const Unit& u, int wr, int wc, int fr, int fq) const {
        const int j = u.pn & 3;
#pragma unroll
        for (int ai = 0; ai < 2; ++ai)
#pragma unroll
            for (int m = 0; m < 4; ++m) { const int r = u.pm * 256 + ai * 128 + wr * 64 + m * 16 + fr; float o[8];
#pragma unroll
                for (int k = 0; k < 8; ++k) o[k] = silu_f(acc[ai][0][m][k >> 2][k & 3]) * acc[ai][1][m][k >> 2][k & 3];
                *(u32x4*)(Hs + (size_t)r * DE + j * 128 + wc * 32 + 8 * fq) = (u32x4){pk2(o[0], o[1]), pk2(o[2], o[3]), pk2(o[4], o[5]), pk2(o[6], o[7])}; }
    }
};
struct EpiYs {
    static constexpr bool PERM = true, AFTER_DRAIN = false;
    bf16_t* Ys;
    __device__ __forceinline__ void operator()(const f32x4 (&acc)[2][2][4][2], const Unit& u, int wr, int wc, int fr, int fq) const {
        const int j = u.pn & 3;
#pragma unroll
        for (int ai = 0; ai < 2; ++ai)
#pragma unroll
            for (int m = 0; m < 4; ++m) { const int r = u.pm * 256 + ai * 128 + wr * 64 + m * 16 + fr;
#pragma unroll
                for (int bj = 0; bj < 2; ++bj) { const f32x4 v0 = acc[ai][bj][m][0], v1 = acc[ai][bj][m][1];
                    *(u32x4*)(Ys + (size_t)r * D + j * 256 + bj * 128 + wc * 32 + 8 * fq) = (u32x4){pk2(v0[0], v0[1]), pk2(v0[2], v0[3]), pk2(v1[0], v1[1]), pk2(v1[2], v1[3])}; } }
    }
};

__device__ __forceinline__ void phase11(const Params& p, LAS unsigned char* lds, int tid, int wave, int lane) {
    const int gw = blockIdx.x * NWAVES + wave, NGW = gridDim.x * NWAVES;
    const float* MOD = (const float*)(p.ws + WS_MOD); const bf16_t* Ys = (const bf16_t*)(p.ws + WS_YS); const int* ts = (const int*)(p.ws + WS_TOKSLOT);
    LAS float* g2 = (LAS float*)lds; LAS float* b2 = g2 + 1024; LAS float* ggl = g2 + 2048;
    lds_stage(g2, p.in[I_LN2G], 1, 256, 0, tid); lds_stage(b2, p.in[I_LN2B], 1, 256, 0, tid); lds_stage(ggl, MOD + 5120, 16, 256, 6144, tid);
    __syncthreads();
    if (NGW == 2048) {
        u32x2 xq[3][4], yaq[3][4], ycq[3][4]; u32x4 rq[4];
#pragma unroll
        for (int q = 0; q < 3; ++q) rq[q] = *(const u32x4*)(ts + (size_t)(gw + 2048 * q) * 4);
#pragma unroll
        for (int q = 0; q < 2; ++q) { const int Rq = gw + 2048 * q; const int s0 = (int)rq[q].x, s1 = (int)rq[q].y;
#pragma unroll
            for (int j = 0; j < 4; ++j) { xq[q][j] = ld_nt((const u32x2*)(p.out + (size_t)Rq * D) + lane + 64 * j); yaq[q][j] = ld_nt((const u32x2*)(Ys + (size_t)s0 * D) + lane + 64 * j); ycq[q][j] = ld_nt((const u32x2*)(Ys + (size_t)s1 * D) + lane + 64 * j); } }
#pragma unroll
        for (int k = 0; k < 16; ++k) {
            const int R = gw + 2048 * k, c0 = k % 3, c2 = (k + 2) % 3;
            const float w0 = __uint_as_float(rq[k & 3].z), w1 = __uint_as_float(rq[k & 3].w);
            { const int s0n = (int)rq[(k + 2) & 3].x, s1n = (int)rq[(k + 2) & 3].y;
            if (k < 13) rq[(k + 3) & 3] = *(const u32x4*)(ts + (size_t)(R + 3 * 2048) * 4);
            if (k < 14) { const int Rn = R + 4096; const int s0 = s0n, s1 = s1n;
#pragma unroll
                for (int j = 0; j < 4; ++j) { xq[c2][j] = ld_nt((const u32x2*)(p.out + (size_t)Rn * D) + lane + 64 * j); yaq[c2][j] = ld_nt((const u32x2*)(Ys + (size_t)s0 * D) + lane + 64 * j); ycq[c2][j] = ld_nt((const u32x2*)(Ys + (size_t)s1 * D) + lane + 64 * j); } }
            }
            __builtin_amdgcn_sched_barrier(0);
            const int b = k; float* xr = p.out + (size_t)R * D; LAS const float* gg = ggl + b * 1024;
            f32x4 v[4]; float s = 0.f;
#pragma unroll
            for (int j = 0; j < 4; ++j) { const int col = 4 * lane + 256 * j; const u32x2 a = yaq[c0][j], c = ycq[c0][j], xx = xq[c0][j];
                f32x4 f; f.x = w0 * bflo(a.x) + w1 * bflo(c.x); f.y = w0 * bfhi(a.x) + w1 * bfhi(c.x); f.z = w0 * bflo(a.y) + w1 * bflo(c.y); f.w = w0 * bfhi(a.y) + w1 * bfhi(c.y);
                const f32x4 xv = {bflo(xx.x), bfhi(xx.x), bflo(xx.y), bfhi(xx.y)};
                v[j] = xv * DN_ALPHA + *(LAS const f32x4*)(gg + col) * f; s += (v[j].x + v[j].y) + (v[j].z + v[j].w); }
            const float mean = wave_sum(s) * (1.f / D); float s2 = 0.f;
#pragma unroll
            for (int j = 0; j < 4; ++j) { v[j] = v[j] - mean; s2 += (v[j].x * v[j].x + v[j].y * v[j].y) + (v[j].z * v[j].z + v[j].w * v[j].w); }
            const float rstd = 1.f / sqrtf(wave_sum(s2) * (1.f / D) + LN_EPS);
#pragma unroll
            for (int j = 0; j < 4; ++j) { const int col = 4 * lane + 256 * j; st_nt((f32x4*)xr + lane + 64 * j, v[j] * rstd * *(LAS const f32x4*)(g2 + col) + *(LAS const f32x4*)(b2 + col)); }
            __builtin_amdgcn_sched_barrier(0);
        }
        return;
    }
    u32x2 x1[4], nx1[4]; u32x2 ya[4], yc[4], nya[4], nyc[4]; float w0 = 0.f, w1 = 0.f, nw0 = 0.f, nw1 = 0.f;
    u32x4 tq = {0u, 0u, 0u, 0u}, tqn = {0u, 0u, 0u, 0u};
    if (gw < NLAT) { const u32x4 t0 = *(const u32x4*)(ts + (size_t)gw * 4); const int s0 = (int)t0.x, s1 = (int)t0.y; w0 = __uint_as_float(t0.z); w1 = __uint_as_float(t0.w);
#pragma unroll
        for (int j = 0; j < 4; ++j) { x1[j] = ld_nt((const u32x2*)(p.out + (size_t)gw * D) + lane + 64 * j); ya[j] = ld_nt((const u32x2*)(Ys + (size_t)s0 * D) + lane + 64 * j); yc[j] = ld_nt((const u32x2*)(Ys + (size_t)s1 * D) + lane + 64 * j); } }
    if (gw + NGW < NLAT) tq = *(const u32x4*)(ts + (size_t)(gw + NGW) * 4);
    for (int R = gw; R < NLAT; R += NGW) {
        const int Rn = R + NGW, Rnn = Rn + NGW;
        if (Rn < NLAT) { const int s0 = (int)tq.x, s1 = (int)tq.y; nw0 = __uint_as_float(tq.z); nw1 = __uint_as_float(tq.w);
#pragma unroll
            for (int j = 0; j < 4; ++j) { nx1[j] = ld_nt((const u32x2*)(p.out + (size_t)Rn * D) + lane + 64 * j); nya[j] = ld_nt((const u32x2*)(Ys + (size_t)s0 * D) + lane + 64 * j); nyc[j] = ld_nt((const u32x2*)(Ys + (size_t)s1 * D) + lane + 64 * j); } }
        if (Rnn < NLAT) tqn = *(const u32x4*)(ts + (size_t)Rnn * 4);
        const int b = R >> 11; float* xr = p.out + (size_t)R * D; LAS const float* gg = ggl + b * 1024;
        f32x4 v[4]; float s = 0.f;
#pragma unroll
        for (int j = 0; j < 4; ++j) { const int col = 4 * lane + 256 * j; const u32x2 a = ya[j], c = yc[j];
            f32x4 f; f.x = w0 * bflo(a.x) + w1 * bflo(c.x); f.y = w0 * bfhi(a.x) + w1 * bfhi(c.x); f.z = w0 * bflo(a.y) + w1 * bflo(c.y); f.w = w0 * bfhi(a.y) + w1 * bfhi(c.y);
            const f32x4 xv = {bflo(x1[j].x), bfhi(x1[j].x), bflo(x1[j].y), bfhi(x1[j].y)};
            v[j] = xv * DN_ALPHA + *(LAS const f32x4*)(gg + col) * f; s += (v[j].x + v[j].y) + (v[j].z + v[j].w); }
        const float mean = wave_sum(s) * (1.f / D); float s2 = 0.f;
#pragma unroll
        for (int j = 0; j < 4; ++j) { v[j] = v[j] - mean; s2 += (v[j].x * v[j].x + v[j].y * v[j].y) + (v[j].z * v[j].z + v[j].w * v[j].w); }
        const float rstd = 1.f / sqrtf(wave_sum(s2) * (1.f / D) + LN_EPS);
#pragma unroll
        for (int j = 0; j < 4; ++j) { const int col = 4 * lane + 256 * j; st_nt((f32x4*)xr + lane + 64 * j, v[j] * rstd * *(LAS const f32x4*)(g2 + col) + *(LAS const f32x4*)(b2 + col)); }
#pragma unroll
        for (int j = 0; j < 4; ++j) { x1[j] = nx1[j]; ya[j] = nya[j]; yc[j] = nyc[j]; }
        w0 = nw0; w1 = nw1; tq = tqn;
    }
}

#define XB_TMO      128
#define XB_XCNT(j)  (256  + 64 * (j))
#define XB_XSUB(j)  (1280 + 64 * (j))
#define XB_XGEN(j)  (2304 + 64 * (j))
#define XB_TOP      3328
#define XB_TOPGEN   3392
#define XCD_BAR_WORDS 3456
#define XB_SPIN_CAP (1u << 18)

__device__ __forceinline__ unsigned xb_ld(unsigned* p)              { return __hip_atomic_load(p, __ATOMIC_RELAXED, __HIP_MEMORY_SCOPE_AGENT); }
__device__ __forceinline__ unsigned xb_add(unsigned* p, unsigned v) { return __hip_atomic_fetch_add(p, v, __ATOMIC_RELAXED, __HIP_MEMORY_SCOPE_AGENT); }
__device__ __forceinline__ unsigned xb_xcc_id() { return (unsigned)__builtin_amdgcn_s_getreg((3 << 11) | 20) & 0xFu; }
#define XB_SPIN(cond, bar) do { unsigned _sp = 0; while (cond) { __builtin_amdgcn_s_sleep(1); \
    if ((++_sp & 255u) == 0u) { if (xb_ld(&(bar)[XB_TMO])) break; if (_sp > XB_SPIN_CAP) { atomicAdd(&(bar)[XB_TMO], 1u); break; } } } } while (0)

struct XcdBarrier {
    unsigned* bar; unsigned x;
    volatile LAS unsigned* st;
};

__device__ __forceinline__ XcdBarrier xcd_barrier_post(unsigned* bar, volatile LAS unsigned* st) {
    XcdBarrier b; b.bar = bar; b.x = xb_xcc_id(); b.st = st;
    if (threadIdx.x == 0) (void)xb_add(&bar[XB_XCNT(b.x)], 1u);
    return b;
}
__device__ __forceinline__ void xcd_barrier_complete(unsigned* bar, unsigned x, unsigned& nloc, unsigned& nx) {
    const unsigned G = gridDim.x * gridDim.y * gridDim.z;
    unsigned sum, cnt, mine, sp = 0u;
    for (;;) {
        sum = 0u; cnt = 0u; mine = 0u;
#pragma unroll
        for (unsigned j = 0; j < 16; ++j) { const unsigned c = xb_ld(&bar[XB_XCNT(j)]); sum += c; cnt += (c > 0u) ? 1u : 0u; mine = (j == x) ? c : mine; }
        if (sum == G) break;
        __builtin_amdgcn_s_sleep(1);
        if ((++sp & 255u) == 0u) { if (xb_ld(&bar[XB_TMO])) break; if (sp > XB_SPIN_CAP) { atomicAdd(&bar[XB_TMO], 1u); break; } }
    }
    nloc = mine > 0u ? mine : 1u; nx = cnt > 0u ? cnt : 1u;
}

__device__ __forceinline__ void xcd_barrier(const XcdBarrier& b) {
    asm volatile("s_waitcnt vmcnt(0)" ::: "memory");
    __syncthreads();
    if (threadIdx.x == 0) {
        unsigned* bar = b.bar;
        __builtin_amdgcn_s_waitcnt(0);
        unsigned nloc = b.st[0], nx = b.st[1];
        if (nloc == 0u) { xcd_barrier_complete(bar, b.x, nloc, nx); b.st[0] = nloc; b.st[1] = nx; }
        const unsigned old = xb_add(&bar[XB_XSUB(b.x)], 1u);
        const unsigned gen = old / nloc;
        if (old + 1u == (gen + 1u) * nloc) {
            __builtin_amdgcn_fence(__ATOMIC_RELEASE, "agent");
            asm volatile("s_waitcnt vmcnt(0)" ::: "memory");
            const unsigned og = xb_add(&bar[XB_TOP], 1u);
            const unsigned tg = og / nx;
            if (og + 1u == (tg + 1u) * nx) xb_add(&bar[XB_TOPGEN], 1u);
            else XB_SPIN(xb_ld(&bar[XB_TOPGEN]) == tg, bar);
            __builtin_amdgcn_fence(__ATOMIC_ACQUIRE, "agent");
            xb_add(&bar[XB_XGEN(b.x)], 1u);
            asm volatile("s_waitcnt vmcnt(0)" ::: "memory");
        } else {
            XB_SPIN(xb_ld(&bar[XB_XGEN(b.x)]) == gen, bar);
            __builtin_amdgcn_fence(__ATOMIC_ACQUIRE, "agent");
            asm volatile("s_waitcnt vmcnt(0)" ::: "memory");
        }
    }
    __syncthreads();
}

#ifdef USE_SIMPLE_GEMM
#define GEMM_CALL(g, S, E) gemm_simple(g, S, E)
#else
#define GEMM_CALL(g, S, E) pg8::gemm_phase<decltype(E), decltype(S), true, true>(lds, g, S, E)
#endif
#ifdef USE_SIMPLE_SCAN
#define SCAN_CALL scan_phase
#else
#ifdef USE_SCAN2
#define SCAN_CALL scan_phase2
#else
#define SCAN_CALL scan_phase3<0>
#endif
#endif
constexpr int NPHASE = 15;
__global__ void __launch_bounds__(NTHREADS) mega(Params p) {
    extern __shared__ __attribute__((aligned(16))) unsigned char lds_raw[];
    LAS unsigned char* lds = (LAS unsigned char*)lds_raw;
    cg::grid_group grid = cg::this_grid();
    const int tid = threadIdx.x, lane = tid & 63, wave = __builtin_amdgcn_readfirstlane(tid >> 6);
    unsigned char* ws = p.ws;
    const int G = gridDim.x, c = blockIdx.x;
    volatile LAS unsigned* xst = (volatile LAS unsigned*)(lds + LDS_BYTES - 16);
    if (tid < 2) xst[tid] = 0u;
    __syncthreads();
    XcdBarrier xbar; xbar.bar = (unsigned*)(ws + WS_BAR); xbar.x = 0; xbar.st = xst;
#ifndef PHMASK
#define PHMASK 0x7fff
#endif
#define IN(k) (((PHMASK >> (k)) & 1) && p.ph_lo <= (k) && (k) < p.ph_hi)
#define GSYNC() xcd_barrier(xbar)
#define SEAM(k) do { if (IN(k) && IN((k) + 1)) { if ((k) == 0) { grid.sync(); xbar = xcd_barrier_post((unsigned*)(ws + WS_BAR), xst); } else GSYNC(); } } while (0)
#ifndef REPMASK
#define REPMASK 0
#endif
#ifndef REPN
#define REPN 2
#endif
#define GEMMPH ((1 << 2) | (1 << 4) | (1 << 7) | (1 << 9) | (1 << 10) | (1 << 13))
#define GREP(k) ((((REPMASK) >> (k)) & 1) ? REPN : 1)
#define PHASE(k) for (int rep_ = 0; rep_ < (IN(k) ? (((((REPMASK) & ~GEMMPH) >> (k)) & 1) ? REPN : 1) : 0); ++rep_) if (rep_ ? (GSYNC(), true) : true)
    PHASE(0) phase0(p, lds, tid, wave, lane);
    SEAM(0);
    PHASE(1) phase1(p, lds, tid, wave, lane);
    SEAM(1);
    PHASE(2) { Gemm g{(const bf16_t*)(ws + WS_U), (const bf16_t*)(ws + WS_WT_IN), NROW, IN_PHYS, D}; SchedProj<0> S{G, c, GREP(2)};
        { LAS f32x2* TR = (LAS f32x2*)(lds + 131072); const f32x2* ROT = (const f32x2*)(ws + WS_ROT);
          lds_stage((LAS float*)TR, (const float*)ROT, 1, 512, 0, tid); lds_stage((LAS float*)TR + 16 * 128, (const float*)ROT, 4, 32, 16 * 128, tid); lds_stage((LAS float*)TR + 20 * 128, (const float*)ROT, 8, 32, 4 * 128, tid);
          __syncthreads(); } EpiProj E{ws, p.in[I_BMG], lds, p.in[I_CONVW], p.in[I_CONVB]}; GEMM_CALL(g, S, E); }
    SEAM(2);
    PHASE(3) { ScanArgs a{(const bf16_t*)(ws + WS_RQ), (const bf16_t*)(ws + WS_RK), (const bf16_t*)(ws + WS_RVT), (const float*)(ws + WS_G), p.in[I_DECAY], (bf16_t*)p.out, (bf16_t*)p.out + (size_t)NLAT * D, 0}; SCAN_CALL(lds, a, tid, wave, lane); }
#ifdef SCANPROBE
    if (IN(3)) { GSYNC(); ScanArgs a{(const bf16_t*)(ws + WS_RQ), (const bf16_t*)(ws + WS_RK), (const bf16_t*)(ws + WS_RVT), (const float*)(ws + WS_G), p.in[I_DECAY], (bf16_t*)(ws + WS_X0), (bf16_t*)(ws + WS_X0 + 64 * MiB), 0}; scan_phase3<SCANPROBE>(lds, a, tid, wave, lane); }
#endif
    SEAM(3);
    PHASE(4) { Gemm g{(const bf16_t*)(ws + WS_U), (const bf16_t*)(ws + WS_WT_IN), NROW, IN_PHYS, D}; SchedProj<1> S{G, c, GREP(4)};
        const int pnl = ((((c >> 3) + 6) & 7) >> 1);
        { LAS float* WL = (LAS float*)(lds + 139264); const float* cwp = p.in[I_CONVW]; const float* cbp = p.in[I_CONVB];
          float tv[4];
#pragma unroll
          for (int j = 0; j < 4; ++j) { const int i = tid + j * NTHREADS, sl = i >> 10, k = (i >> 8) & 3, col = i & 255, cg0 = sl * 1024 + pnl * 256; tv[j] = (k < 3) ? cwp[k * 2048 + cg0 + col] : cbp[cg0 + col]; }
#pragma unroll
          for (int j = 0; j < 4; ++j) { const int i = tid + j * NTHREADS; WL[i] = tv[j] * ((i >> 10) ? 0.0625f : 1.f); }
          __syncthreads(); }
        EpiProj E{ws, p.in[I_BMG], lds, p.in[I_CONVW], p.in[I_CONVB], pnl}; GEMM_CALL(g, S, E); }
    if (IN(4) && IN(6)) GSYNC();
    PHASE(6) { ScanArgs a{(const bf16_t*)(ws + WS_MQ), (const bf16_t*)(ws + WS_MK), (const bf16_t*)(ws + WS_MVT), (const float*)(ws + WS_G), p.in[I_DECAY], (bf16_t*)(ws + WS_OMF), (bf16_t*)(ws + WS_OMB), 1}; SCAN_CALL(lds, a, tid, wave, lane); }
    SEAM(6);
    PHASE(7) { Gemm g{(const bf16_t*)(ws + WS_U), (const bf16_t*)(ws + WS_WT_IN), NROW, IN_PHYS, D}; SchedProj<2> S{G, c, GREP(7)}; EpiProj E{ws, p.in[I_BMG], lds, p.in[I_CONVW], p.in[I_CONVB]}; GEMM_CALL(g, S, E); }
    SEAM(7);
    PHASE(8) {
        phase4_one<0>((const bf16_t*)p.out, (const bf16_t*)p.out + (size_t)NLAT * D, (const bf16_t*)(ws + WS_RGA), (bf16_t*)p.out, wave, lane);
        phase4_one<1>((const bf16_t*)(ws + WS_OMF), (const bf16_t*)(ws + WS_OMB), (const bf16_t*)(ws + WS_MOA), (bf16_t*)(ws + WS_M), wave, lane);
    }
    SEAM(8);
    PHASE(9) {
        SchedDense S{G, c, 128, 4, 1}; SchedDense S1{G, c, 128, 4, GREP(9)};
        { Gemm g{(const bf16_t*)p.out, (const bf16_t*)(ws + WS_WT_R), NLAT, D, D}; EpiY E{(bf16_t*)(ws + WS_Y), (const bf16_t*)(ws + WS_GRA), 0}; GEMM_CALL(g, S1, E); }
        { Gemm g{(const bf16_t*)(ws + WS_M), (const bf16_t*)(ws + WS_WT_M), NLAT, D, D}; EpiY E{(bf16_t*)(ws + WS_Y), (const bf16_t*)(ws + WS_GMA), 1}; GEMM_CALL(g, S, E); }
    }
    SEAM(9);
    PHASE(10) { SchedDense S{G, c, 128, 4, GREP(10)}; Gemm g{(const bf16_t*)(ws + WS_Y), (const bf16_t*)(ws + WS_WT_O), NLAT, D, D}; EpiY2 E{(bf16_t*)(ws + WS_Y2)}; GEMM_CALL(g, S, E); }
    SEAM(10);
    PHASE(11) phase7(p, lds, tid, wave, lane);
    SEAM(11);
    PHASE(12) phase8(p, lds, tid, wave, lane);
    SEAM(12);
    PHASE(13) {
        const int ntiles = ((const int*)(ws + WS_CTL))[64];
        SchedMoe S{G, c, (const int*)(ws + WS_TILEEXP), ntiles, GREP(13)};
        Gemm g{(const bf16_t*)(ws + WS_XS), (const bf16_t*)(ws + WS_W13T), MAXSLOT, 32 * 1024, D}; EpiH E{(bf16_t*)(ws + WS_HS)}; GEMM_CALL(g, S, E);
        GSYNC();
        Gemm g2{(const bf16_t*)(ws + WS_HS), (const bf16_t*)(ws + WS_W2T), MAXSLOT, 32 * 1024, DE}; EpiYs E2{(bf16_t*)(ws + WS_YS)}; GEMM_CALL(g2, S, E2);
    }
    SEAM(13);
    PHASE(14) phase11(p, lds, tid, wave, lane);
#undef IN
#undef SEAM
}

extern "C" void kernel_launch(void* const* d_in, const int* in_sizes, int n_in, void* d_out, int out_size, void* d_ws, size_t ws_size, hipStream_t stream) {
    static int grid = 0;
    if (grid == 0) {
        if (n_in != 25 || out_size != NLAT * D || ws_size < WS_NEED) { fprintf(stderr, "kernel_launch: unexpected shapes n_in %d out %d ws %zu; nothing launched\n", n_in, out_size, ws_size); grid = -1; return; }
        int dev = 0, cus = 0, per_cu = 0;
        if (hipGetDevice(&dev) != hipSuccess || hipDeviceGetAttribute(&cus, hipDeviceAttributeMultiprocessorCount, dev) != hipSuccess) { grid = -1; return; }
        if (hipFuncSetAttribute((const void*)mega, hipFuncAttributeMaxDynamicSharedMemorySize, LDS_BYTES) != hipSuccess) { fprintf(stderr, "kernel_launch: hipFuncSetAttribute failed\n"); grid = -1; return; }
        if (hipOccupancyMaxActiveBlocksPerMultiprocessor(&per_cu, (const void*)mega, NTHREADS, LDS_BYTES) != hipSuccess || per_cu < 1) { fprintf(stderr, "kernel_launch: occupancy query says %d\n", per_cu); per_cu = 1; }
        (void)hipGetLastError();
        grid = cus * 1;
        (void)per_cu;
    }
    if (grid < 0) return;
    Params p{};
    for (int i = 0; i < 25; ++i) p.in[i] = (const float*)d_in[i];
    p.out = (float*)d_out; p.ws = (unsigned char*)d_ws; p.ph_lo = 0; p.ph_hi = NPHASE;
    void* args[] = {&p};
    hipError_t e = hipLaunchCooperativeKernel((const void*)mega, dim3(grid), dim3(NTHREADS), args, LDS_BYTES, stream);
    if (e != hipSuccess) fprintf(stderr, "kernel_launch: cooperative launch failed: %s (grid %d)\n", hipGetErrorString(e), grid);
}
```
